# Optimizing an MI355X kernel written in HIP

```python
import jax, jax.numpy as jnp
from jax import lax
import numpy as np

D_MODEL = 1024
BATCH = 8
SEQ = 4096
DEPTH = 4

CTX_LEN = 256
GRID_W = 64
D_MIX = D_MODEL
N_GROUPS = 4
GROUP_W = D_MIX // N_GROUPS
HEAD_DIM = 64
GROUP_HEADS = GROUP_W // HEAD_DIM
NORM_EPS = 1e-6

CONV_W = GROUP_W
MLA_HEADS = GROUP_HEADS
MLA_NOPE = HEAD_DIM
MLA_ROPE = HEAD_DIM // 2
MLA_QK = MLA_NOPE + MLA_ROPE
MLA_V = HEAD_DIM
MLA_W = MLA_HEADS * MLA_V
KV_RANK = D_MODEL // 8
ROPE_BASE = 10000.0
Q_BLOCK = 128
RWKV_HEADS = GROUP_HEADS
RWKV_N = HEAD_DIM
RWKV_W = GROUP_W
DECAY_LORA = 64
ICLR_LORA = 64
GATE_LORA = 128
RWKV_GN_EPS = 64e-5
RET_HEADS = GROUP_HEADS
RET_DK = HEAD_DIM
RET_DV = HEAD_DIM
RET_W = GROUP_W
RET_CHUNK = 128
RET_THETA_BASE = 10000.0
N_EXP = 16
CAP_FACTOR = 2
EXP_FF = D_MODEL

COLS_CONV = 3 * CONV_W
COLS_MLA = MLA_HEADS * MLA_QK + KV_RANK + MLA_ROPE
COLS_RWKV = 3 * RWKV_W + DECAY_LORA + ICLR_LORA + GATE_LORA
COLS_RET = 4 * RET_W
IN_COLS = COLS_CONV + COLS_MLA + COLS_RWKV + COLS_RET
MIX_SPLITS = (COLS_CONV, COLS_CONV + COLS_MLA, COLS_CONV + COLS_MLA + COLS_RWKV)
MLA_SPLITS = (MLA_HEADS * MLA_NOPE, MLA_HEADS * MLA_QK, MLA_HEADS * MLA_QK + KV_RANK)
RWKV_SPLITS = (RWKV_W, 2 * RWKV_W, 3 * RWKV_W, 3 * RWKV_W + DECAY_LORA, 3 * RWKV_W + DECAY_LORA + ICLR_LORA)

kernel_name = 'hybrid_diffusion_parallel_groups_ec_moe'


def rms_norm(t, g):
    tf = t.astype(jnp.float32)
    y = tf * lax.rsqrt(jnp.mean(tf * tf, axis=-1, keepdims=True) + NORM_EPS)
    return y.astype(t.dtype) * g


def modulate(h, shift, scale):
    return h * (1.0 + scale) + shift


def split_heads(t, n):
    return t.reshape(t.shape[:-1] + (n, t.shape[-1] // n))


def merge_heads(t):
    return t.reshape(t.shape[:-2] + (-1,))


def shift_prev(t):
    return jnp.pad(t, ((0, 0), (1, 0), (0, 0)))[:, :-1]


def shift_next(t):
    return jnp.pad(t, ((0, 0), (0, 1), (0, 0)))[:, 1:]


def cos_sin(ang):
    return jnp.cos(ang)[:, None, :], jnp.sin(ang)[:, None, :]


def rotate(t, cos, sin):
    t1, t2 = jnp.split(t, 2, axis=-1)
    return jnp.concatenate([t1 * cos - t2 * sin, t1 * sin + t2 * cos], axis=-1)


def short_conv_mixer(z, conv_w, g_out):
    b, cg, h = jnp.split(z, 3, axis=-1)
    u = cg * h
    y = conv_w[0] * shift_prev(u) + conv_w[1] * u + conv_w[2] * shift_next(u)
    return rms_norm(b * y, g_out)


def rope_2d_tail(t, rot_row, rot_col):
    nope, rr, rc = jnp.split(t, [MLA_NOPE, MLA_NOPE + MLA_ROPE // 2], axis=-1)
    return jnp.concatenate([nope, rotate(rr, *rot_row), rotate(rc, *rot_col)], axis=-1)


def mla_queries(z, g_q):
    q_nope, q_rope, _, _ = jnp.split(z, MLA_SPLITS, axis=-1)
    q = jnp.concatenate([split_heads(q_nope, MLA_HEADS), split_heads(q_rope, MLA_HEADS)], axis=-1)
    return rms_norm(q, g_q)


def mla_keys_values(z, g_kv, w_uk, w_uv, g_k):
    _, _, ckv, k_rope = jnp.split(z, MLA_SPLITS, axis=-1)
    ckv = rms_norm(ckv, g_kv)
    k_nope = split_heads(ckv @ w_uk, MLA_HEADS)
    v = split_heads(ckv @ w_uv, MLA_HEADS)
    k_rope = jnp.broadcast_to(k_rope[:, :, None, :], k_nope.shape[:-1] + (MLA_ROPE,))
    k = rms_norm(jnp.concatenate([k_nope, k_rope], axis=-1), g_k)
    return k, v


def softmax_attend(q, k, v):
    s = jnp.einsum('bqhd,bkhd->bhqk', q, k).astype(jnp.float32) * (MLA_QK ** -0.5)
    p = jax.nn.softmax(s, axis=-1).astype(v.dtype)
    return jnp.einsum('bhqk,bkhd->bqhd', p, v)


def blocked_attend(q, k, v):
    B, L, H, dq = q.shape
    qb = q.reshape(B, L // Q_BLOCK, Q_BLOCK, H, dq).swapaxes(0, 1)
    out = lax.map(lambda blk: softmax_attend(blk, k, v), qb)
    return out.swapaxes(0, 1).reshape(B, L, H, -1)


def mla_mixer(z_x, z_c, g_kv, w_uk, w_uv, g_q, g_k, g_out, rot_row, rot_col, need_ctx):
    k_c, v_c = mla_keys_values(z_c, g_kv, w_uk, w_uv, g_k)
    k_x, v_x = mla_keys_values(z_x, g_kv, w_uk, w_uv, g_k)
    k_x = rope_2d_tail(k_x, rot_row, rot_col)
    q_x = rope_2d_tail(mla_queries(z_x, g_q), rot_row, rot_col)
    k_all = jnp.concatenate([k_c, k_x], axis=1)
    v_all = jnp.concatenate([v_c, v_x], axis=1)
    y_x = rms_norm(merge_heads(blocked_attend(q_x, k_all, v_all)), g_out)
    y_c = rms_norm(merge_heads(softmax_attend(mla_queries(z_c, g_q), k_c, v_c)), g_out) if need_ctx else None
    return y_x, y_c


def rwkv_project(z, mu, w0, w2, a0, a2, k_k, k_a):
    z = z.astype(jnp.float32)
    z = z + mu * (0.5 * (shift_prev(z) + shift_next(z)) - z)
    r, k, v, wl, al, gl = jnp.split(z, RWKV_SPLITS, axis=-1)
    kk = split_heads(k * k_k, RWKV_HEADS)
    kk = kk * lax.rsqrt(jnp.sum(kk * kk, axis=-1, keepdims=True) + 1e-12)
    dirs = []
    for d in range(2):
        log_w = -jax.nn.softplus(-(w0[d] + jnp.tanh(wl) @ w2[d])) - 0.5
        w = jnp.exp(-jnp.exp(log_w))
        a = jax.nn.sigmoid(a0[d] + al @ a2[d])
        kt = k * (1.0 + (a - 1.0) * k_a)
        dirs.append((split_heads(w, RWKV_HEADS), split_heads(a, RWKV_HEADS), split_heads(kt, RWKV_HEADS)))
    return split_heads(r, RWKV_HEADS), split_heads(v, RWKV_HEADS), kk, gl, dirs


def wkv_scan(state, w, a, k, v, kk, r, reverse, emit):
    xs = (w, a, k, v, kk) + ((r,) if emit else ())
    xs = tuple(jnp.moveaxis(t, 1, 0) for t in xs)

    def step(s, inp):
        w_t, a_t, k_t, v_t, kk_t = inp[:5]
        s = (s * w_t[:, :, None, :]
             - jnp.einsum('bhvk,bhk->bhv', s, kk_t)[..., None] * (kk_t * a_t)[:, :, None, :]
             + v_t[..., None] * k_t[:, :, None, :])
        y = jnp.einsum('bhvk,bhk->bhv', s, inp[5]) if emit else None
        return s, y

    state, ys = lax.scan(step, state, xs, reverse=reverse)
    return state, (jnp.moveaxis(ys, 0, 1) if emit else None)


def rwkv_out(y, r, v, k_sum, gl, g2, r_k, g_ln):
    mean = jnp.mean(y, axis=-1, keepdims=True)
    var = jnp.mean(jnp.square(y - mean), axis=-1, keepdims=True)
    y = (y - mean) * lax.rsqrt(var + RWKV_GN_EPS) * g_ln.reshape(RWKV_HEADS, RWKV_N)
    y = y + jnp.sum(r * k_sum * r_k.reshape(RWKV_HEADS, RWKV_N), axis=-1, keepdims=True) * v
    return merge_heads(y) * (jax.nn.sigmoid(gl) @ g2)


def rwkv_mixer(z_x, z_c, mu, w0, w2, a0, a2, g2, k_k, k_a, r_k, g_ln, need_ctx):
    s0 = jnp.zeros((z_x.shape[0], RWKV_HEADS, RWKV_N, RWKV_N), jnp.float32)
    rx, vx, kkx, glx, dx = rwkv_project(z_x, mu, w0, w2, a0, a2, k_k, k_a)
    rc, vc, kkc, glc, dc = rwkv_project(z_c, mu, w0, w2, a0, a2, k_k, k_a)
    s_fw, yc_fw = wkv_scan(s0, *dc[0], vc, kkc, rc, False, need_ctx)
    s_bw, yc_bw = wkv_scan(s0, *dc[1], vc, kkc, rc, True, need_ctx)
    _, yx_fw = wkv_scan(s_fw, *dx[0], vx, kkx, rx, False, True)
    _, yx_bw = wkv_scan(s_bw, *dx[1], vx, kkx, rx, True, True)
    y_x = rwkv_out(yx_fw + yx_bw, rx, vx, dx[0][2] + dx[1][2], glx, g2, r_k, g_ln)
    y_c = rwkv_out(yc_fw + yc_bw, rc, vc, dc[0][2] + dc[1][2], glc, g2, r_k, g_ln) if need_ctx else None
    return y_x, y_c


def ret_project(z, rot):
    q, k, v, g = jnp.split(z.astype(jnp.float32), 4, axis=-1)
    q = split_heads(q, RET_HEADS) * (RET_DK ** -0.5)
    k = split_heads(k, RET_HEADS)
    if rot is not None:
        q = rotate(q, *rot)
        k = rotate(k, *rot)
    return q, k, split_heads(v, RET_HEADS), g


def ret_chunkwise(q, k, v, r0, log_gamma, strict, emit):
    B, L, H, dk = k.shape
    nc = L // RET_CHUNK
    kc = k.reshape(B, nc, RET_CHUNK, H, dk)
    vc = v.reshape(B, nc, RET_CHUNK, H, -1)
    j = jnp.arange(RET_CHUNK, dtype=jnp.float32)
    zeta = jnp.exp((RET_CHUNK - 1 - j)[:, None] * log_gamma[None, :])
    d_r = jnp.einsum('bnchk,bnchv->bnhkv', kc * zeta[None, None, :, :, None], vc)
    dec_c = jnp.exp(RET_CHUNK * log_gamma)[None, :, None, None]

    def step(r_state, dr_i):
        return r_state * dec_c + dr_i, (r_state if emit else None)

    r_fin, r_prev = lax.scan(step, r0, d_r.swapaxes(0, 1))
    if not emit:
        return None, r_fin
    qc = q.reshape(B, nc, RET_CHUNK, H, dk)
    xi = jnp.exp((j + 1.0)[:, None] * log_gamma[None, :])
    cross = jnp.einsum('bnchk,nbhkv->bnchv', qc * xi[None, None, :, :, None], r_prev)
    diff = j[:, None] - j[None, :]
    mask = diff > 0 if strict else diff >= 0
    dmat = jnp.where(mask[None], jnp.exp(jnp.where(mask, diff, 0.0)[None] * log_gamma[:, None, None]), 0.0)
    s = jnp.einsum('bnqhd,bnkhd->bnhqk', qc, kc) * dmat[None, None]
    inner = jnp.einsum('bnhqk,bnkhv->bnqhv', s, vc)
    return (inner + cross).reshape(B, L, H, -1), r_fin


def ret_out(y, g, g_norm):
    y = rms_norm(y, g_norm.reshape(RET_HEADS, RET_DV))
    return jax.nn.silu(g) * merge_heads(y)


def retention_mixer(z_x, z_c, g_norm, rot, log_gamma, need_ctx):
    r0 = jnp.zeros((z_x.shape[0], RET_HEADS, RET_DK, RET_DV), jnp.float32)
    flip = lambda t: jnp.flip(t, axis=1)
    qx, kx, vx, gx = ret_project(z_x, rot)
    qc, kc, vc, gc = ret_project(z_c, None)
    yc_fw, r_fw = ret_chunkwise(qc, kc, vc, r0, log_gamma, False, need_ctx)
    yc_bw, r_bw = ret_chunkwise(flip(qc), flip(kc), flip(vc), r0, log_gamma, True, need_ctx)
    yx_fw, _ = ret_chunkwise(qx, kx, vx, r_fw, log_gamma, False, True)
    yx_bw, _ = ret_chunkwise(flip(qx), flip(kx), flip(vx), r_bw, log_gamma, True, True)
    y_x = ret_out(yx_fw + flip(yx_bw), gx, g_norm)
    y_c = ret_out(yc_fw + flip(yc_bw), gc, g_norm) if need_ctx else None
    return y_x, y_c


def ec_ffn(h, w_router, b_router, w_gate, w_up, w_down):
    n_tok = h.shape[1]
    cap = CAP_FACTOR * n_tok // N_EXP

    def route_set(hs):
        aff = jax.nn.softmax((hs @ w_router + b_router).astype(jnp.float32), axis=-1)
        gate, idx = lax.top_k(aff.T, cap)
        xe = hs[idx]
        hid = jax.nn.silu(jnp.einsum('ecd,edf->ecf', xe, w_gate)) * jnp.einsum('ecd,edf->ecf', xe, w_up)
        ye = jnp.einsum('ecf,efd->ecd', hid, w_down) * gate[..., None].astype(hid.dtype)
        return jnp.zeros(hs.shape, ye.dtype).at[idx.reshape(-1)].add(ye.reshape(-1, hs.shape[-1]))

    return jax.vmap(route_set)(h)


def setup_inputs(seed: int = 0) -> dict:
    key = jax.random.key(seed)
    ks = iter(jax.random.split(key, 40))
    f32 = jnp.float32
    D = D_MODEL

    def nrm(shape, scale):
        return scale * jax.random.normal(next(ks), shape, f32)

    def gain(shape):
        return 1.0 + nrm(shape, 0.02)

    return {
        'x': nrm((BATCH, SEQ, D), 1.0),
        'c': nrm((BATCH, D), 1.0),
        'ctx': nrm((BATCH, CTX_LEN, D), 1.0),
        'c_ctx': nrm((D,), 1.0),
        'w_ada': nrm((DEPTH, D, 6 * D), 0.5 * D ** -0.5),
        'b_ada': nrm((DEPTH, 6 * D), 0.02),
        'g_norm1': gain((DEPTH, D)),
        'g_norm2': gain((DEPTH, D)),
        'w_in': nrm((DEPTH, D, IN_COLS), D ** -0.5),
        'w_out': nrm((DEPTH, D_MIX, D), D_MIX ** -0.5),
        'conv_w': nrm((DEPTH, 3, CONV_W), 0.5),
        'g_out_conv': gain((DEPTH, CONV_W)),
        'g_kv_norm': gain((DEPTH, KV_RANK)),
        'w_uk': nrm((DEPTH, KV_RANK, MLA_HEADS * MLA_NOPE), KV_RANK ** -0.5),
        'w_uv': nrm((DEPTH, KV_RANK, MLA_HEADS * MLA_V), KV_RANK ** -0.5),
        'g_q_norm': gain((DEPTH, MLA_QK)),
        'g_k_norm': gain((DEPTH, MLA_QK)),
        'g_out_mla': gain((DEPTH, MLA_W)),
        'rwkv_mu': 0.5 + nrm((DEPTH, COLS_RWKV), 0.1),
        'rwkv_w0': jax.random.uniform(next(ks), (DEPTH, 2, RWKV_W), f32, -6.0, -1.0),
        'rwkv_w2': nrm((DEPTH, 2, DECAY_LORA, RWKV_W), 0.1),
        'rwkv_a0': nrm((DEPTH, 2, RWKV_W), 0.1),
        'rwkv_a2': nrm((DEPTH, 2, ICLR_LORA, RWKV_W), 0.1),
        'rwkv_g2': nrm((DEPTH, GATE_LORA, RWKV_W), GATE_LORA ** -0.5),
        'rwkv_k_k': 0.85 + nrm((DEPTH, RWKV_W), 0.05),
        'rwkv_k_a': 1.0 + nrm((DEPTH, RWKV_W), 0.05),
        'rwkv_r_k': nrm((DEPTH, RWKV_W), 0.1),
        'g_ln_x': gain((DEPTH, RWKV_W)),
        'g_ret_norm': gain((DEPTH, RET_W)),
        'w_router': nrm((DEPTH, D, N_EXP), D ** -0.5),
        'b_router': nrm((DEPTH, N_EXP), 0.01),
        'w_gate': nrm((DEPTH, N_EXP, D, EXP_FF), D ** -0.5),
        'w_up': nrm((DEPTH, N_EXP, D, EXP_FF), D ** -0.5),
        'w_down': nrm((DEPTH, N_EXP, EXP_FF, D), EXP_FF ** -0.5),
    }


def reference(x, c, ctx, c_ctx, w_ada, b_ada, g_norm1, g_norm2, w_in, w_out, conv_w, g_out_conv,
              g_kv_norm, w_uk, w_uv, g_q_norm, g_k_norm, g_out_mla, rwkv_mu, rwkv_w0, rwkv_w2,
              rwkv_a0, rwkv_a2, rwkv_g2, rwkv_k_k, rwkv_k_a, rwkv_r_k, g_ln_x, g_ret_norm,
              w_router, b_router, w_gate, w_up, w_down):
    f32 = jnp.float32
    L = x.shape[1]
    ROWS = L // GRID_W
    row = jnp.repeat(jnp.arange(ROWS, dtype=f32), GRID_W)
    col = jnp.tile(jnp.arange(GRID_W, dtype=f32), ROWS)
    axis_dim = MLA_ROPE // 2
    inv_axis = ROPE_BASE ** (-jnp.arange(0, axis_dim, 2, dtype=f32) / axis_dim)
    rot_row = cos_sin(row[:, None] * inv_axis[None, :])
    rot_col = cos_sin(col[:, None] * inv_axis[None, :])
    theta = 1.0 / (RET_THETA_BASE ** jnp.linspace(0.0, 1.0, RET_DK // 2, dtype=f32))
    rot_ret = cos_sin(jnp.arange(L, dtype=f32)[:, None] * theta[None, :])
    log_gamma = jnp.log1p(-jnp.exp2(-5.0 - jnp.arange(RET_HEADS, dtype=f32)))

    xc = ctx
    for l in range(DEPTH):
        need_ctx = l < DEPTH - 1
        mod_x = (jax.nn.silu(c) @ w_ada[l] + b_ada[l])[:, None, :]
        mod_c = jax.nn.silu(c_ctx) @ w_ada[l] + b_ada[l]
        sh1, sc1, ga1, sh2, sc2, ga2 = jnp.split(mod_x, 6, axis=-1)
        csh1, csc1, cga1, csh2, csc2, cga2 = jnp.split(mod_c, 6, axis=-1)

        z_x = modulate(rms_norm(x, g_norm1[l]), sh1, sc1) @ w_in[l]
        z_c = modulate(rms_norm(xc, g_norm1[l]), csh1, csc1) @ w_in[l]
        zx_conv, zx_mla, zx_rwkv, zx_ret = jnp.split(z_x, MIX_SPLITS, axis=-1)
        zc_conv, zc_mla, zc_rwkv, zc_ret = jnp.split(z_c, MIX_SPLITS, axis=-1)
        y_mla_x, y_mla_c = mla_mixer(zx_mla, zc_mla, g_kv_norm[l], w_uk[l], w_uv[l], g_q_norm[l],
                                     g_k_norm[l], g_out_mla[l], rot_row, rot_col, need_ctx)
        y_rwkv_x, y_rwkv_c = rwkv_mixer(zx_rwkv, zc_rwkv, rwkv_mu[l], rwkv_w0[l], rwkv_w2[l], rwkv_a0[l],
                                        rwkv_a2[l], rwkv_g2[l], rwkv_k_k[l], rwkv_k_a[l], rwkv_r_k[l],
                                        g_ln_x[l], need_ctx)
        y_ret_x, y_ret_c = retention_mixer(zx_ret, zc_ret, g_ret_norm[l], rot_ret, log_gamma, need_ctx)
        y_x = jnp.concatenate([short_conv_mixer(zx_conv, conv_w[l], g_out_conv[l]),
                               y_mla_x, y_rwkv_x, y_ret_x], axis=-1).astype(x.dtype)
        x = x + ga1 * (y_x @ w_out[l])
        if need_ctx:
            y_c = jnp.concatenate([short_conv_mixer(zc_conv, conv_w[l], g_out_conv[l]),
                                   y_mla_c, y_rwkv_c, y_ret_c], axis=-1).astype(xc.dtype)
            xc = xc + cga1 * (y_c @ w_out[l])

        h_x = modulate(rms_norm(x, g_norm2[l]), sh2, sc2)
        x = x + ga2 * ec_ffn(h_x, w_router[l], b_router[l], w_gate[l], w_up[l], w_down[l])
        if need_ctx:
            h_c = modulate(rms_norm(xc, g_norm2[l]), csh2, csc2)
            xc = xc + cga2 * ec_ffn(h_c, w_router[l], b_router[l], w_gate[l], w_up[l], w_down[l])
    return x
```

```cpp
#include <hip/hip_runtime.h>
#include <stdint.h>
#include <math.h>
#include <string.h>

#ifdef SMALL_CFG
#define D_ 256
#define B_ 2
#define L_ 256
#define DEPTH_ 2
#define LC_ 128
#define GRIDW_ 64
#define HD_ 32
#define KVR_ 32
#define DLORA_ 16
#define ALORA_ 16
#define GLORA_ 32
#define NEXP_ 4
#else
#define D_ 1024
#define B_ 8
#define L_ 4096
#define DEPTH_ 4
#define LC_ 256
#define GRIDW_ 64
#define HD_ 64
#define KVR_ 128
#define DLORA_ 64
#define ALORA_ 64
#define GLORA_ 128
#define NEXP_ 16
#endif
#define CAPF_ 2
#define GWID_ (D_ / 4)
#define NH_ (GWID_ / HD_)
#define ROPE_ (HD_ / 2)
#define QK_ (HD_ + ROPE_)
#define NTOK_ (B_ * L_)
#define NCTX_ (B_ * LC_)
#define NROWS_ (NTOK_ + NCTX_)
#define LK_ (LC_ + L_)
#define COLS_MLA_ (NH_ * QK_ + KVR_ + ROPE_)
#define COLS_RWKV_ (3 * GWID_ + DLORA_ + ALORA_ + GLORA_)
#define MLA0_ (3 * GWID_)
#define RW0_ (MLA0_ + COLS_MLA_)
#define RT0_ (RW0_ + COLS_RWKV_)
#define INCOLS_ (RT0_ + 4 * GWID_)
#define ZLD_ (((INCOLS_ + 255) / 256) * 256)
#define CAP_ (CAPF_ * L_ / NEXP_)
#define CAPC_ (CAPF_ * LC_ / NEXP_)
#define XSLOTS_ (B_ * NEXP_ * CAP_)
#define CSLOTS_ (B_ * NEXP_ * CAPC_)
#define RCH_ 128
#define NCC_ (LC_ / RCH_)
#define NCX_ (L_ / RCH_)
#define NCH_ (NCC_ + NCX_)
#define NT 512
#define NWAVE (NT / 64)

typedef unsigned short bf16_t;

__device__ __forceinline__ float bf2f(bf16_t v) { union { unsigned u; float f; } x; x.u = ((unsigned)v) << 16; return x.f; }
__device__ __forceinline__ bf16_t f2bf(float f) { union { unsigned u; float f; } x; x.f = f; unsigned u = x.u; u += 0x7FFFu + ((u >> 16) & 1u); return (bf16_t)(u >> 16); }
__device__ __forceinline__ float wave_sum(float v) { for (int m = 32; m >= 1; m >>= 1) v += __shfl_xor(v, m); return v; }
__device__ __forceinline__ float wave_max(float v) { for (int m = 32; m >= 1; m >>= 1) v = fmaxf(v, __shfl_xor(v, m)); return v; }
__device__ __forceinline__ float sigmoidf_(float x) { return 1.0f / (1.0f + expf(-x)); }
__device__ __forceinline__ float siluf_(float x) { return x / (1.0f + expf(-x)); }


#ifdef CPU_EMU
__device__ __forceinline__ int otid() { return threadIdx.x; }
__device__ __forceinline__ int obid() { return blockIdx.x; }
#else
__device__ __forceinline__ int otid() { int t = threadIdx.x; asm volatile("" : "+v"(t)); return t; }
__device__ __forceinline__ int obid() { int b = blockIdx.x; asm volatile("" : "+s"(b)); return b; }
#endif
struct Params {
  const float *x, *c, *ctx, *c_ctx, *w_ada, *b_ada, *g_norm1, *g_norm2, *w_in, *w_out, *conv_w, *g_out_conv, *g_kv_norm, *w_uk, *w_uv,
      *g_q_norm, *g_k_norm, *g_out_mla, *rwkv_mu, *rwkv_w0, *rwkv_w2, *rwkv_a0, *rwkv_a2, *rwkv_g2, *rwkv_k_k, *rwkv_k_a, *rwkv_r_k, *g_ln_x,
      *g_ret_norm, *w_router, *b_router, *w_gate, *w_up, *w_down;
  float* out;
  unsigned* bar;
  float* modv;
  float* xc;
  bf16_t* h;
  bf16_t* z;
  bf16_t* y;
  bf16_t* qb;
  bf16_t* kb;
  bf16_t* vb;
  float* ob;
  float* sc_r;
  float* sc_v;
  float* sc_kk;
  float* sc_w;
  float* sc_kka;
  float* sc_kt;
  float* sc_gate;
  float* sc_bonus;
  float* ys;
  bf16_t* rq;
  bf16_t* rk;
  bf16_t* rv;
  float* rd;
  float* rs;
  float* tab_mla;
  float* tab_ret;
  float* aff;
  int* sel_idx;
  float* sel_gate;
  int* inv;
  bf16_t* hid;
  bf16_t* ye;
};

enum { PH_MOD = 0, PH_NORM1, PH_GEMM_IN, PH_PREP, PH_RETD, PH_MIX, PH_POST, PH_GEMM_OUT, PH_NORM2, PH_TOPK, PH_MOE1, PH_MOE2, PH_FINAL, PH_COUNT };

__device__ __forceinline__ int row_batch(int row) { return row < NTOK_ ? row / L_ : (row - NTOK_) / LC_; }
__device__ __forceinline__ int row_modidx(int row) { return row < NTOK_ ? row / L_ : B_; }
__device__ __forceinline__ int row_pos(int row) { return row < NTOK_ ? row % L_ : (row - NTOK_) % LC_; }
__device__ __forceinline__ int row_len(int row) { return row < NTOK_ ? L_ : LC_; }

__device__ __forceinline__ void phase_mod(const Params& p) {
  const int tid = otid();
  for (int idx = obid() * NT + tid; idx < DEPTH_ * 6 * D_; idx += gridDim.x * NT) {
    const int l = idx / (6 * D_), col = idx % (6 * D_);
    float acc[B_ + 1];
#pragma unroll
    for (int r = 0; r <= B_; ++r) acc[r] = 0.f;
    const float* w = p.w_ada + (size_t)l * D_ * 6 * D_ + col;
    for (int k = 0; k < D_; ++k) {
      const float wv = w[(size_t)k * 6 * D_];
#pragma unroll
      for (int r = 0; r < B_; ++r) acc[r] += siluf_(p.c[r * D_ + k]) * wv;
      acc[B_] += siluf_(p.c_ctx[k]) * wv;
    }
    const float bb = p.b_ada[l * 6 * D_ + col];
#pragma unroll
    for (int r = 0; r <= B_; ++r) p.modv[((size_t)l * (B_ + 1) + r) * 6 * D_ + col] = acc[r] + bb;
  }
  const int NF = ROPE_ / 4;
  for (int idx = obid() * NT + tid; idx < L_ * NF; idx += gridDim.x * NT) {
    const int t = idx / NF, i = idx % NF;
    const float inv = powf(10000.0f, -(float)(2 * i) / (float)(ROPE_ / 2));
    const float ar = (float)(t / GRIDW_) * inv, ac = (float)(t % GRIDW_) * inv;
    float* o = p.tab_mla + (size_t)t * 4 * NF;
    o[0 * NF + i] = cosf(ar); o[1 * NF + i] = sinf(ar); o[2 * NF + i] = cosf(ac); o[3 * NF + i] = sinf(ac);
  }
  const int NR = HD_ / 2;
  for (int idx = obid() * NT + tid; idx < L_ * NR; idx += gridDim.x * NT) {
    const int t = idx / NR, i = idx % NR;
    const float theta = 1.0f / powf(10000.0f, (float)i / (float)(NR - 1));
    const float a = (float)t * theta;
    p.tab_ret[(size_t)t * 2 * NR + i] = cosf(a); p.tab_ret[(size_t)t * 2 * NR + NR + i] = sinf(a);
  }
}

template <int MODE> __device__ __forceinline__ void phase_norm(const Params& p, int l) {
  const int tid = otid(), wave = tid >> 6, lane = tid & 63;
  const bool last = (l == DEPTH_ - 1);
  for (int row = obid() * NWAVE + wave; row < NROWS_; row += gridDim.x * NWAVE) {
    const bool isx = row < NTOK_;
    if (MODE == 2 && !isx) continue;
    if (MODE == 1 && !isx && last) continue;
    const int mi = row_modidx(row);
    float* xrow = isx ? p.out + (size_t)row * D_ : p.xc + (size_t)(row - NTOK_) * D_;
    const float* src = xrow;
    if (MODE == 0 && l == 0) src = isx ? p.x + (size_t)row * D_ : p.ctx + (size_t)(row - NTOK_) * D_;
    float v[D_ / 64];
    float ss = 0.f;
    const bool combine = (MODE == 0 && l > 0) || MODE == 2;
    const int lprev = (MODE == 2) ? l : l - 1;
#pragma unroll
    for (int i = 0; i < D_ / 256; ++i) {
      const int col = (i * 64 + lane) * 4;
      float a0 = src[col], a1 = src[col + 1], a2 = src[col + 2], a3 = src[col + 3];
      if (combine) {
        float s0 = 0.f, s1 = 0.f, s2 = 0.f, s3 = 0.f;
        for (int e = 0; e < NEXP_; ++e) {
          const int slot = p.inv[(size_t)row * NEXP_ + e];
          if (slot >= 0) { const bf16_t* yr = p.ye + (size_t)slot * D_ + col; s0 += bf2f(yr[0]); s1 += bf2f(yr[1]); s2 += bf2f(yr[2]); s3 += bf2f(yr[3]); }
        }
        const float* ga2 = p.modv + ((size_t)lprev * (B_ + 1) + mi) * 6 * D_ + 5 * D_ + col;
        a0 += ga2[0] * s0; a1 += ga2[1] * s1; a2 += ga2[2] * s2; a3 += ga2[3] * s3;
      }
      v[i * 4 + 0] = a0; v[i * 4 + 1] = a1; v[i * 4 + 2] = a2; v[i * 4 + 3] = a3;
      ss += a0 * a0 + a1 * a1 + a2 * a2 + a3 * a3;
      if (combine || (MODE == 0 && l == 0)) { xrow[col] = a0; xrow[col + 1] = a1; xrow[col + 2] = a2; xrow[col + 3] = a3; }
    }
    if (MODE == 2) continue;
    ss = wave_sum(ss);
    const float rstd = rsqrtf(ss / (float)D_ + 1e-6f);
    const float* g = (MODE == 0 ? p.g_norm1 : p.g_norm2) + (size_t)l * D_;
    const float* mv = p.modv + ((size_t)l * (B_ + 1) + mi) * 6 * D_ + (MODE == 0 ? 0 : 3 * D_);
    float lg[NEXP_];
#pragma unroll
    for (int e = 0; e < NEXP_; ++e) lg[e] = 0.f;
#pragma unroll
    for (int i = 0; i < D_ / 256; ++i) {
      const int col = (i * 64 + lane) * 4;
#pragma unroll
      for (int j = 0; j < 4; ++j) {
        const float hv = v[i * 4 + j] * rstd * g[col + j] * (1.0f + mv[D_ + col + j]) + mv[col + j];
        p.h[(size_t)row * D_ + col + j] = f2bf(hv);
        if (MODE == 1) {
          const float* wr = p.w_router + ((size_t)l * D_ + col + j) * NEXP_;
#pragma unroll
          for (int e = 0; e < NEXP_; ++e) lg[e] += hv * wr[e];
        }
      }
    }
    if (MODE == 1) {
      float mx = -1e30f;
#pragma unroll
      for (int e = 0; e < NEXP_; ++e) { lg[e] = wave_sum(lg[e]) + p.b_router[l * NEXP_ + e]; mx = fmaxf(mx, lg[e]); }
      float sum = 0.f;
#pragma unroll
      for (int e = 0; e < NEXP_; ++e) { lg[e] = expf(lg[e] - mx); sum += lg[e]; }
      const float is = 1.0f / sum;
      if (lane == 0) {
#pragma unroll
        for (int e = 0; e < NEXP_; ++e) p.aff[(size_t)row * NEXP_ + e] = lg[e] * is;
      }
    }
  }
}

struct GemmDesc { const bf16_t* A; int lda; const int* amap; const float* W; const float* W2; int ldw; int M, N, K; };
template <bool DUAL, class Epi> __device__ __forceinline__ void gemm_tile_f32(const GemmDesc& g, int tm, int tn, const Epi& epi) {
  __shared__ float As[16][132];
  __shared__ float Bs[16][64];
  __shared__ float Bs2[DUAL ? 16 : 1][64];
  const int tid = otid(), ty = tid >> 4, tx = tid & 15;
  float acc[4][4], acc2[4][4];
#pragma unroll
  for (int i = 0; i < 4; ++i)
#pragma unroll
    for (int j = 0; j < 4; ++j) { acc[i][j] = 0.f; acc2[i][j] = 0.f; }
  const int ar = tid >> 2, ak = (tid & 3) * 4;
  int arow = tm * 128 + ar; if (arow >= g.M) arow = g.M - 1;
  const size_t asrc = (size_t)(g.amap ? g.amap[arow] : arow) * g.lda;
  const int bk = tid >> 5, bn = (tid & 31) * 2;
  for (int k0 = 0; k0 < g.K; k0 += 16) {
    __syncthreads();
#pragma unroll
    for (int j = 0; j < 4; ++j) As[ak + j][ar] = bf2f(g.A[asrc + k0 + ak + j]);
#pragma unroll
    for (int j = 0; j < 2; ++j) {
      const int n = tn * 64 + bn + j;
      Bs[bk][bn + j] = n < g.N ? g.W[(size_t)(k0 + bk) * g.ldw + n] : 0.f;
      if (DUAL) Bs2[bk][bn + j] = n < g.N ? g.W2[(size_t)(k0 + bk) * g.ldw + n] : 0.f;
    }
    __syncthreads();
#pragma unroll
    for (int kk = 0; kk < 16; ++kk) {
      float a[4], b[4], b2[4];
#pragma unroll
      for (int i = 0; i < 4; ++i) a[i] = As[kk][ty * 4 + i];
#pragma unroll
      for (int j = 0; j < 4; ++j) { b[j] = Bs[kk][tx * 4 + j]; if (DUAL) b2[j] = Bs2[kk][tx * 4 + j]; }
#pragma unroll
      for (int i = 0; i < 4; ++i)
#pragma unroll
        for (int j = 0; j < 4; ++j) { acc[i][j] += a[i] * b[j]; if (DUAL) acc2[i][j] += a[i] * b2[j]; }
    }
  }
#pragma unroll
  for (int i = 0; i < 4; ++i) {
    const int m = tm * 128 + ty * 4 + i;
    if (m >= g.M) continue;
#pragma unroll
    for (int j = 0; j < 4; ++j) { const int n = tn * 64 + tx * 4 + j; if (n < g.N) epi(m, n, acc[i][j], acc2[i][j]); }
  }
}

struct EpiZ { bf16_t* z; __device__ void operator()(int m, int n, float a, float) const { z[(size_t)m * ZLD_ + n] = f2bf(a); } };
struct EpiOut { const float* modv; float* out; float* xc; int l; __device__ void operator()(int m, int n, float a, float) const {
    const int mi = row_modidx(m); const float ga1 = modv[((size_t)l * (B_ + 1) + mi) * 6 * D_ + 2 * D_ + n];
    float* xr = m < NTOK_ ? out + (size_t)m * D_ : xc + (size_t)(m - NTOK_) * D_; xr[n] += ga1 * a; } };
struct EpiHid { bf16_t* hid; int row0; __device__ void operator()(int m, int n, float a, float b) const { hid[(size_t)(row0 + m) * D_ + n] = f2bf(siluf_(a) * b); } };
struct EpiYe { bf16_t* ye; const float* gate; int row0; __device__ void operator()(int m, int n, float a, float) const { ye[(size_t)(row0 + m) * D_ + n] = f2bf(a * gate[row0 + m]); } };

__device__ __forceinline__ void phase_gemm_in(const Params& p, int l) {
  GemmDesc g; g.A = p.h; g.lda = D_; g.amap = nullptr; g.W = p.w_in + (size_t)l * D_ * INCOLS_; g.W2 = nullptr; g.ldw = INCOLS_; g.M = NROWS_; g.N = INCOLS_; g.K = D_;
  EpiZ epi{p.z};
  const int ntm = (NROWS_ + 127) / 128, ntn = (INCOLS_ + 63) / 64;
  for (int u = obid(); u < ntm * ntn; u += gridDim.x) gemm_tile_f32<false>(g, u / ntn, u % ntn, epi);
}
__device__ __forceinline__ void phase_gemm_out(const Params& p, int l) {
  const bool last = (l == DEPTH_ - 1);
  GemmDesc g; g.A = p.y; g.lda = D_; g.amap = nullptr; g.W = p.w_out + (size_t)l * D_ * D_; g.W2 = nullptr; g.ldw = D_; g.M = last ? NTOK_ : NROWS_; g.N = D_; g.K = D_;
  EpiOut epi{p.modv, p.out, p.xc, l};
  const int ntm = (g.M + 127) / 128, ntn = D_ / 64;
  for (int u = obid(); u < ntm * ntn; u += gridDim.x) gemm_tile_f32<false>(g, u / ntn, u % ntn, epi);
}
__device__ __forceinline__ int slot_expert(int slotrow) { return slotrow < XSLOTS_ ? (slotrow / CAP_) % NEXP_ : (slotrow - XSLOTS_) / (B_ * CAPC_); }
__device__ __forceinline__ void phase_moe1(const Params& p, int l) {
  const bool last = (l == DEPTH_ - 1);
  const int M = last ? XSLOTS_ : XSLOTS_ + CSLOTS_;
  const int ntm = M / 128, ntn = D_ / 64;
  for (int u = obid(); u < ntm * ntn; u += gridDim.x) {
    const int tm = u / ntn, tn = u % ntn, e = slot_expert(tm * 128);
    GemmDesc g; g.A = p.h; g.lda = D_; g.amap = p.sel_idx + tm * 128; g.W = p.w_gate + ((size_t)l * NEXP_ + e) * D_ * D_; g.W2 = p.w_up + ((size_t)l * NEXP_ + e) * D_ * D_;
    g.ldw = D_; g.M = 128; g.N = D_; g.K = D_;
    EpiHid epi{p.hid, tm * 128};
    gemm_tile_f32<true>(g, 0, tn, epi);
  }
}
__device__ __forceinline__ void phase_moe2(const Params& p, int l) {
  const bool last = (l == DEPTH_ - 1);
  const int M = last ? XSLOTS_ : XSLOTS_ + CSLOTS_;
  const int ntm = M / 128, ntn = D_ / 64;
  for (int u = obid(); u < ntm * ntn; u += gridDim.x) {
    const int tm = u / ntn, tn = u % ntn, e = slot_expert(tm * 128);
    GemmDesc g; g.A = p.hid + (size_t)tm * 128 * D_; g.lda = D_; g.amap = nullptr; g.W = p.w_down + ((size_t)l * NEXP_ + e) * D_ * D_; g.W2 = nullptr;
    g.ldw = D_; g.M = 128; g.N = D_; g.K = D_;
    EpiYe epi{p.ye, p.sel_gate, tm * 128};
    gemm_tile_f32<false>(g, 0, tn, epi);
  }
}

__device__ __forceinline__ void phase_prep(const Params& p, int l) {
  __shared__ float sm[NWAVE][COLS_RWKV_ + 64];
  const int tid = otid(), wave = tid >> 6, lane = tid & 63;
  float* ws = sm[wave];
  const bool last = (l == DEPTH_ - 1);
  for (int row = obid() * NWAVE + wave; row < NROWS_; row += gridDim.x * NWAVE) {
    const bool isx = row < NTOK_;
    const int pos = row_pos(row), len = row_len(row), b = row_batch(row);
    const bf16_t* zr = p.z + (size_t)row * ZLD_;
    const bool hasp = pos > 0, hasn = pos < len - 1;
    const bf16_t* zp = zr - ZLD_; const bf16_t* zn = zr + ZLD_;
    const bool need_out = isx || !last;
    if (need_out) {
      const float* cw = p.conv_w + (size_t)l * 3 * GWID_;
      float t[GWID_ / 64]; float ss = 0.f;
#pragma unroll
      for (int i = 0; i < GWID_ / 64; ++i) {
        const int ch = i * 64 + lane;
        const float bv = bf2f(zr[ch]);
        const float u0 = bf2f(zr[GWID_ + ch]) * bf2f(zr[2 * GWID_ + ch]);
        const float up = hasp ? bf2f(zp[GWID_ + ch]) * bf2f(zp[2 * GWID_ + ch]) : 0.f;
        const float un = hasn ? bf2f(zn[GWID_ + ch]) * bf2f(zn[2 * GWID_ + ch]) : 0.f;
        const float yv = cw[ch] * up + cw[GWID_ + ch] * u0 + cw[2 * GWID_ + ch] * un;
        t[i] = bv * yv; ss += t[i] * t[i];
      }
      ss = wave_sum(ss);
      const float rstd = rsqrtf(ss / (float)GWID_ + 1e-6f);
#pragma unroll
      for (int i = 0; i < GWID_ / 64; ++i) { const int ch = i * 64 + lane; p.y[(size_t)row * D_ + ch] = f2bf(t[i] * rstd * p.g_out_conv[l * GWID_ + ch]); }
    }
    {
      const bf16_t* zm = zr + MLA0_;
      const int NF = ROPE_ / 4;
      const float* tab = p.tab_mla + (size_t)pos * 4 * NF;
      if (need_out) {
        for (int hh = 0; hh < NH_; ++hh) {
          float q0 = 0.f, q1 = 0.f;
          { const int e = lane; if (e < QK_) q0 = bf2f(e < HD_ ? zm[hh * HD_ + e] : zm[NH_ * HD_ + hh * ROPE_ + (e - HD_)]); }
          { const int e = lane + 64; if (e < QK_) q1 = bf2f(e < HD_ ? zm[hh * HD_ + e] : zm[NH_ * HD_ + hh * ROPE_ + (e - HD_)]); }
          const float ss = wave_sum(q0 * q0 + q1 * q1);
          const float rstd = rsqrtf(ss / (float)QK_ + 1e-6f);
          if (lane < QK_) ws[lane] = q0 * rstd * p.g_q_norm[l * QK_ + lane];
          if (lane + 64 < QK_) ws[lane + 64] = q1 * rstd * p.g_q_norm[l * QK_ + lane + 64];
          __builtin_amdgcn_wave_barrier();
          const float scale = 1.0f / sqrtf((float)QK_);
          for (int e = lane; e < QK_; e += 64) {
            float v = ws[e];
            if (isx && e >= HD_) {
              const int r = e - HD_; const int ax = r / (ROPE_ / 2), ri = r % (ROPE_ / 2); const int half = ri / NF, fi = ri % NF;
              const float cs = tab[(ax * 2 + 0) * NF + fi], sn = tab[(ax * 2 + 1) * NF + fi];
              const int base = HD_ + ax * (ROPE_ / 2);
              const float t1 = ws[base + fi], t2 = ws[base + NF + fi];
              v = half == 0 ? t1 * cs - t2 * sn : t1 * sn + t2 * cs;
            }
            p.qb[((size_t)row * NH_ + hh) * QK_ + e] = f2bf(v * scale);
          }
          __builtin_amdgcn_wave_barrier();
        }
      }
      float cs2 = 0.f;
      for (int e = lane; e < KVR_; e += 64) { const float v = bf2f(zm[NH_ * QK_ + e]); cs2 += v * v; }
      cs2 = wave_sum(cs2);
      const float crstd = rsqrtf(cs2 / (float)KVR_ + 1e-6f);
      for (int e = lane; e < KVR_; e += 64) ws[e] = bf2f(zm[NH_ * QK_ + e]) * crstd * p.g_kv_norm[l * KVR_ + e];
      __builtin_amdgcn_wave_barrier();
      float kn[GWID_ / 64], vv[GWID_ / 64];
#pragma unroll
      for (int i = 0; i < GWID_ / 64; ++i) { kn[i] = 0.f; vv[i] = 0.f; }
      const float* wuk = p.w_uk + (size_t)l * KVR_ * GWID_; const float* wuv = p.w_uv + (size_t)l * KVR_ * GWID_;
#pragma unroll 4
      for (int k = 0; k < KVR_; ++k) {
        const float cv = ws[k];
#pragma unroll
        for (int i = 0; i < GWID_ / 64; ++i) { kn[i] += cv * wuk[k * GWID_ + i * 64 + lane]; vv[i] += cv * wuv[k * GWID_ + i * 64 + lane]; }
      }
      __builtin_amdgcn_wave_barrier();
      const int kpos = isx ? LC_ + pos : pos;
#pragma unroll
      for (int i = 0; i < GWID_ / 64; ++i) {
        const int cidx = i * 64 + lane, hh = cidx / HD_, e = cidx % HD_;
        p.vb[(((size_t)b * NH_ + hh) * LK_ + kpos) * HD_ + e] = f2bf(vv[i]);
        ws[64 + cidx] = kn[i];
      }
      for (int e = lane; e < ROPE_; e += 64) ws[64 + GWID_ + e] = bf2f(zm[NH_ * QK_ + KVR_ + e]);
      __builtin_amdgcn_wave_barrier();
      float kr2 = 0.f;
      for (int e = lane; e < ROPE_; e += 64) { const float v = ws[64 + GWID_ + e]; kr2 += v * v; }
      kr2 = wave_sum(kr2);
      for (int hh = 0; hh < NH_; ++hh) {
        float s2 = 0.f;
        for (int e = lane; e < HD_; e += 64) { const float v = ws[64 + hh * HD_ + e]; s2 += v * v; }
        s2 = wave_sum(s2) + kr2;
        const float rstd = rsqrtf(s2 / (float)QK_ + 1e-6f);
        for (int e = lane; e < QK_; e += 64) {
          float v;
          if (e < HD_) v = ws[64 + hh * HD_ + e] * rstd * p.g_k_norm[l * QK_ + e];
          else {
            const int r = e - HD_;
            if (!isx) v = ws[64 + GWID_ + r] * rstd * p.g_k_norm[l * QK_ + e];
            else {
              const int ax = r / (ROPE_ / 2), ri = r % (ROPE_ / 2); const int half = ri / NF, fi = ri % NF;
              const float cs = tab[(ax * 2 + 0) * NF + fi], sn = tab[(ax * 2 + 1) * NF + fi];
              const int i1 = ax * (ROPE_ / 2) + fi, i2 = i1 + NF;
              const float t1 = ws[64 + GWID_ + i1] * rstd * p.g_k_norm[l * QK_ + HD_ + i1], t2 = ws[64 + GWID_ + i2] * rstd * p.g_k_norm[l * QK_ + HD_ + i2];
              v = half == 0 ? t1 * cs - t2 * sn : t1 * sn + t2 * cs;
            }
          }
          p.kb[(((size_t)b * NH_ + hh) * LK_ + kpos) * QK_ + e] = f2bf(v);
        }
      }
      __builtin_amdgcn_wave_barrier();
    }
    {
      const bf16_t* zw = zr + RW0_; const bf16_t* zwp = zp + RW0_; const bf16_t* zwn = zn + RW0_;
      const float* mu = p.rwkv_mu + (size_t)l * COLS_RWKV_;
      for (int e = lane; e < COLS_RWKV_; e += 64) {
        const float zc = bf2f(zw[e]); const float pv = hasp ? bf2f(zwp[e]) : 0.f; const float nv = hasn ? bf2f(zwn[e]) : 0.f;
        ws[e] = zc + mu[e] * (0.5f * (pv + nv) - zc);
      }
      __builtin_amdgcn_wave_barrier();
      for (int j = lane; j < DLORA_; j += 64) ws[3 * GWID_ + j] = tanhf(ws[3 * GWID_ + j]);
      for (int j = lane; j < GLORA_; j += 64) ws[3 * GWID_ + DLORA_ + ALORA_ + j] = sigmoidf_(ws[3 * GWID_ + DLORA_ + ALORA_ + j]);
      __builtin_amdgcn_wave_barrier();
      const float* zs = ws;
      const float* w2 = p.rwkv_w2 + (size_t)l * 2 * DLORA_ * GWID_; const float* a2 = p.rwkv_a2 + (size_t)l * 2 * ALORA_ * GWID_; const float* g2 = p.rwkv_g2 + (size_t)l * GLORA_ * GWID_;
      float bon[GWID_ / 64];
#pragma unroll
      for (int i = 0; i < GWID_ / 64; ++i) {
        const int ch = i * 64 + lane;
        const float rr = zs[ch], kk0 = zs[GWID_ + ch], vvv = zs[2 * GWID_ + ch];
        const float kkr = kk0 * p.rwkv_k_k[l * GWID_ + ch];
        float s2 = kkr * kkr;
        for (int m = 1; m < HD_ && m < 64; m <<= 1) s2 += __shfl_xor(s2, m);
        const float kkn = kkr * rsqrtf(s2 + 1e-12f);
        float gacc = 0.f;
#pragma unroll 4
        for (int j = 0; j < GLORA_; ++j) gacc += zs[3 * GWID_ + DLORA_ + ALORA_ + j] * g2[j * GWID_ + ch];
        float ksum = 0.f;
#pragma unroll 1
        for (int d = 0; d < 2; ++d) {
          float lw = p.rwkv_w0[(l * 2 + d) * GWID_ + ch], la = p.rwkv_a0[(l * 2 + d) * GWID_ + ch];
#pragma unroll 4
          for (int j = 0; j < DLORA_; ++j) lw += zs[3 * GWID_ + j] * w2[(d * DLORA_ + j) * GWID_ + ch];
#pragma unroll 4
          for (int j = 0; j < ALORA_; ++j) la += zs[3 * GWID_ + DLORA_ + j] * a2[(d * ALORA_ + j) * GWID_ + ch];
          const float sp = (-lw > 20.f) ? -lw : log1pf(expf(-lw));
          const float wdec = expf(-expf(-sp - 0.5f));
          const float a = sigmoidf_(la);
          const float kt = kk0 * (1.0f + (a - 1.0f) * p.rwkv_k_a[l * GWID_ + ch]);
          const size_t o = ((size_t)d * NROWS_ + row) * GWID_ + ch;
          p.sc_w[o] = wdec; p.sc_kka[o] = kkn * a; p.sc_kt[o] = kt; ksum += kt;
        }
        const size_t o = (size_t)row * GWID_ + ch;
        p.sc_r[o] = rr; p.sc_v[o] = vvv; p.sc_kk[o] = kkn; p.sc_gate[o] = gacc;
        float bs = rr * ksum * p.rwkv_r_k[l * GWID_ + ch];
        for (int m = 1; m < HD_ && m < 64; m <<= 1) bs += __shfl_xor(bs, m);
        bon[i] = bs;
      }
#pragma unroll
      for (int i = 0; i < GWID_ / 64; ++i) {
        const int ch = i * 64 + lane;
        if ((ch % HD_) == 0) p.sc_bonus[(size_t)row * NH_ + ch / HD_] = bon[i];
      }
      __builtin_amdgcn_wave_barrier();
    }
    {
      const bf16_t* zt = zr + RT0_;
      const int NR = HD_ / 2;
      const float* tab = p.tab_ret + (size_t)pos * 2 * NR;
      const float qs = 1.0f / sqrtf((float)HD_);
#pragma unroll
      for (int i = 0; i < GWID_ / 64; ++i) {
        const int ch = i * 64 + lane, hh = ch / HD_, e = ch % HD_;
        float q = bf2f(zt[ch]) * qs, k = bf2f(zt[GWID_ + ch]);
        if (isx) {
          const int fi = e % NR; const int half = e / NR;
          const int c1 = hh * HD_ + fi, c2 = c1 + NR;
          const float q1 = bf2f(zt[c1]) * qs, q2 = bf2f(zt[c2]) * qs, k1 = bf2f(zt[GWID_ + c1]), k2 = bf2f(zt[GWID_ + c2]);
          const float cs = tab[fi], sn = tab[NR + fi];
          q = half == 0 ? q1 * cs - q2 * sn : q1 * sn + q2 * cs;
          k = half == 0 ? k1 * cs - k2 * sn : k1 * sn + k2 * cs;
        }
        p.rq[(size_t)row * GWID_ + ch] = f2bf(q); p.rk[(size_t)row * GWID_ + ch] = f2bf(k); p.rv[(size_t)row * GWID_ + ch] = zt[2 * GWID_ + ch];
      }
    }
  }
}

__device__ __forceinline__ int chunk_row0(int b, int n) { return n < NCC_ ? NTOK_ + b * LC_ + n * RCH_ : b * L_ + (n - NCC_) * RCH_; }
__device__ __forceinline__ float ret_lg(int hh) { return log1pf(-exp2f(-5.0f - (float)hh)); }

__device__ __forceinline__ void phase_retd(const Params& p, int l) {
  const int tid = otid();
  const int nunits = B_ * NH_ * NCH_ * 2;
  for (int u = obid(); u < nunits; u += gridDim.x) {
    const int d = u & 1, n = (u >> 1) % NCH_, hh = ((u >> 1) / NCH_) % NH_, b = (u >> 1) / (NCH_ * NH_);
    const int r0 = chunk_row0(b, n);
    const float lg = ret_lg(hh);
    float* o = p.rd + ((((size_t)b * NH_ + hh) * NCH_ + n) * 2 + d) * HD_ * HD_;
    for (int e = tid; e < HD_ * HD_; e += NT) {
      const int kc = e / HD_, vc = e % HD_;
      float acc = 0.f;
      for (int c = 0; c < RCH_; ++c) {
        const float zeta = expf((d == 0 ? (float)(RCH_ - 1 - c) : (float)c) * lg);
        acc += zeta * bf2f(p.rk[(size_t)(r0 + c) * GWID_ + hh * HD_ + kc]) * bf2f(p.rv[(size_t)(r0 + c) * GWID_ + hh * HD_ + vc]);
      }
      o[e] = acc;
    }
  }
}

__device__ __forceinline__ void phase_mix(const Params& p, int l) {
  const int tid = otid(), wave = tid >> 6, lane = tid & 63;
  const bool last = (l == DEPTH_ - 1);
  for (int u = obid(); u < B_ * NH_ * 2; u += gridDim.x) {
    const int d = u & 1, hh = (u >> 1) % NH_, b = (u >> 1) / NH_;
    const float dec = expf((float)RCH_ * ret_lg(hh));
    for (int e = tid; e < HD_ * HD_; e += NT) {
      float st = 0.f;
      for (int i = 0; i < NCH_; ++i) {
        int n;
        if (d == 0) n = i; else n = i < NCC_ ? (NCC_ - 1 - i) : (NCC_ + (NCH_ - 1 - i));
        const size_t o = ((((size_t)b * NH_ + hh) * NCH_ + n) * 2 + d) * HD_ * HD_ + e;
        p.rs[o] = st;
        st = st * dec + p.rd[o];
      }
    }
  }
  for (int u = obid() * NWAVE + wave; u < B_ * NH_ * 2; u += gridDim.x * NWAVE) {
    const int d = u & 1, hh = (u >> 1) % NH_, b = (u >> 1) / NH_;
    float s[HD_];
#pragma unroll
    for (int k = 0; k < HD_; ++k) s[k] = 0.f;
    const int vr = lane % HD_;
    for (int i = 0; i < LK_; ++i) {
      int row;
      if (d == 0) row = i < LC_ ? NTOK_ + b * LC_ + i : b * L_ + (i - LC_);
      else row = i < LC_ ? NTOK_ + b * LC_ + (LC_ - 1 - i) : b * L_ + (L_ - 1 - (i - LC_));
      const size_t o1 = (size_t)row * GWID_ + hh * HD_, o2 = ((size_t)d * NROWS_ + row) * GWID_ + hh * HD_;
      const float vt = p.sc_v[o1 + vr];
      float sa = 0.f;
#pragma unroll
      for (int k = 0; k < HD_; ++k) sa += s[k] * p.sc_kk[o1 + k];
      float yv = 0.f;
#pragma unroll
      for (int k = 0; k < HD_; ++k) { s[k] = s[k] * p.sc_w[o2 + k] - sa * p.sc_kka[o2 + k] + vt * p.sc_kt[o2 + k]; yv += s[k] * p.sc_r[o1 + k]; }
      if (lane < HD_) p.ys[o2 + vr] = yv;
    }
  }
  {
    const int nq = last ? NTOK_ : NROWS_;
    for (int idx = obid() * NT + tid; idx < ((nq + NT - 1) / NT) * NT * NH_; idx += gridDim.x * NT) {
      const int blk = idx / (NT * NH_), rem = idx % (NT * NH_), hh = rem / NT, row = blk * NT + rem % NT;
      if (row >= nq) continue;
      const bool isx = row < NTOK_; const int b = row_batch(row);
      const int nk = isx ? LK_ : LC_;
      unsigned q[QK_ / 2]; float o[HD_];
      { const unsigned* qp = (const unsigned*)(p.qb + ((size_t)row * NH_ + hh) * QK_);
#pragma unroll
        for (int e = 0; e < QK_ / 2; ++e) q[e] = qp[e]; }
#pragma unroll
      for (int e = 0; e < HD_; ++e) o[e] = 0.f;
      float m = -1e30f, lsum = 0.f;
      const bf16_t* kbase = p.kb + ((size_t)b * NH_ + hh) * LK_ * QK_; const bf16_t* vbase = p.vb + ((size_t)b * NH_ + hh) * LK_ * HD_;
      for (int j = 0; j < nk; ++j) {
        float sdot = 0.f;
        const unsigned* kp = (const unsigned*)(kbase + (size_t)j * QK_);
#pragma unroll
        for (int e = 0; e < QK_ / 2; ++e) { const unsigned kq = kp[e], qq = q[e];
          union { unsigned u; float f; } a0, a1, b0, b1; a0.u = qq << 16; a1.u = qq & 0xFFFF0000u; b0.u = kq << 16; b1.u = kq & 0xFFFF0000u;
          sdot += a0.f * b0.f + a1.f * b1.f; }
        if (sdot > m) { const float corr = expf(m - sdot); lsum *= corr;
#pragma unroll
          for (int e = 0; e < HD_; ++e) o[e] *= corr;
          m = sdot; }
        const float pj = expf(sdot - m); lsum += pj;
#pragma unroll
        for (int e = 0; e < HD_; ++e) o[e] += pj * bf2f(vbase[(size_t)j * HD_ + e]);
      }
      const float il = 1.0f / lsum;
#pragma unroll
      for (int e = 0; e < HD_; ++e) p.ob[(size_t)row * GWID_ + hh * HD_ + e] = o[e] * il;
    }
  }
}

__device__ __forceinline__ void phase_post(const Params& p, int l) {
  __shared__ float sm[NWAVE][RCH_ + 2 * HD_];
  const int tid = otid(), wave = tid >> 6, lane = tid & 63;
  float* ws = sm[wave];
  const bool last = (l == DEPTH_ - 1);
  const int nrow = last ? NTOK_ : NROWS_;
  for (int row = obid() * NWAVE + wave; row < nrow; row += gridDim.x * NWAVE) {
    const int pos = row_pos(row), b = row_batch(row); const bool isx = row < NTOK_;
    {
      float t[GWID_ / 64]; float ss = 0.f;
#pragma unroll
      for (int i = 0; i < GWID_ / 64; ++i) { t[i] = p.ob[(size_t)row * GWID_ + i * 64 + lane]; ss += t[i] * t[i]; }
      ss = wave_sum(ss); const float rstd = rsqrtf(ss / (float)GWID_ + 1e-6f);
#pragma unroll
      for (int i = 0; i < GWID_ / 64; ++i) p.y[(size_t)row * D_ + GWID_ + i * 64 + lane] = f2bf(t[i] * rstd * p.g_out_mla[l * GWID_ + i * 64 + lane]);
    }
    {
#pragma unroll
      for (int i = 0; i < GWID_ / 64; ++i) {
        const int ch = i * 64 + lane; const size_t o = (size_t)row * GWID_ + ch;
        const float yv = p.ys[o] + p.ys[(size_t)NROWS_ * GWID_ + o];
        float s1 = yv;
        for (int m = 1; m < HD_ && m < 64; m <<= 1) s1 += __shfl_xor(s1, m);
        const float mean = s1 / (float)HD_;
        const float dv = yv - mean; float s2 = dv * dv;
        for (int m = 1; m < HD_ && m < 64; m <<= 1) s2 += __shfl_xor(s2, m);
        const float var = s2 / (float)HD_;
        float r = dv * rsqrtf(var + 64e-5f) * p.g_ln_x[l * GWID_ + ch];
        r += p.sc_bonus[(size_t)row * NH_ + ch / HD_] * p.sc_v[o];
        p.y[(size_t)row * D_ + 2 * GWID_ + ch] = f2bf(r * p.sc_gate[o]);
      }
    }
    {
      const int n = isx ? NCC_ + pos / RCH_ : pos / RCH_, c = pos % RCH_;
      const int r0 = chunk_row0(b, n);
      for (int hh = 0; hh < NH_; ++hh) {
        const float lg = ret_lg(hh);
        for (int j = lane; j < RCH_; j += 64) {
          float sdot = 0.f;
          for (int e = 0; e < HD_; ++e) sdot += bf2f(p.rq[(size_t)row * GWID_ + hh * HD_ + e]) * bf2f(p.rk[(size_t)(r0 + j) * GWID_ + hh * HD_ + e]);
          const int dist = c > j ? c - j : j - c;
          ws[j] = sdot * expf((float)dist * lg);
        }
        for (int e = lane; e < HD_; e += 64) ws[RCH_ + e] = bf2f(p.rq[(size_t)row * GWID_ + hh * HD_ + e]);
        __builtin_amdgcn_wave_barrier();
        float yv = 0.f;
        const int vc = lane % HD_;
        for (int j = 0; j < RCH_; ++j) yv += ws[j] * bf2f(p.rv[(size_t)(r0 + j) * GWID_ + hh * HD_ + vc]);
        const float xf = expf((float)(c + 1) * lg), xb = expf((float)(RCH_ - c) * lg);
        const float* sf = p.rs + ((((size_t)b * NH_ + hh) * NCH_ + n) * 2 + 0) * HD_ * HD_;
        const float* sb = sf + HD_ * HD_;
        float cf = 0.f, cb = 0.f;
        for (int k = 0; k < HD_; ++k) { const float qk = ws[RCH_ + k]; cf += qk * sf[k * HD_ + vc]; cb += qk * sb[k * HD_ + vc]; }
        yv += xf * cf + xb * cb;
        float s2 = yv * yv;
        for (int m = 1; m < HD_ && m < 64; m <<= 1) s2 += __shfl_xor(s2, m);
        const float rstd = rsqrtf(s2 / (float)HD_ + 1e-6f);
        const int ch = hh * HD_ + vc;
        const float g = bf2f(p.z[(size_t)row * ZLD_ + RT0_ + 3 * GWID_ + ch]);
        if (lane < HD_) p.y[(size_t)row * D_ + 3 * GWID_ + ch] = f2bf(siluf_(g) * yv * rstd * p.g_ret_norm[l * GWID_ + ch]);
        __builtin_amdgcn_wave_barrier();
      }
    }
  }
}

__device__ __forceinline__ void phase_topk(const Params& p, int l) {
  __shared__ unsigned vals[L_ > LC_ ? L_ : LC_];
  __shared__ int hist[256];
  __shared__ int scan_gt[NT + 1], scan_eq[NT + 1];
  __shared__ unsigned s_prefix; __shared__ int s_need;
  const int tid = otid();
  const bool last = (l == DEPTH_ - 1);
  const int nunits = (last ? B_ : 2 * B_) * NEXP_;
  for (int u = obid(); u < nunits; u += gridDim.x) {
    const int e = u % NEXP_, set = u / NEXP_; const bool isx = set < B_; const int b = isx ? set : set - B_;
    const int N = isx ? L_ : LC_, cap = isx ? CAP_ : CAPC_;
    const int row0 = isx ? b * L_ : NTOK_ + b * LC_;
    __syncthreads();
    for (int i = tid; i < N; i += NT) { union { float f; unsigned u; } x; x.f = p.aff[(size_t)(row0 + i) * NEXP_ + e]; vals[i] = x.u; }
    if (tid == 0) { s_prefix = 0u; s_need = cap; }
    __syncthreads();
    for (int pass = 0; pass < 4; ++pass) {
      const int shift = 24 - 8 * pass;
      for (int i = tid; i < 256; i += NT) hist[i] = 0;
      __syncthreads();
      const unsigned prefix = s_prefix; const unsigned himask = pass == 0 ? 0u : (0xFFFFFFFFu << (shift + 8));
      for (int i = tid; i < N; i += NT) { const unsigned v = vals[i]; if ((v & himask) == prefix) atomicAdd(&hist[(v >> shift) & 255], 1); }
      __syncthreads();
      if (tid == 0) {
        int need = s_need, bin = 255;
        for (; bin > 0; --bin) { if (hist[bin] >= need) break; need -= hist[bin]; }
        s_prefix = prefix | ((unsigned)bin << shift); s_need = need;
      }
      __syncthreads();
    }
    const unsigned T = s_prefix; const int need_eq = s_need;
    const int per = (N + NT - 1) / NT;
    int cg = 0, ce = 0;
    for (int j = 0; j < per; ++j) { const int i = tid * per + j; if (i < N) { const unsigned v = vals[i]; cg += v > T; ce += v == T; } }
    scan_gt[tid + 1] = cg; scan_eq[tid + 1] = ce;
    __syncthreads();
    if (tid == 0) { scan_gt[0] = 0; scan_eq[0] = 0; for (int i = 1; i <= NT; ++i) { scan_gt[i] += scan_gt[i - 1]; scan_eq[i] += scan_eq[i - 1]; } }
    __syncthreads();
    int rg = scan_gt[tid], re = scan_eq[tid];
    const int slot0 = isx ? (b * NEXP_ + e) * CAP_ : XSLOTS_ + (e * B_ + b) * CAPC_;
    for (int j = 0; j < per; ++j) {
      const int i = tid * per + j; if (i >= N) break;
      const unsigned v = vals[i];
      int slot = -1;
      if (v > T) { slot = rg + (re < need_eq ? re : need_eq); ++rg; }
      else if (v == T) { if (re < need_eq) slot = rg + re; ++re; }
      if (slot >= 0) { union { float f; unsigned u; } x; x.u = v; p.sel_idx[slot0 + slot] = row0 + i; p.sel_gate[slot0 + slot] = x.f; }
      p.inv[(size_t)(row0 + i) * NEXP_ + e] = slot >= 0 ? slot0 + slot : -1;
    }
  }
}

#ifndef CPU_EMU
#define XB_SPIN_CAP (1u << 24)
#endif
__device__ __forceinline__ void grid_sync(const Params& p) { (void)p; }

template <int PH> __device__ __forceinline__ void run_phase(const Params& p, int l) {
  if (PH == PH_MOD) phase_mod(p);
  if (PH == PH_NORM1) phase_norm<0>(p, l);
  if (PH == PH_GEMM_IN) phase_gemm_in(p, l);
  if (PH == PH_PREP) phase_prep(p, l);
  if (PH == PH_RETD) phase_retd(p, l);
  if (PH == PH_MIX) phase_mix(p, l);
  if (PH == PH_POST) phase_post(p, l);
  if (PH == PH_GEMM_OUT) phase_gemm_out(p, l);
  if (PH == PH_NORM2) phase_norm<1>(p, l);
  if (PH == PH_TOPK) phase_topk(p, l);
  if (PH == PH_MOE1) phase_moe1(p, l);
  if (PH == PH_MOE2) phase_moe2(p, l);
  if (PH == PH_FINAL) phase_norm<2>(p, l);
}
template <int PH> __global__ void __launch_bounds__(NT) k_phase(Params p, int l) { run_phase<PH>(p, l); }

#ifndef CPU_EMU
#define XB_TMO      128
#define XB_XCNT(j)  (256  + 64 * (j))
#define XB_XSUB(j)  (1280 + 64 * (j))
#define XB_XGEN(j)  (2304 + 64 * (j))
#define XB_TOP      3328
#define XB_TOPGEN   3392
#define XCD_BAR_WORDS 3456
#define XB_SPIN_CAP (1u << 23)
#define LAS __attribute__((address_space(3)))
__device__ __forceinline__ unsigned xb_ld(unsigned* p)              { return __hip_atomic_load(p, __ATOMIC_RELAXED, __HIP_MEMORY_SCOPE_AGENT); }
__device__ __forceinline__ unsigned xb_add(unsigned* p, unsigned v) { return __hip_atomic_fetch_add(p, v, __ATOMIC_RELAXED, __HIP_MEMORY_SCOPE_AGENT); }
__device__ __forceinline__ unsigned xb_xcc_id() { return (unsigned)__builtin_amdgcn_s_getreg((3 << 11) | 20) & 0xFu; }
#define XB_SPIN(cond, bar) do { unsigned _sp = 0; while (cond) { __builtin_amdgcn_s_sleep(1); \
    if ((++_sp & 255u) == 0u) { if (xb_ld(&(bar)[XB_TMO])) break; if (_sp > XB_SPIN_CAP) { atomicAdd(&(bar)[XB_TMO], 1u); break; } } } } while (0)
struct XcdBarrier { unsigned* bar; unsigned x; volatile LAS unsigned* st; };
__device__ __forceinline__ XcdBarrier xcd_barrier_post(unsigned* bar, volatile LAS unsigned* st) {
    XcdBarrier b; b.bar = bar; b.x = xb_xcc_id(); b.st = st;
    if (threadIdx.x == 0) (void)xb_add(&bar[XB_XCNT(b.x)], 1u);
    return b;
}
__device__ __forceinline__ void xcd_barrier_complete(unsigned* bar, unsigned x, unsigned& nloc, unsigned& nx) {
    const unsigned G = gridDim.x * gridDim.y * gridDim.z;
    unsigned sum, cnt, mine, sp = 0u;
    for (;;) {
        sum = 0u; cnt = 0u; mine = 0u;
#pragma unroll
        for (unsigned j = 0; j < 16; ++j) { const unsigned c = xb_ld(&bar[XB_XCNT(j)]); sum += c; cnt += (c > 0u) ? 1u : 0u; mine = (j == x) ? c : mine; }
        if (sum == G) break;
        __builtin_amdgcn_s_sleep(1);
        if ((++sp & 255u) == 0u) { if (xb_ld(&bar[XB_TMO])) break; if (sp > XB_SPIN_CAP) { atomicAdd(&bar[XB_TMO], 1u); break; } }
    }
    nloc = mine > 0u ? mine : 1u; nx = cnt > 0u ? cnt : 1u;
}
__device__ __forceinline__ void xcd_barrier(const XcdBarrier& b) {
    asm volatile("s_waitcnt vmcnt(0)" ::: "memory");
    __syncthreads();
    if (threadIdx.x == 0) {
        unsigned* bar = b.bar; unsigned bx = b.x;
        asm volatile("" : "+s"(bx));
        __builtin_amdgcn_s_waitcnt(0);
        unsigned nloc = b.st[0], nx = b.st[1];
        if (nloc == 0u) { xcd_barrier_complete(bar, bx, nloc, nx); b.st[0] = nloc; b.st[1] = nx; }
        const unsigned old = xb_add(&bar[XB_XSUB(bx)], 1u);
        const unsigned gen = old / nloc;
        if (old + 1u == (gen + 1u) * nloc) {
            __builtin_amdgcn_fence(__ATOMIC_RELEASE, "agent");
            asm volatile("s_waitcnt vmcnt(0)" ::: "memory");
            const unsigned og = xb_add(&bar[XB_TOP], 1u);
            const unsigned tg = og / nx;
            if (og + 1u == (tg + 1u) * nx) xb_add(&bar[XB_TOPGEN], 1u);
            else XB_SPIN(xb_ld(&bar[XB_TOPGEN]) == tg, bar);
            __builtin_amdgcn_fence(__ATOMIC_ACQUIRE, "agent");
            xb_add(&bar[XB_XGEN(bx)], 1u);
            asm volatile("s_waitcnt vmcnt(0)" ::: "memory");
        } else {
            XB_SPIN(xb_ld(&bar[XB_XGEN(bx)]) == gen, bar);
            __builtin_amdgcn_fence(__ATOMIC_ACQUIRE, "agent");
            asm volatile("s_waitcnt vmcnt(0)" ::: "memory");
        }
    }
    __syncthreads();
}
__global__ void __launch_bounds__(NT, 2) mega(Params p) {
  __shared__ uint4 xb_words;
  if (threadIdx.x == 0) xb_words = make_uint4(0u, 0u, 0u, 0u);
  __syncthreads();
  XcdBarrier bar = xcd_barrier_post(p.bar, (volatile LAS unsigned*)&xb_words);
  phase_mod(p);
  xcd_barrier(bar);
  for (int l = 0; l < DEPTH_; ++l) {
    phase_norm<0>(p, l); xcd_barrier(bar);
    phase_gemm_in(p, l); xcd_barrier(bar);
    phase_prep(p, l); xcd_barrier(bar);
    phase_retd(p, l); xcd_barrier(bar);
    phase_mix(p, l); xcd_barrier(bar);
    phase_post(p, l); xcd_barrier(bar);
    phase_gemm_out(p, l); xcd_barrier(bar);
    phase_norm<1>(p, l); xcd_barrier(bar);
    phase_topk(p, l); xcd_barrier(bar);
    phase_moe1(p, l); xcd_barrier(bar);
    phase_moe2(p, l); xcd_barrier(bar);
  }
  phase_norm<2>(p, DEPTH_ - 1);
}
#endif

#ifdef CPU_EMU
#define LAUNCH(PH, grid, p, l) emu_launch(dim3(grid), dim3(NT), 0, [=]() { k_phase<PH>(p, l); })
#else
#define LAUNCH(PH, grid, p, l) hipLaunchKernelGGL(k_phase<PH>, dim3(grid), dim3(NT), 0, stream, p, l)
#endif

static size_t align_up(size_t v) { return (v + 255) & ~(size_t)255; }

extern "C" void kernel_launch(void* const* d_in, const int* in_sizes, int n_in, void* d_out, int out_size, void* d_ws, size_t ws_size, hipStream_t stream) {
  (void)in_sizes; (void)n_in; (void)out_size; (void)ws_size;
  Params p;
  memset(&p, 0, sizeof(p));
  const float** ip = (const float**)&p.x;
  for (int i = 0; i < 34; ++i) ip[i] = (const float*)d_in[i];
  p.out = (float*)d_out;
  char* w = (char*)d_ws; size_t off = 0;
#define CARVE(field, type, count) do { p.field = (type*)(w + off); off = align_up(off + sizeof(type) * (size_t)(count)); } while (0)
  CARVE(bar, unsigned, 4096);
  CARVE(modv, float, (size_t)DEPTH_ * (B_ + 1) * 6 * D_);
  CARVE(xc, float, (size_t)NCTX_ * D_);
  CARVE(h, bf16_t, (size_t)NROWS_ * D_);
  CARVE(z, bf16_t, (size_t)NROWS_ * ZLD_);
  CARVE(y, bf16_t, (size_t)NROWS_ * D_);
  CARVE(qb, bf16_t, (size_t)NROWS_ * NH_ * QK_);
  CARVE(kb, bf16_t, (size_t)B_ * NH_ * LK_ * QK_);
  CARVE(vb, bf16_t, (size_t)B_ * NH_ * LK_ * HD_);
  CARVE(ob, float, (size_t)NROWS_ * GWID_);
  CARVE(sc_r, float, (size_t)NROWS_ * GWID_);
  CARVE(sc_v, float, (size_t)NROWS_ * GWID_);
  CARVE(sc_kk, float, (size_t)NROWS_ * GWID_);
  CARVE(sc_w, float, (size_t)2 * NROWS_ * GWID_);
  CARVE(sc_kka, float, (size_t)2 * NROWS_ * GWID_);
  CARVE(sc_kt, float, (size_t)2 * NROWS_ * GWID_);
  CARVE(sc_gate, float, (size_t)NROWS_ * GWID_);
  CARVE(sc_bonus, float, (size_t)NROWS_ * NH_);
  CARVE(ys, float, (size_t)2 * NROWS_ * GWID_);
  CARVE(rq, bf16_t, (size_t)NROWS_ * GWID_);
  CARVE(rk, bf16_t, (size_t)NROWS_ * GWID_);
  CARVE(rv, bf16_t, (size_t)NROWS_ * GWID_);
  CARVE(rd, float, (size_t)B_ * NH_ * NCH_ * 2 * HD_ * HD_);
  CARVE(rs, float, (size_t)B_ * NH_ * NCH_ * 2 * HD_ * HD_);
  CARVE(tab_mla, float, (size_t)L_ * ROPE_);
  CARVE(tab_ret, float, (size_t)L_ * HD_);
  CARVE(aff, float, (size_t)NROWS_ * NEXP_);
  CARVE(sel_idx, int, (size_t)XSLOTS_ + CSLOTS_);
  CARVE(sel_gate, float, (size_t)XSLOTS_ + CSLOTS_);
  CARVE(inv, int, (size_t)NROWS_ * NEXP_);
  p.hid = (bf16_t*)p.z;
  p.ye = (bf16_t*)p.sc_w;
#undef CARVE
#ifndef CPU_EMU
  {
    static int grid = 0;
    if (!grid) {
      int dev = 0, cus = 0, per_cu = 0;
      hipGetDevice(&dev);
      hipDeviceGetAttribute(&cus, hipDeviceAttributeMultiprocessorCount, dev);
      hipOccupancyMaxActiveBlocksPerMultiprocessor(&per_cu, mega, NT, 0);
      grid = cus * (per_cu < 1 ? per_cu : 1);
    }
    hipMemsetAsync(p.bar, 0, XCD_BAR_WORDS * sizeof(unsigned), stream);
    hipLaunchKernelGGL(mega, dim3(grid), dim3(NT), 0, stream, p);
    return;
  }
#else
  const int grid = 256;
  LAUNCH(PH_MOD, grid, p, 0);
  for (int l = 0; l < DEPTH_; ++l) {
    LAUNCH(PH_NORM1, grid, p, l);
    LAUNCH(PH_GEMM_IN, grid, p, l);
    LAUNCH(PH_PREP, grid, p, l);
    LAUNCH(PH_RETD, grid, p, l);
    LAUNCH(PH_MIX, grid, p, l);
    LAUNCH(PH_POST, grid, p, l);
    LAUNCH(PH_GEMM_OUT, grid, p, l);
    LAUNCH(PH_NORM2, grid, p, l);
    LAUNCH(PH_TOPK, grid, p, l);
    LAUNCH(PH_MOE1, grid, p, l);
    LAUNCH(PH_MOE2, grid, p, l);
    if (l == DEPTH_ - 1) LAUNCH(PH_FINAL, grid, p, l);
  }
#endif
}
```

```cpp
#include <hip/hip_runtime.h>
#include <stdint.h>
#include <math.h>
#include <string.h>

#ifdef SMALL_CFG
#define D_ 256
#define B_ 2
#define L_ 256
#define DEPTH_ 2
#define LC_ 128
#define GRIDW_ 64
#define HD_ 32
#define KVR_ 32
#define DLORA_ 16
#define ALORA_ 16
#define GLORA_ 32
#define NEXP_ 4
#else
#define D_ 1024
#define B_ 8
#define L_ 4096
#define DEPTH_ 4
#define LC_ 256
#define GRIDW_ 64
#define HD_ 64
#define KVR_ 128
#define DLORA_ 64
#define ALORA_ 64
#define GLORA_ 128
#define NEXP_ 16
#endif
#define CAPF_ 2
#define GWID_ (D_ / 4)
#define NH_ (GWID_ / HD_)
#define ROPE_ (HD_ / 2)
#define QK_ (HD_ + ROPE_)
#define NTOK_ (B_ * L_)
#define NCTX_ (B_ * LC_)
#define NROWS_ (NTOK_ + NCTX_)
#define LK_ (LC_ + L_)
#define COLS_MLA_ (NH_ * QK_ + KVR_ + ROPE_)
#define COLS_RWKV_ (3 * GWID_ + DLORA_ + ALORA_ + GLORA_)
#define MLA0_ (3 * GWID_)
#define RW0_ (MLA0_ + COLS_MLA_)
#define RT0_ (RW0_ + COLS_RWKV_)
#define INCOLS_ (RT0_ + 4 * GWID_)
#define ZLD_ (((INCOLS_ + 255) / 256) * 256)
#define CAP_ (CAPF_ * L_ / NEXP_)
#define CAPC_ (CAPF_ * LC_ / NEXP_)
#define XSLOTS_ (B_ * NEXP_ * CAP_)
#define CSLOTS_ (B_ * NEXP_ * CAPC_)
#define RCH_ 128
#define NCC_ (LC_ / RCH_)
#define NCX_ (L_ / RCH_)
#define NCH_ (NCC_ + NCX_)
#define KLD_ (((QK_ + 63) / 64) * 64)
#define NT 512
#define NWAVE (NT / 64)

typedef unsigned short bf16_t;

__device__ __forceinline__ float bf2f(bf16_t v) { union { unsigned u; float f; } x; x.u = ((unsigned)v) << 16; return x.f; }
__device__ __forceinline__ bf16_t f2bf(float f) { union { unsigned u; float f; } x; x.f = f; unsigned u = x.u; u += 0x7FFFu + ((u >> 16) & 1u); return (bf16_t)(u >> 16); }
__device__ __forceinline__ float wave_sum(float v) { for (int m = 32; m >= 1; m >>= 1) v += __shfl_xor(v, m); return v; }
__device__ __forceinline__ float wave_max(float v) { for (int m = 32; m >= 1; m >>= 1) v = fmaxf(v, __shfl_xor(v, m)); return v; }
__device__ __forceinline__ float sigmoidf_(float x) { return 1.0f / (1.0f + expf(-x)); }
__device__ __forceinline__ float siluf_(float x) { return x / (1.0f + expf(-x)); }


#ifdef CPU_EMU
__device__ __forceinline__ int otid() { return threadIdx.x; }
__device__ __forceinline__ int obid() { return blockIdx.x; }
#else
__device__ __forceinline__ int otid() { int t = threadIdx.x; asm volatile("" : "+v"(t)); return t; }
__device__ __forceinline__ int obid() { int b = blockIdx.x; asm volatile("" : "+s"(b)); return b; }
#endif

#define LDS_BYTES_ (132 * 1024)
#define XBW_OFF_ (128 * 1024)
#ifdef CPU_EMU
#define SMEM_PTR() ((unsigned char*)emu_dynshm())
#else
extern __shared__ __attribute__((aligned(16))) unsigned char smem_dyn[];
#define SMEM_PTR() (smem_dyn)
#endif
struct Params {
  const float *x, *c, *ctx, *c_ctx, *w_ada, *b_ada, *g_norm1, *g_norm2, *w_in, *w_out, *conv_w, *g_out_conv, *g_kv_norm, *w_uk, *w_uv,
      *g_q_norm, *g_k_norm, *g_out_mla, *rwkv_mu, *rwkv_w0, *rwkv_w2, *rwkv_a0, *rwkv_a2, *rwkv_g2, *rwkv_k_k, *rwkv_k_a, *rwkv_r_k, *g_ln_x,
      *g_ret_norm, *w_router, *b_router, *w_gate, *w_up, *w_down;
  float* out;
  unsigned* bar;
  float* modv;
  float* xc;
  bf16_t* h;
  bf16_t* z;
  bf16_t* y;
  bf16_t* qb;
  bf16_t* kb;
  bf16_t* vb;
  float* ob;
  float* sc_r;
  float* sc_v;
  float* sc_kk;
  float* sc_w;
  float* sc_kka;
  float* sc_kt;
  float* sc_gate;
  float* sc_bonus;
  float* ys;
  bf16_t* rq;
  bf16_t* rk;
  bf16_t* rv;
  float* rd;
  float* rs;
  float* tab_mla;
  float* tab_ret;
  float* aff;
  int* sel_idx;
  float* sel_gate;
  int* inv;
  bf16_t* hid;
  bf16_t* ye;
  bf16_t* wb_in;
  bf16_t* wb_out;
  bf16_t* wb_moe1;
  bf16_t* wb_moe2;
};

enum { PH_MOD = 0, PH_NORM1, PH_GEMM_IN, PH_PREP, PH_RETD, PH_MIX, PH_POST, PH_GEMM_OUT, PH_NORM2, PH_TOPK, PH_MOE1, PH_MOE2, PH_FINAL, PH_COUNT };

__device__ __forceinline__ int row_batch(int row) { return row < NTOK_ ? row / L_ : (row - NTOK_) / LC_; }
__device__ __forceinline__ int row_modidx(int row) { return row < NTOK_ ? row / L_ : B_; }
__device__ __forceinline__ int row_pos(int row) { return row < NTOK_ ? row % L_ : (row - NTOK_) % LC_; }
__device__ __forceinline__ int row_len(int row) { return row < NTOK_ ? L_ : LC_; }

__device__ __forceinline__ void phase_mod(const Params& p) {
  const int tid = otid();
  for (int idx = obid() * NT + tid; idx < DEPTH_ * 6 * D_; idx += gridDim.x * NT) {
    const int l = idx / (6 * D_), col = idx % (6 * D_);
    float acc[B_ + 1];
#pragma unroll
    for (int r = 0; r <= B_; ++r) acc[r] = 0.f;
    const float* w = p.w_ada + (size_t)l * D_ * 6 * D_ + col;
    for (int k = 0; k < D_; ++k) {
      const float wv = w[(size_t)k * 6 * D_];
#pragma unroll
      for (int r = 0; r < B_; ++r) acc[r] += siluf_(p.c[r * D_ + k]) * wv;
      acc[B_] += siluf_(p.c_ctx[k]) * wv;
    }
    const float bb = p.b_ada[l * 6 * D_ + col];
#pragma unroll
    for (int r = 0; r <= B_; ++r) p.modv[((size_t)l * (B_ + 1) + r) * 6 * D_ + col] = acc[r] + bb;
  }
  const int NF = ROPE_ / 4;
  for (int idx = obid() * NT + tid; idx < L_ * NF; idx += gridDim.x * NT) {
    const int t = idx / NF, i = idx % NF;
    const float inv = powf(10000.0f, -(float)(2 * i) / (float)(ROPE_ / 2));
    const float ar = (float)(t / GRIDW_) * inv, ac = (float)(t % GRIDW_) * inv;
    float* o = p.tab_mla + (size_t)t * 4 * NF;
    o[0 * NF + i] = cosf(ar); o[1 * NF + i] = sinf(ar); o[2 * NF + i] = cosf(ac); o[3 * NF + i] = sinf(ac);
  }
  const int NR = HD_ / 2;
  for (int idx = obid() * NT + tid; idx < L_ * NR; idx += gridDim.x * NT) {
    const int t = idx / NR, i = idx % NR;
    const float theta = 1.0f / powf(10000.0f, (float)i / (float)(NR - 1));
    const float a = (float)t * theta;
    p.tab_ret[(size_t)t * 2 * NR + i] = cosf(a); p.tab_ret[(size_t)t * 2 * NR + NR + i] = sinf(a);
  }
}

template <int MODE> __device__ __forceinline__ void phase_norm(const Params& p, int l) {
  const int tid = otid(), wave = tid >> 6, lane = tid & 63;
  const bool last = (l == DEPTH_ - 1);
  for (int row = obid() * NWAVE + wave; row < NROWS_; row += gridDim.x * NWAVE) {
    const bool isx = row < NTOK_;
    if (MODE == 2 && !isx) continue;
    if (MODE == 1 && !isx && last) continue;
    const int mi = row_modidx(row);
    float* xrow = isx ? p.out + (size_t)row * D_ : p.xc + (size_t)(row - NTOK_) * D_;
    const float* src = xrow;
    if (MODE == 0 && l == 0) src = isx ? p.x + (size_t)row * D_ : p.ctx + (size_t)(row - NTOK_) * D_;
    float v[D_ / 64];
    float ss = 0.f;
    const bool combine = (MODE == 0 && l > 0) || MODE == 2;
    const int lprev = (MODE == 2) ? l : l - 1;
#pragma unroll
    for (int i = 0; i < D_ / 256; ++i) {
      const int col = (i * 64 + lane) * 4;
      float a0 = src[col], a1 = src[col + 1], a2 = src[col + 2], a3 = src[col + 3];
      if (combine) {
        float s0 = 0.f, s1 = 0.f, s2 = 0.f, s3 = 0.f;
        for (int e = 0; e < NEXP_; ++e) {
          const int slot = p.inv[(size_t)row * NEXP_ + e];
          if (slot >= 0) { const bf16_t* yr = p.ye + (size_t)slot * D_ + col; s0 += bf2f(yr[0]); s1 += bf2f(yr[1]); s2 += bf2f(yr[2]); s3 += bf2f(yr[3]); }
        }
        const float* ga2 = p.modv + ((size_t)lprev * (B_ + 1) + mi) * 6 * D_ + 5 * D_ + col;
        a0 += ga2[0] * s0; a1 += ga2[1] * s1; a2 += ga2[2] * s2; a3 += ga2[3] * s3;
      }
      v[i * 4 + 0] = a0; v[i * 4 + 1] = a1; v[i * 4 + 2] = a2; v[i * 4 + 3] = a3;
      ss += a0 * a0 + a1 * a1 + a2 * a2 + a3 * a3;
      if (combine || (MODE == 0 && l == 0)) { xrow[col] = a0; xrow[col + 1] = a1; xrow[col + 2] = a2; xrow[col + 3] = a3; }
    }
    if (MODE == 2) continue;
    ss = wave_sum(ss);
    const float rstd = rsqrtf(ss / (float)D_ + 1e-6f);
    const float* g = (MODE == 0 ? p.g_norm1 : p.g_norm2) + (size_t)l * D_;
    const float* mv = p.modv + ((size_t)l * (B_ + 1) + mi) * 6 * D_ + (MODE == 0 ? 0 : 3 * D_);
    float lg[NEXP_];
#pragma unroll
    for (int e = 0; e < NEXP_; ++e) lg[e] = 0.f;
#pragma unroll
    for (int i = 0; i < D_ / 256; ++i) {
      const int col = (i * 64 + lane) * 4;
#pragma unroll
      for (int j = 0; j < 4; ++j) {
        const float hv = v[i * 4 + j] * rstd * g[col + j] * (1.0f + mv[D_ + col + j]) + mv[col + j];
        p.h[(size_t)row * D_ + col + j] = f2bf(hv);
        if (MODE == 1) {
          const float* wr = p.w_router + ((size_t)l * D_ + col + j) * NEXP_;
#pragma unroll
          for (int e = 0; e < NEXP_; ++e) lg[e] += hv * wr[e];
        }
      }
    }
    if (MODE == 1) {
      float mx = -1e30f;
#pragma unroll
      for (int e = 0; e < NEXP_; ++e) { lg[e] = wave_sum(lg[e]) + p.b_router[l * NEXP_ + e]; mx = fmaxf(mx, lg[e]); }
      float sum = 0.f;
#pragma unroll
      for (int e = 0; e < NEXP_; ++e) { lg[e] = expf(lg[e] - mx); sum += lg[e]; }
      const float is = 1.0f / sum;
      if (lane == 0) {
#pragma unroll
        for (int e = 0; e < NEXP_; ++e) p.aff[(size_t)row * NEXP_ + e] = lg[e] * is;
      }
    }
  }
}

struct GemmDesc { const bf16_t* A; int lda; const int* amap; const float* W; const float* W2; int ldw; int M, N, K; };
template <bool DUAL, class Epi> __device__ __forceinline__ void gemm_tile_f32(const GemmDesc& g, int tm, int tn, const Epi& epi) {
  float (*As)[132] = (float (*)[132])SMEM_PTR();
  float (*Bs)[64] = (float (*)[64])(SMEM_PTR() + 16 * 132 * 4);
  float (*Bs2)[64] = (float (*)[64])(SMEM_PTR() + 16 * 132 * 4 + 16 * 64 * 4);
  const int tid = otid(), ty = tid >> 4, tx = tid & 15;
  float acc[4][4], acc2[4][4];
#pragma unroll
  for (int i = 0; i < 4; ++i)
#pragma unroll
    for (int j = 0; j < 4; ++j) { acc[i][j] = 0.f; acc2[i][j] = 0.f; }
  const int ar = tid >> 2, ak = (tid & 3) * 4;
  int arow = tm * 128 + ar; if (arow >= g.M) arow = g.M - 1;
  const size_t asrc = (size_t)(g.amap ? g.amap[arow] : arow) * g.lda;
  const int bk = tid >> 5, bn = (tid & 31) * 2;
  for (int k0 = 0; k0 < g.K; k0 += 16) {
    __syncthreads();
#pragma unroll
    for (int j = 0; j < 4; ++j) As[ak + j][ar] = bf2f(g.A[asrc + k0 + ak + j]);
#pragma unroll
    for (int j = 0; j < 2; ++j) {
      const int n = tn * 64 + bn + j;
      Bs[bk][bn + j] = n < g.N ? g.W[(size_t)(k0 + bk) * g.ldw + n] : 0.f;
      if (DUAL) Bs2[bk][bn + j] = n < g.N ? g.W2[(size_t)(k0 + bk) * g.ldw + n] : 0.f;
    }
    __syncthreads();
#pragma unroll
    for (int kk = 0; kk < 16; ++kk) {
      float a[4], b[4], b2[4];
#pragma unroll
      for (int i = 0; i < 4; ++i) a[i] = As[kk][ty * 4 + i];
#pragma unroll
      for (int j = 0; j < 4; ++j) { b[j] = Bs[kk][tx * 4 + j]; if (DUAL) b2[j] = Bs2[kk][tx * 4 + j]; }
#pragma unroll
      for (int i = 0; i < 4; ++i)
#pragma unroll
        for (int j = 0; j < 4; ++j) { acc[i][j] += a[i] * b[j]; if (DUAL) acc2[i][j] += a[i] * b2[j]; }
    }
  }
#pragma unroll
  for (int i = 0; i < 4; ++i) {
    const int m = tm * 128 + ty * 4 + i;
    if (m >= g.M) continue;
#pragma unroll
    for (int j = 0; j < 4; ++j) { const int n = tn * 64 + tx * 4 + j; if (n < g.N) epi(m, n, acc[i][j], acc2[i][j]); }
  }
}

struct EpiZ { bf16_t* z; __device__ void operator()(int m, int n, float a, float) const { z[(size_t)m * ZLD_ + n] = f2bf(a); } };
struct EpiOut { const float* modv; float* out; float* xc; int l; __device__ void operator()(int m, int n, float a, float) const {
    const int mi = row_modidx(m); const float ga1 = modv[((size_t)l * (B_ + 1) + mi) * 6 * D_ + 2 * D_ + n];
    float* xr = m < NTOK_ ? out + (size_t)m * D_ : xc + (size_t)(m - NTOK_) * D_; xr[n] += ga1 * a; } };
struct EpiHid { bf16_t* hid; int row0; __device__ void operator()(int m, int n, float a, float b) const { hid[(size_t)(row0 + m) * D_ + n] = f2bf(siluf_(a) * b); } };
struct EpiYe { bf16_t* ye; const float* gate; int row0; __device__ void operator()(int m, int n, float a, float) const { ye[(size_t)(row0 + m) * D_ + n] = f2bf(a * gate[row0 + m]); } };

__device__ __forceinline__ void phase_gemm_in(const Params& p, int l) {
  GemmDesc g; g.A = p.h; g.lda = D_; g.amap = nullptr; g.W = p.w_in + (size_t)l * D_ * INCOLS_; g.W2 = nullptr; g.ldw = INCOLS_; g.M = NROWS_; g.N = INCOLS_; g.K = D_;
  EpiZ epi{p.z};
  const int ntm = (NROWS_ + 127) / 128, ntn = (INCOLS_ + 63) / 64;
  for (int u = obid(); u < ntm * ntn; u += gridDim.x) gemm_tile_f32<false>(g, u / ntn, u % ntn, epi);
}
__device__ __forceinline__ void phase_gemm_out(const Params& p, int l) {
  const bool last = (l == DEPTH_ - 1);
  GemmDesc g; g.A = p.y; g.lda = D_; g.amap = nullptr; g.W = p.w_out + (size_t)l * D_ * D_; g.W2 = nullptr; g.ldw = D_; g.M = last ? NTOK_ : NROWS_; g.N = D_; g.K = D_;
  EpiOut epi{p.modv, p.out, p.xc, l};
  const int ntm = (g.M + 127) / 128, ntn = D_ / 64;
  for (int u = obid(); u < ntm * ntn; u += gridDim.x) gemm_tile_f32<false>(g, u / ntn, u % ntn, epi);
}
__device__ __forceinline__ int slot_expert(int slotrow) { return slotrow < XSLOTS_ ? slotrow / (B_ * CAP_) : (slotrow - XSLOTS_) / (B_ * CAPC_); }
__device__ __forceinline__ void phase_moe1(const Params& p, int l) {
  const bool last = (l == DEPTH_ - 1);
  const int M = last ? XSLOTS_ : XSLOTS_ + CSLOTS_;
  const int ntm = M / 128, ntn = D_ / 64;
  for (int u = obid(); u < ntm * ntn; u += gridDim.x) {
    const int tm = u / ntn, tn = u % ntn, e = slot_expert(tm * 128);
    GemmDesc g; g.A = p.h; g.lda = D_; g.amap = p.sel_idx + tm * 128; g.W = p.w_gate + ((size_t)l * NEXP_ + e) * D_ * D_; g.W2 = p.w_up + ((size_t)l * NEXP_ + e) * D_ * D_;
    g.ldw = D_; g.M = 128; g.N = D_; g.K = D_;
    EpiHid epi{p.hid, tm * 128};
    gemm_tile_f32<true>(g, 0, tn, epi);
  }
}
__device__ __forceinline__ void phase_moe2(const Params& p, int l) {
  const bool last = (l == DEPTH_ - 1);
  const int M = last ? XSLOTS_ : XSLOTS_ + CSLOTS_;
  const int ntm = M / 128, ntn = D_ / 64;
  for (int u = obid(); u < ntm * ntn; u += gridDim.x) {
    const int tm = u / ntn, tn = u % ntn, e = slot_expert(tm * 128);
    GemmDesc g; g.A = p.hid + (size_t)tm * 128 * D_; g.lda = D_; g.amap = nullptr; g.W = p.w_down + ((size_t)l * NEXP_ + e) * D_ * D_; g.W2 = nullptr;
    g.ldw = D_; g.M = 128; g.N = D_; g.K = D_;
    EpiYe epi{p.ye, p.sel_gate, tm * 128};
    gemm_tile_f32<false>(g, 0, tn, epi);
  }
}


#ifndef CPU_EMU
#define LAS __attribute__((address_space(3)))
namespace pg8 {
typedef short bf16x8 __attribute__((ext_vector_type(8)));
typedef float f32x4 __attribute__((ext_vector_type(4)));
typedef unsigned u32x4 __attribute__((ext_vector_type(4)));
constexpr int BM = 256, BK = 64, HALF = 128, HTB = HALF * BK * 2, STAGE_BYTES = 8 * HTB, NXCD = 8, WGM = 8;
__device__ __forceinline__ int lds_byte(int r, int c) { const int st = (r >> 4) * 2 + (c >> 5), rr = r & 15, cc = c & 31, ob = rr * 64 + cc * 2; return st * 1024 + (ob ^ (((ob >> 9) & 1) << 5)); }
__device__ __forceinline__ void stage_rc(int b, int& R, int& C) { const int st = b / 1024, sb = b % 1024, swz = sb ^ (((sb >> 9) & 1) << 5); R = (st >> 1) * 16 + swz / 64; C = (st & 1) * 32 + (swz % 64) / 2; }
__device__ __forceinline__ int perm32(int rho) { const int n = rho >> 4, i = rho & 15; return 8 * (i >> 2) + 4 * n + (i & 3); }
struct Unit { int pm, pn; };
__device__ __forceinline__ bool static_order(int i, int nM, int nN, int G, int c, Unit& u) {
    const int nwg = nM * nN; const long L = (long)i * G + c; if (L >= nwg) return false;
    int wgid = (int)L; { const int q = nwg / NXCD, r = nwg % NXCD, xcd = wgid % NXCD, off = wgid / NXCD; wgid = (xcd < r ? xcd * (q + 1) : r * (q + 1) + (xcd - r) * q) + off; }
    const int nig = WGM * nN, gid = wgid / nig, fm = gid * WGM, gsz = (nM - fm) < WGM ? (nM - fm) : WGM;
    u.pm = fm + ((wgid % nig) % gsz); u.pn = (wgid % nig) / gsz; return true;
}
__device__ __forceinline__ unsigned cvt_pk_bf16(float lo, float hi) { unsigned r; asm volatile("v_cvt_pk_bf16_f32 %0, %1, %2" : "=v"(r) : "v"(lo), "v"(hi)); return r; }

template <class P> __device__ __forceinline__ void gemm_phase(LAS unsigned char* lds, const P& prob) {
    const int tid = otid(), wid = __builtin_amdgcn_readfirstlane(tid >> 6), lane = tid & 63, wr = wid >> 2, wc = wid & 3, fr = lane & 15, fq = lane >> 4;
    constexpr int K = D_, nt = K / BK;
    unsigned voffB[2]; int sR[2], sC[2];
#pragma unroll
    for (int i = 0; i < 2; ++i) { int R, C; stage_rc(tid * 16 + i * 8192, R, C); sR[i] = R; sC[i] = C; const int Rb = P::PERM ? ((R & ~31) + perm32(R & 31)) : R; voffB[i] = (unsigned)(Rb * K + C) * 2u; }
    constexpr size_t kstep = (size_t)(BK * 2);
    constexpr size_t hstep = (size_t)HALF * K * 2;
    const unsigned ldsw = (unsigned)wid * 1024u;
    const int aoff = lds_byte(wr * 64 + fr, fq * 8), boff = lds_byte(wc * 32 + fr, fq * 8);
#define PG8_SA(b, h) (((b) * 2 + (h)) * HTB)
#define PG8_SB(b, h) ((4 + (b) * 2 + (h)) * HTB)
#define PG8_STAGE(bufoff, gbase, voff) do { _Pragma("unroll") for (int _i = 0; _i < 2; ++_i) \
        __builtin_amdgcn_global_load_lds((const unsigned*)((const char*)(gbase) + (voff)[_i]), (LAS unsigned*)(lds + (bufoff) + ldsw + _i * 8192), 16, 0, 0); } while (0)
#define PG8_LDA(dst, b, h) do { _Pragma("unroll") for (int m = 0; m < 4; ++m) _Pragma("unroll") for (int k = 0; k < 2; ++k) dst[m][k] = *(const LAS bf16x8*)(lds + PG8_SA(b, h) + aoff + m * 2048 + k * 1024); } while (0)
#define PG8_LDB(dst, b, h) do { _Pragma("unroll") for (int n = 0; n < 2; ++n) _Pragma("unroll") for (int k = 0; k < 2; ++k) dst[n][k] = *(const LAS bf16x8*)(lds + PG8_SB(b, h) + boff + n * 2048 + k * 1024); } while (0)
#define PG8_MMA(ai, bj, At, Bt) do { __builtin_amdgcn_s_setprio(1); _Pragma("unroll") for (int m = 0; m < 4; ++m) _Pragma("unroll") for (int n = 0; n < 2; ++n) _Pragma("unroll") for (int k = 0; k < 2; ++k) \
        acc[ai][bj][m][n] = __builtin_amdgcn_mfma_f32_16x16x32_bf16(Bt[n][k], At[m][k], acc[ai][bj][m][n], 0, 0, 0); __builtin_amdgcn_s_setprio(0); } while (0)
#define PG8_WAIT_V(n) asm volatile("s_waitcnt vmcnt(" #n ")" ::: "memory")
#define PG8_WAIT_L(n) asm volatile("s_waitcnt lgkmcnt(" #n ")" ::: "memory")
#define PG8_BAR __builtin_amdgcn_s_barrier()
#define PG8_SCHED __builtin_amdgcn_sched_barrier(0)
    Unit cur, nxt; int ui = 0;
    if (!prob.unit(0, cur)) return;
    f32x4 acc[2][2][4][2];
#pragma unroll
    for (int a = 0; a < 2; ++a)
#pragma unroll
        for (int b = 0; b < 2; ++b)
#pragma unroll
            for (int m = 0; m < 4; ++m)
#pragma unroll
                for (int n = 0; n < 2; ++n) acc[a][b][m][n] = (f32x4){0.f, 0.f, 0.f, 0.f};
    bf16x8 At[4][2], B0[2][2], B1[2][2];
    unsigned vc[2][2], vn[2][2];
#pragma unroll
    for (int h = 0; h < 2; ++h)
#pragma unroll
        for (int i = 0; i < 2; ++i) vc[h][i] = prob.a_voff(cur, h * HALF + sR[i], sC[i]);
    const char* Ab = prob.a_base();
    const char* cB = prob.b_base(cur);
    PG8_STAGE(PG8_SB(0, 0), cB, voffB); PG8_STAGE(PG8_SA(0, 0), Ab, vc[0]); PG8_STAGE(PG8_SB(0, 1), cB + hstep, voffB); PG8_STAGE(PG8_SA(0, 1), Ab, vc[1]);
    if (wr == 1) PG8_BAR;
    PG8_WAIT_V(4); PG8_BAR;
    PG8_STAGE(PG8_SB(1, 0), cB + kstep, voffB); PG8_STAGE(PG8_SA(1, 0), Ab + kstep, vc[0]); PG8_STAGE(PG8_SB(1, 1), cB + hstep + kstep, voffB);
    PG8_WAIT_V(6); PG8_BAR;
    for (;;) {
        const bool has_next = prob.unit(ui + 1, nxt);
        const char* nB = has_next ? prob.b_base(nxt) : cB;
#pragma unroll
        for (int h = 0; h < 2; ++h)
#pragma unroll
            for (int i = 0; i < 2; ++i) vn[h][i] = has_next ? prob.a_voff(nxt, h * HALF + sR[i], sC[i]) : vc[h][i];
        for (int t = 0; t < nt; t += 2) {
            const bool last = (t == nt - 2);
            const char* a1 = Ab + (size_t)(t + 1) * kstep;
            const char* a2 = last ? Ab : Ab + (size_t)(t + 2) * kstep; const char* b2 = last ? nB : cB + (size_t)(t + 2) * kstep;
            const char* a3 = a2 + kstep; const char* b3 = b2 + kstep;
            unsigned v2[2][2];
#pragma unroll
            for (int h = 0; h < 2; ++h)
#pragma unroll
                for (int i = 0; i < 2; ++i) v2[h][i] = last ? vn[h][i] : vc[h][i];
            PG8_LDB(B0, 0, 0); PG8_SCHED; PG8_LDA(At, 0, 0); PG8_STAGE(PG8_SA(1, 1), a1, vc[1]);
            PG8_WAIT_L(8); PG8_BAR; PG8_WAIT_L(0); PG8_MMA(0, 0, At, B0); PG8_BAR; PG8_SCHED;
            PG8_LDB(B1, 0, 1); PG8_STAGE(PG8_SB(0, 0), b2, voffB);
            PG8_BAR; PG8_WAIT_L(0); PG8_MMA(0, 1, At, B1); PG8_BAR;
            PG8_LDA(At, 0, 1); PG8_STAGE(PG8_SA(0, 0), a2, v2[0]);
            PG8_BAR; PG8_WAIT_L(0); PG8_MMA(1, 0, At, B0); PG8_BAR; PG8_SCHED;
            PG8_STAGE(PG8_SB(0, 1), b2 + hstep, voffB);
            PG8_WAIT_V(6); PG8_BAR; PG8_MMA(1, 1, At, B1); PG8_BAR;
            PG8_LDB(B0, 1, 0); PG8_SCHED; PG8_LDA(At, 1, 0); PG8_STAGE(PG8_SA(0, 1), a2, v2[1]);
            PG8_WAIT_L(8); PG8_BAR; PG8_WAIT_L(0); PG8_MMA(0, 0, At, B0); PG8_BAR; PG8_SCHED;
            PG8_LDB(B1, 1, 1); PG8_STAGE(PG8_SB(1, 0), b3, voffB);
            PG8_BAR; PG8_WAIT_L(0); PG8_MMA(0, 1, At, B1); PG8_BAR;
            PG8_LDA(At, 1, 1); PG8_STAGE(PG8_SA(1, 0), a3, v2[0]);
            PG8_BAR; PG8_WAIT_L(0); PG8_MMA(1, 0, At, B0); PG8_BAR; PG8_SCHED;
            PG8_STAGE(PG8_SB(1, 1), b3 + hstep, voffB);
            PG8_WAIT_V(6); PG8_BAR; PG8_MMA(1, 1, At, B1); PG8_BAR;
        }
        prob.epi(acc, cur, wr, wc, fr, fq);
        if (!has_next) break;
#pragma unroll
        for (int a = 0; a < 2; ++a)
#pragma unroll
            for (int b = 0; b < 2; ++b)
#pragma unroll
                for (int m = 0; m < 4; ++m)
#pragma unroll
                    for (int n = 0; n < 2; ++n) acc[a][b][m][n] = (f32x4){0.f, 0.f, 0.f, 0.f};
        cur = nxt; cB = nB; ++ui;
#pragma unroll
        for (int h = 0; h < 2; ++h)
#pragma unroll
            for (int i = 0; i < 2; ++i) vc[h][i] = vn[h][i];
    }
    PG8_WAIT_V(0);
    if (wr == 0) PG8_BAR;
    PG8_BAR;
#undef PG8_SA
#undef PG8_SB
#undef PG8_STAGE
#undef PG8_LDA
#undef PG8_LDB
#undef PG8_MMA
#undef PG8_WAIT_V
#undef PG8_WAIT_L
#undef PG8_BAR
#undef PG8_SCHED
}
typedef f32x4 Acc[2][2][4][2];

struct ProbIn {
    static constexpr bool PERM = true;
    const bf16_t* A; const bf16_t* Bt; bf16_t* z; int G, c;
    __device__ __forceinline__ bool unit(int i, Unit& u) const { return static_order(i, NROWS_ / BM, ZLD_ / BM, G, c, u); }
    __device__ __forceinline__ const char* a_base() const { return (const char*)A; }
    __device__ __forceinline__ unsigned a_voff(const Unit& u, int r, int cc) const { return (unsigned)((u.pm * BM + r) * D_ + cc) * 2u; }
    __device__ __forceinline__ const char* b_base(const Unit& u) const { return (const char*)Bt + (size_t)u.pn * BM * D_ * 2; }
    __device__ __forceinline__ void epi(const Acc& acc, const Unit& u, int wr, int wc, int fr, int fq) const {
        const int row0 = u.pm * BM + wr * 64 + fr, col0 = u.pn * BM + wc * 32 + 8 * fq;
#pragma unroll
        for (int ai = 0; ai < 2; ++ai)
#pragma unroll
            for (int m = 0; m < 4; ++m) { bf16_t* rowp = z + (size_t)(row0 + ai * HALF + m * 16) * ZLD_ + col0;
#pragma unroll
                for (int bj = 0; bj < 2; ++bj) { const f32x4 v0 = acc[ai][bj][m][0], v1 = acc[ai][bj][m][1];
                    u32x4 w; w.x = cvt_pk_bf16(v0[0], v0[1]); w.y = cvt_pk_bf16(v0[2], v0[3]); w.z = cvt_pk_bf16(v1[0], v1[1]); w.w = cvt_pk_bf16(v1[2], v1[3]);
                    *(u32x4*)(rowp + bj * HALF) = w; } }
    }
};
struct ProbOut {
    static constexpr bool PERM = false;
    const bf16_t* A; const bf16_t* Bt; float* out; float* xc; const float* modv_l; int nM, G, c;
    __device__ __forceinline__ bool unit(int i, Unit& u) const { return static_order(i, nM, D_ / BM, G, c, u); }
    __device__ __forceinline__ const char* a_base() const { return (const char*)A; }
    __device__ __forceinline__ unsigned a_voff(const Unit& u, int r, int cc) const { return (unsigned)((u.pm * BM + r) * D_ + cc) * 2u; }
    __device__ __forceinline__ const char* b_base(const Unit& u) const { return (const char*)Bt + (size_t)u.pn * BM * D_ * 2; }
    __device__ __forceinline__ void epi(const Acc& acc, const Unit& u, int wr, int wc, int fr, int fq) const {
        const int rt = u.pm * BM; const bool isx = rt < NTOK_;
        const int mi = isx ? rt / L_ : B_;
        float* xb = isx ? out + (size_t)rt * D_ : xc + (size_t)(rt - NTOK_) * D_;
        const int rl = wr * 64 + fr, col0 = u.pn * BM + wc * 32 + 4 * fq;
        const float* gp = modv_l + (size_t)mi * 6 * D_ + 2 * D_ + col0;
        f32x4 ga[2][2];
#pragma unroll
        for (int bj = 0; bj < 2; ++bj)
#pragma unroll
            for (int n = 0; n < 2; ++n) ga[bj][n] = *(const f32x4*)(gp + bj * HALF + n * 16);
#pragma unroll
        for (int ai = 0; ai < 2; ++ai)
#pragma unroll
            for (int m = 0; m < 4; ++m) { float* rowp = xb + (size_t)(rl + ai * HALF + m * 16) * D_ + col0;
#pragma unroll
                for (int bj = 0; bj < 2; ++bj)
#pragma unroll
                    for (int n = 0; n < 2; ++n) { f32x4* q = (f32x4*)(rowp + bj * HALF + n * 16); *q = *q + ga[bj][n] * acc[ai][bj][m][n]; } }
    }
};
struct ProbMoe1 {
    static constexpr bool PERM = true;
    const bf16_t* A; const bf16_t* Bt; const int* sel; bf16_t* hid; int nM, G, c;
    __device__ __forceinline__ bool unit(int i, Unit& u) const { return static_order(i, nM, 2 * D_ / BM, G, c, u); }
    __device__ __forceinline__ const char* a_base() const { return (const char*)A; }
    __device__ __forceinline__ unsigned a_voff(const Unit& u, int r, int cc) const { return (unsigned)(sel[u.pm * BM + r] * D_ + cc) * 2u; }
    __device__ __forceinline__ const char* b_base(const Unit& u) const { const int rt = u.pm * BM; const int e = rt < XSLOTS_ ? rt / (B_ * CAP_) : (rt - XSLOTS_) / (B_ * CAPC_);
        return (const char*)Bt + ((size_t)e * 2 * D_ + (size_t)u.pn * BM) * D_ * 2; }
    __device__ __forceinline__ void epi(const Acc& acc, const Unit& u, int wr, int wc, int fr, int fq) const {
        const int row0 = u.pm * BM + wr * 64 + fr, col0 = u.pn * HALF + wc * 32 + 8 * fq;
#pragma unroll
        for (int ai = 0; ai < 2; ++ai)
#pragma unroll
            for (int m = 0; m < 4; ++m) { bf16_t* rowp = hid + (size_t)(row0 + ai * HALF + m * 16) * D_ + col0;
                float r[8];
#pragma unroll
                for (int n = 0; n < 2; ++n)
#pragma unroll
                    for (int j = 0; j < 4; ++j) { const float g = acc[ai][0][m][n][j], uu = acc[ai][1][m][n][j]; r[n * 4 + j] = g * __builtin_amdgcn_rcpf(1.0f + __expf(-g)) * uu; }
                u32x4 w; w.x = cvt_pk_bf16(r[0], r[1]); w.y = cvt_pk_bf16(r[2], r[3]); w.z = cvt_pk_bf16(r[4], r[5]); w.w = cvt_pk_bf16(r[6], r[7]);
                *(u32x4*)rowp = w; }
    }
};
struct ProbMoe2 {
    static constexpr bool PERM = true;
    const bf16_t* A; const bf16_t* Bt; const float* gate; bf16_t* ye; int nM, G, c;
    __device__ __forceinline__ bool unit(int i, Unit& u) const { return static_order(i, nM, D_ / BM, G, c, u); }
    __device__ __forceinline__ const char* a_base() const { return (const char*)A; }
    __device__ __forceinline__ unsigned a_voff(const Unit& u, int r, int cc) const { return (unsigned)((u.pm * BM + r) * D_ + cc) * 2u; }
    __device__ __forceinline__ const char* b_base(const Unit& u) const { const int rt = u.pm * BM; const int e = rt < XSLOTS_ ? rt / (B_ * CAP_) : (rt - XSLOTS_) / (B_ * CAPC_);
        return (const char*)Bt + ((size_t)e * D_ + (size_t)u.pn * BM) * D_ * 2; }
    __device__ __forceinline__ void epi(const Acc& acc, const Unit& u, int wr, int wc, int fr, int fq) const {
        const int row0 = u.pm * BM + wr * 64 + fr, col0 = u.pn * BM + wc * 32 + 8 * fq;
#pragma unroll
        for (int ai = 0; ai < 2; ++ai)
#pragma unroll
            for (int m = 0; m < 4; ++m) { const int row = row0 + ai * HALF + m * 16; const float gt = gate[row]; bf16_t* rowp = ye + (size_t)row * D_ + col0;
#pragma unroll
                for (int bj = 0; bj < 2; ++bj) { const f32x4 v0 = acc[ai][bj][m][0] * gt, v1 = acc[ai][bj][m][1] * gt;
                    u32x4 w; w.x = cvt_pk_bf16(v0[0], v0[1]); w.y = cvt_pk_bf16(v0[2], v0[3]); w.z = cvt_pk_bf16(v1[0], v1[1]); w.w = cvt_pk_bf16(v1[2], v1[3]);
                    *(u32x4*)(rowp + bj * HALF) = w; } }
    }
};
}

__device__ __forceinline__ void cvt_tile(const float* src, int ld, int nvalid, int k0, int n0, bf16_t* dst, int dst_row0) {
  float (*tile)[65] = (float (*)[65])SMEM_PTR();
  const int tid = otid();
#pragma unroll
  for (int j = 0; j < 8; ++j) { const int k = j * 8 + (tid >> 6), n = tid & 63; tile[k][n] = (n0 + n < nvalid) ? src[(size_t)(k0 + k) * ld + n0 + n] : 0.f; }
  __syncthreads();
#pragma unroll
  for (int j = 0; j < 4; ++j) { const int n = j * 16 + (tid >> 5), k2 = tid & 31;
    const unsigned v = (unsigned)f2bf(tile[2 * k2][n]) | ((unsigned)f2bf(tile[2 * k2 + 1][n]) << 16);
    *(unsigned*)(dst + (size_t)(dst_row0 + n) * D_ + k0 + 2 * k2) = v; }
  __syncthreads();
}
__device__ __forceinline__ void phase_cvt_static(const Params& p) {
  const int nin = DEPTH_ * (D_ / 64) * (ZLD_ / 64), nout = DEPTH_ * (D_ / 64) * (D_ / 64);
  for (int u = obid(); u < nin + nout; u += gridDim.x) {
    if (u < nin) { const int l = u / ((D_ / 64) * (ZLD_ / 64)), r = u % ((D_ / 64) * (ZLD_ / 64)), kt = r / (ZLD_ / 64), ntl = r % (ZLD_ / 64);
      cvt_tile(p.w_in + (size_t)l * D_ * INCOLS_, INCOLS_, INCOLS_, kt * 64, ntl * 64, p.wb_in + (size_t)l * ZLD_ * D_, ntl * 64); }
    else { const int v = u - nin; const int l = v / ((D_ / 64) * (D_ / 64)), r = v % ((D_ / 64) * (D_ / 64)), kt = r / (D_ / 64), ntl = r % (D_ / 64);
      cvt_tile(p.w_out + (size_t)l * D_ * D_, D_, D_, kt * 64, ntl * 64, p.wb_out + (size_t)l * D_ * D_, ntl * 64); }
  }
}
__device__ __forceinline__ void phase_cvt_moe(const Params& p, int l) {
  const int per = (D_ / 64) * (D_ / 64);
  for (int u = obid(); u < 3 * NEXP_ * per; u += gridDim.x) {
    const int mat = u / (NEXP_ * per), e = (u / per) % NEXP_, r = u % per, kt = r / (D_ / 64), ntl = r % (D_ / 64);
    const size_t so = ((size_t)l * NEXP_ + e) * D_ * D_;
    const int n0 = ntl * 64;
    if (mat == 0) cvt_tile(p.w_gate + so, D_, D_, kt * 64, n0, p.wb_moe1 + (size_t)e * 2 * D_ * D_, (n0 / 128) * 256 + (n0 % 128));
    else if (mat == 1) cvt_tile(p.w_up + so, D_, D_, kt * 64, n0, p.wb_moe1 + (size_t)e * 2 * D_ * D_, (n0 / 128) * 256 + 128 + (n0 % 128));
    else cvt_tile(p.w_down + so, D_, D_, kt * 64, n0, p.wb_moe2 + (size_t)e * D_ * D_, n0);
  }
}
__device__ __forceinline__ void phase_gemm_in_mfma(const Params& p, int l, LAS unsigned char* lds) {
  pg8::ProbIn pr; pr.A = p.h; pr.Bt = p.wb_in + (size_t)l * ZLD_ * D_; pr.z = p.z; pr.G = gridDim.x; pr.c = obid();
  pg8::gemm_phase(lds, pr);
}
__device__ __forceinline__ void phase_gemm_out_mfma(const Params& p, int l, LAS unsigned char* lds) {
  pg8::ProbOut pr; pr.A = p.y; pr.Bt = p.wb_out + (size_t)l * D_ * D_; pr.out = p.out; pr.xc = p.xc; pr.modv_l = p.modv + (size_t)l * (B_ + 1) * 6 * D_;
  pr.nM = (l == DEPTH_ - 1 ? NTOK_ : NROWS_) / 256; pr.G = gridDim.x; pr.c = obid();
  pg8::gemm_phase(lds, pr);
}
__device__ __forceinline__ void phase_moe1_mfma(const Params& p, int l, LAS unsigned char* lds) {
  pg8::ProbMoe1 pr; pr.A = p.h; pr.Bt = p.wb_moe1; pr.sel = p.sel_idx; pr.hid = p.hid; pr.nM = (l == DEPTH_ - 1 ? XSLOTS_ : XSLOTS_ + CSLOTS_) / 256; pr.G = gridDim.x; pr.c = obid();
  pg8::gemm_phase(lds, pr);
}
__device__ __forceinline__ void phase_moe2_mfma(const Params& p, int l, LAS unsigned char* lds) {
  pg8::ProbMoe2 pr; pr.A = p.hid; pr.Bt = p.wb_moe2; pr.gate = p.sel_gate; pr.ye = p.ye; pr.nM = (l == DEPTH_ - 1 ? XSLOTS_ : XSLOTS_ + CSLOTS_) / 256; pr.G = gridDim.x; pr.c = obid();
  pg8::gemm_phase(lds, pr);
}
#endif

__device__ __forceinline__ void phase_prep(const Params& p, int l) {
  float (*sm)[COLS_RWKV_ + 64] = (float (*)[COLS_RWKV_ + 64])SMEM_PTR();
  const int tid = otid(), wave = tid >> 6, lane = tid & 63;
  float* ws = sm[wave];
  const bool last = (l == DEPTH_ - 1);
  for (int row = obid() * NWAVE + wave; row < NROWS_; row += gridDim.x * NWAVE) {
    const bool isx = row < NTOK_;
    const int pos = row_pos(row), len = row_len(row), b = row_batch(row);
    const bf16_t* zr = p.z + (size_t)row * ZLD_;
    const bool hasp = pos > 0, hasn = pos < len - 1;
    const bf16_t* zp = zr - ZLD_; const bf16_t* zn = zr + ZLD_;
    const bool need_out = isx || !last;
    if (need_out) {
      const float* cw = p.conv_w + (size_t)l * 3 * GWID_;
      float t[GWID_ / 64]; float ss = 0.f;
#pragma unroll
      for (int i = 0; i < GWID_ / 64; ++i) {
        const int ch = i * 64 + lane;
        const float bv = bf2f(zr[ch]);
        const float u0 = bf2f(zr[GWID_ + ch]) * bf2f(zr[2 * GWID_ + ch]);
        const float up = hasp ? bf2f(zp[GWID_ + ch]) * bf2f(zp[2 * GWID_ + ch]) : 0.f;
        const float un = hasn ? bf2f(zn[GWID_ + ch]) * bf2f(zn[2 * GWID_ + ch]) : 0.f;
        const float yv = cw[ch] * up + cw[GWID_ + ch] * u0 + cw[2 * GWID_ + ch] * un;
        t[i] = bv * yv; ss += t[i] * t[i];
      }
      ss = wave_sum(ss);
      const float rstd = rsqrtf(ss / (float)GWID_ + 1e-6f);
#pragma unroll
      for (int i = 0; i < GWID_ / 64; ++i) { const int ch = i * 64 + lane; p.y[(size_t)row * D_ + ch] = f2bf(t[i] * rstd * p.g_out_conv[l * GWID_ + ch]); }
    }
    {
      const bf16_t* zm = zr + MLA0_;
      const int NF = ROPE_ / 4;
      const float* tab = p.tab_mla + (size_t)pos * 4 * NF;
      if (need_out) {
        for (int hh = 0; hh < NH_; ++hh) {
          float q0 = 0.f, q1 = 0.f;
          { const int e = lane; if (e < QK_) q0 = bf2f(e < HD_ ? zm[hh * HD_ + e] : zm[NH_ * HD_ + hh * ROPE_ + (e - HD_)]); }
          { const int e = lane + 64; if (e < QK_) q1 = bf2f(e < HD_ ? zm[hh * HD_ + e] : zm[NH_ * HD_ + hh * ROPE_ + (e - HD_)]); }
          const float ss = wave_sum(q0 * q0 + q1 * q1);
          const float rstd = rsqrtf(ss / (float)QK_ + 1e-6f);
          if (lane < QK_) ws[lane] = q0 * rstd * p.g_q_norm[l * QK_ + lane];
          if (lane + 64 < QK_) ws[lane + 64] = q1 * rstd * p.g_q_norm[l * QK_ + lane + 64];
          __builtin_amdgcn_wave_barrier();
          const float scale = 1.0f / sqrtf((float)QK_);
          for (int e = lane; e < QK_; e += 64) {
            float v = ws[e];
            if (isx && e >= HD_) {
              const int r = e - HD_; const int ax = r / (ROPE_ / 2), ri = r % (ROPE_ / 2); const int half = ri / NF, fi = ri % NF;
              const float cs = tab[(ax * 2 + 0) * NF + fi], sn = tab[(ax * 2 + 1) * NF + fi];
              const int base = HD_ + ax * (ROPE_ / 2);
              const float t1 = ws[base + fi], t2 = ws[base + NF + fi];
              v = half == 0 ? t1 * cs - t2 * sn : t1 * sn + t2 * cs;
            }
            p.qb[((size_t)row * NH_ + hh) * QK_ + e] = f2bf(v * scale);
          }
          __builtin_amdgcn_wave_barrier();
        }
      }
      float cs2 = 0.f;
      for (int e = lane; e < KVR_; e += 64) { const float v = bf2f(zm[NH_ * QK_ + e]); cs2 += v * v; }
      cs2 = wave_sum(cs2);
      const float crstd = rsqrtf(cs2 / (float)KVR_ + 1e-6f);
      for (int e = lane; e < KVR_; e += 64) ws[e] = bf2f(zm[NH_ * QK_ + e]) * crstd * p.g_kv_norm[l * KVR_ + e];
      __builtin_amdgcn_wave_barrier();
      float kn[GWID_ / 64], vv[GWID_ / 64];
#pragma unroll
      for (int i = 0; i < GWID_ / 64; ++i) { kn[i] = 0.f; vv[i] = 0.f; }
      const float* wuk = p.w_uk + (size_t)l * KVR_ * GWID_; const float* wuv = p.w_uv + (size_t)l * KVR_ * GWID_;
#pragma unroll 4
      for (int k = 0; k < KVR_; ++k) {
        const float cv = ws[k];
#pragma unroll
        for (int i = 0; i < GWID_ / 64; ++i) { kn[i] += cv * wuk[k * GWID_ + i * 64 + lane]; vv[i] += cv * wuv[k * GWID_ + i * 64 + lane]; }
      }
      __builtin_amdgcn_wave_barrier();
      const int kpos = isx ? LC_ + pos : pos;
#pragma unroll
      for (int i = 0; i < GWID_ / 64; ++i) {
        const int cidx = i * 64 + lane, hh = cidx / HD_, e = cidx % HD_;
        p.vb[(((size_t)b * NH_ + hh) * LK_ + kpos) * HD_ + e] = f2bf(vv[i]);
        ws[64 + cidx] = kn[i];
      }
      for (int e = lane; e < ROPE_; e += 64) ws[64 + GWID_ + e] = bf2f(zm[NH_ * QK_ + KVR_ + e]);
      __builtin_amdgcn_wave_barrier();
      float kr2 = 0.f;
      for (int e = lane; e < ROPE_; e += 64) { const float v = ws[64 + GWID_ + e]; kr2 += v * v; }
      kr2 = wave_sum(kr2);
      for (int hh = 0; hh < NH_; ++hh) {
        float s2 = 0.f;
        for (int e = lane; e < HD_; e += 64) { const float v = ws[64 + hh * HD_ + e]; s2 += v * v; }
        s2 = wave_sum(s2) + kr2;
        const float rstd = rsqrtf(s2 / (float)QK_ + 1e-6f);
        for (int e = lane; e < QK_; e += 64) {
          float v;
          if (e < HD_) v = ws[64 + hh * HD_ + e] * rstd * p.g_k_norm[l * QK_ + e];
          else {
            const int r = e - HD_;
            if (!isx) v = ws[64 + GWID_ + r] * rstd * p.g_k_norm[l * QK_ + e];
            else {
              const int ax = r / (ROPE_ / 2), ri = r % (ROPE_ / 2); const int half = ri / NF, fi = ri % NF;
              const float cs = tab[(ax * 2 + 0) * NF + fi], sn = tab[(ax * 2 + 1) * NF + fi];
              const int i1 = ax * (ROPE_ / 2) + fi, i2 = i1 + NF;
              const float t1 = ws[64 + GWID_ + i1] * rstd * p.g_k_norm[l * QK_ + HD_ + i1], t2 = ws[64 + GWID_ + i2] * rstd * p.g_k_norm[l * QK_ + HD_ + i2];
              v = half == 0 ? t1 * cs - t2 * sn : t1 * sn + t2 * cs;
            }
          }
          p.kb[(((size_t)b * NH_ + hh) * LK_ + kpos) * KLD_ + e] = f2bf(v);
        }
        for (int e = QK_ + lane; e < KLD_; e += 64) p.kb[(((size_t)b * NH_ + hh) * LK_ + kpos) * KLD_ + e] = 0;
      }
      __builtin_amdgcn_wave_barrier();
    }
    {
      const bf16_t* zw = zr + RW0_; const bf16_t* zwp = zp + RW0_; const bf16_t* zwn = zn + RW0_;
      const float* mu = p.rwkv_mu + (size_t)l * COLS_RWKV_;
      for (int e = lane; e < COLS_RWKV_; e += 64) {
        const float zc = bf2f(zw[e]); const float pv = hasp ? bf2f(zwp[e]) : 0.f; const float nv = hasn ? bf2f(zwn[e]) : 0.f;
        ws[e] = zc + mu[e] * (0.5f * (pv + nv) - zc);
      }
      __builtin_amdgcn_wave_barrier();
      for (int j = lane; j < DLORA_; j += 64) ws[3 * GWID_ + j] = tanhf(ws[3 * GWID_ + j]);
      for (int j = lane; j < GLORA_; j += 64) ws[3 * GWID_ + DLORA_ + ALORA_ + j] = sigmoidf_(ws[3 * GWID_ + DLORA_ + ALORA_ + j]);
      __builtin_amdgcn_wave_barrier();
      const float* zs = ws;
      const float* w2 = p.rwkv_w2 + (size_t)l * 2 * DLORA_ * GWID_; const float* a2 = p.rwkv_a2 + (size_t)l * 2 * ALORA_ * GWID_; const float* g2 = p.rwkv_g2 + (size_t)l * GLORA_ * GWID_;
      float bon[GWID_ / 64];
#pragma unroll
      for (int i = 0; i < GWID_ / 64; ++i) {
        const int ch = i * 64 + lane;
        const float rr = zs[ch], kk0 = zs[GWID_ + ch], vvv = zs[2 * GWID_ + ch];
        const float kkr = kk0 * p.rwkv_k_k[l * GWID_ + ch];
        float s2 = kkr * kkr;
        for (int m = 1; m < HD_ && m < 64; m <<= 1) s2 += __shfl_xor(s2, m);
        const float kkn = kkr * rsqrtf(s2 + 1e-12f);
        float gacc = 0.f;
#pragma unroll 4
        for (int j = 0; j < GLORA_; ++j) gacc += zs[3 * GWID_ + DLORA_ + ALORA_ + j] * g2[j * GWID_ + ch];
        float ksum = 0.f;
#pragma unroll 1
        for (int d = 0; d < 2; ++d) {
          float lw = p.rwkv_w0[(l * 2 + d) * GWID_ + ch], la = p.rwkv_a0[(l * 2 + d) * GWID_ + ch];
#pragma unroll 4
          for (int j = 0; j < DLORA_; ++j) lw += zs[3 * GWID_ + j] * w2[(d * DLORA_ + j) * GWID_ + ch];
#pragma unroll 4
          for (int j = 0; j < ALORA_; ++j) la += zs[3 * GWID_ + DLORA_ + j] * a2[(d * ALORA_ + j) * GWID_ + ch];
          const float sp = (-lw > 20.f) ? -lw : log1pf(expf(-lw));
          const float wdec = expf(-expf(-sp - 0.5f));
          const float a = sigmoidf_(la);
          const float kt = kk0 * (1.0f + (a - 1.0f) * p.rwkv_k_a[l * GWID_ + ch]);
          const size_t o = ((size_t)d * NROWS_ + row) * GWID_ + ch;
          p.sc_w[o] = wdec; p.sc_kka[o] = kkn * a; p.sc_kt[o] = kt; ksum += kt;
        }
        const size_t o = (size_t)row * GWID_ + ch;
        p.sc_r[o] = rr; p.sc_v[o] = vvv; p.sc_kk[o] = kkn; p.sc_gate[o] = gacc;
        float bs = rr * ksum * p.rwkv_r_k[l * GWID_ + ch];
        for (int m = 1; m < HD_ && m < 64; m <<= 1) bs += __shfl_xor(bs, m);
        bon[i] = bs;
      }
#pragma unroll
      for (int i = 0; i < GWID_ / 64; ++i) {
        const int ch = i * 64 + lane;
        if ((ch % HD_) == 0) p.sc_bonus[(size_t)row * NH_ + ch / HD_] = bon[i];
      }
      __builtin_amdgcn_wave_barrier();
    }
    {
      const bf16_t* zt = zr + RT0_;
      const int NR = HD_ / 2;
      const float* tab = p.tab_ret + (size_t)pos * 2 * NR;
      const float qs = 1.0f / sqrtf((float)HD_);
#pragma unroll
      for (int i = 0; i < GWID_ / 64; ++i) {
        const int ch = i * 64 + lane, hh = ch / HD_, e = ch % HD_;
        float q = bf2f(zt[ch]) * qs, k = bf2f(zt[GWID_ + ch]);
        if (isx) {
          const int fi = e % NR; const int half = e / NR;
          const int c1 = hh * HD_ + fi, c2 = c1 + NR;
          const float q1 = bf2f(zt[c1]) * qs, q2 = bf2f(zt[c2]) * qs, k1 = bf2f(zt[GWID_ + c1]), k2 = bf2f(zt[GWID_ + c2]);
          const float cs = tab[fi], sn = tab[NR + fi];
          q = half == 0 ? q1 * cs - q2 * sn : q1 * sn + q2 * cs;
          k = half == 0 ? k1 * cs - k2 * sn : k1 * sn + k2 * cs;
        }
        p.rq[(size_t)row * GWID_ + ch] = f2bf(q); p.rk[(size_t)row * GWID_ + ch] = f2bf(k); p.rv[(size_t)row * GWID_ + ch] = zt[2 * GWID_ + ch];
      }
    }
  }
}

__device__ __forceinline__ int chunk_row0(int b, int n) { return n < NCC_ ? NTOK_ + b * LC_ + n * RCH_ : b * L_ + (n - NCC_) * RCH_; }
__device__ __forceinline__ float ret_lg(int hh) { return log1pf(-exp2f(-5.0f - (float)hh)); }

__device__ __forceinline__ void phase_retd(const Params& p, int l) {
  const int tid = otid();
  const int nunits = B_ * NH_ * NCH_ * 2;
  for (int u = obid(); u < nunits; u += gridDim.x) {
    const int d = u & 1, n = (u >> 1) % NCH_, hh = ((u >> 1) / NCH_) % NH_, b = (u >> 1) / (NCH_ * NH_);
    const int r0 = chunk_row0(b, n);
    const float lg = ret_lg(hh);
    float* o = p.rd + ((((size_t)b * NH_ + hh) * NCH_ + n) * 2 + d) * HD_ * HD_;
    for (int e = tid; e < HD_ * HD_; e += NT) {
      const int kc = e / HD_, vc = e % HD_;
      float acc = 0.f;
      for (int c = 0; c < RCH_; ++c) {
        const float zeta = expf((d == 0 ? (float)(RCH_ - 1 - c) : (float)c) * lg);
        acc += zeta * bf2f(p.rk[(size_t)(r0 + c) * GWID_ + hh * HD_ + kc]) * bf2f(p.rv[(size_t)(r0 + c) * GWID_ + hh * HD_ + vc]);
      }
      o[e] = acc;
    }
  }
}

template <bool WITH_ATTN, bool WITH_SCAN> __device__ __forceinline__ void phase_mix(const Params& p, int l) {
  const int tid = otid(), wave = tid >> 6, lane = tid & 63;
  const bool last = (l == DEPTH_ - 1);
  for (int u = obid(); u < B_ * NH_ * 2; u += gridDim.x) {
    const int d = u & 1, hh = (u >> 1) % NH_, b = (u >> 1) / NH_;
    const float dec = expf((float)RCH_ * ret_lg(hh));
    for (int e = tid; e < HD_ * HD_; e += NT) {
      float st = 0.f;
      for (int i = 0; i < NCH_; ++i) {
        int n;
        if (d == 0) n = i; else n = i < NCC_ ? (NCC_ - 1 - i) : (NCC_ + (NCH_ - 1 - i));
        const size_t o = ((((size_t)b * NH_ + hh) * NCH_ + n) * 2 + d) * HD_ * HD_ + e;
        p.rs[o] = st;
        st = st * dec + p.rd[o];
      }
    }
  }
  if (WITH_SCAN) for (int u = obid() * NWAVE + wave; u < B_ * NH_ * 2; u += gridDim.x * NWAVE) {
    const int d = u & 1, hh = (u >> 1) % NH_, b = (u >> 1) / NH_;
    float s[HD_];
#pragma unroll
    for (int k = 0; k < HD_; ++k) s[k] = 0.f;
    const int vr = lane % HD_;
    for (int i = 0; i < LK_; ++i) {
      int row;
      if (d == 0) row = i < LC_ ? NTOK_ + b * LC_ + i : b * L_ + (i - LC_);
      else row = i < LC_ ? NTOK_ + b * LC_ + (LC_ - 1 - i) : b * L_ + (L_ - 1 - (i - LC_));
      const size_t o1 = (size_t)row * GWID_ + hh * HD_, o2 = ((size_t)d * NROWS_ + row) * GWID_ + hh * HD_;
      const float vt = p.sc_v[o1 + vr];
      float sa = 0.f;
#pragma unroll
      for (int k = 0; k < HD_; ++k) sa += s[k] * p.sc_kk[o1 + k];
      float yv = 0.f;
#pragma unroll
      for (int k = 0; k < HD_; ++k) { s[k] = s[k] * p.sc_w[o2 + k] - sa * p.sc_kka[o2 + k] + vt * p.sc_kt[o2 + k]; yv += s[k] * p.sc_r[o1 + k]; }
      if (lane < HD_) p.ys[o2 + vr] = yv;
    }
  }
  if (WITH_ATTN) {
    const int nq = last ? NTOK_ : NROWS_;
    for (int idx = obid() * NT + tid; idx < ((nq + NT - 1) / NT) * NT * NH_; idx += gridDim.x * NT) {
      const int blk = idx / (NT * NH_), rem = idx % (NT * NH_), hh = rem / NT, row = blk * NT + rem % NT;
      if (row >= nq) continue;
      const bool isx = row < NTOK_; const int b = row_batch(row);
      const int nk = isx ? LK_ : LC_;
      unsigned q[QK_ / 2]; float o[HD_];
      { const unsigned* qp = (const unsigned*)(p.qb + ((size_t)row * NH_ + hh) * QK_);
#pragma unroll
        for (int e = 0; e < QK_ / 2; ++e) q[e] = qp[e]; }
#pragma unroll
      for (int e = 0; e < HD_; ++e) o[e] = 0.f;
      float m = -1e30f, lsum = 0.f;
      const bf16_t* kbase = p.kb + ((size_t)b * NH_ + hh) * LK_ * KLD_; const bf16_t* vbase = p.vb + ((size_t)b * NH_ + hh) * LK_ * HD_;
      for (int j = 0; j < nk; ++j) {
        float sdot = 0.f;
        const unsigned* kp = (const unsigned*)(kbase + (size_t)j * KLD_);
#pragma unroll
        for (int e = 0; e < QK_ / 2; ++e) { const unsigned kq = kp[e], qq = q[e];
          union { unsigned u; float f; } a0, a1, b0, b1; a0.u = qq << 16; a1.u = qq & 0xFFFF0000u; b0.u = kq << 16; b1.u = kq & 0xFFFF0000u;
          sdot += a0.f * b0.f + a1.f * b1.f; }
        if (sdot > m) { const float corr = expf(m - sdot); lsum *= corr;
#pragma unroll
          for (int e = 0; e < HD_; ++e) o[e] *= corr;
          m = sdot; }
        const float pj = expf(sdot - m); lsum += pj;
#pragma unroll
        for (int e = 0; e < HD_; ++e) o[e] += pj * bf2f(vbase[(size_t)j * HD_ + e]);
      }
      const float il = 1.0f / lsum;
#pragma unroll
      for (int e = 0; e < HD_; ++e) p.ob[(size_t)row * GWID_ + hh * HD_ + e] = o[e] * il;
    }
  }
}


#ifndef CPU_EMU
namespace fa {
using bf16x8 = __attribute__((ext_vector_type(8))) short;
using s16x4  = __attribute__((ext_vector_type(4))) short;
using f32x16 = __attribute__((ext_vector_type(16))) float;
using u32x4  = __attribute__((ext_vector_type(4))) unsigned;
constexpr int NW = 8, QBLK = 32, KVBLK = 64, ND0 = QK_ / 16, NDV = HD_ / 32;
constexpr float THR = 8.f;
constexpr int LDQ = NH_ * QK_, LDKK = KLD_, LDV = HD_, LDO = GWID_;
constexpr size_t SHM_V = KVBLK * HD_ * 2, SHM_K = KVBLK * KLD_ * 2, SHM_ATTN = 2 * SHM_V + 2 * SHM_K + NW * 64 * 4;
#define KSWZ(row, colB) ((row) * 256 + ((colB) ^ (((row) & 7) << 4)))
#define SBAR() __builtin_amdgcn_sched_barrier(0)
__device__ __forceinline__ int crow(int r, int hi) { return (r & 3) + 8 * (r >> 2) + 4 * hi; }
__device__ __forceinline__ unsigned cvtpk(float lo, float hi) { unsigned r; asm volatile("v_cvt_pk_bf16_f32 %0, %1, %2" : "=v"(r) : "v"(lo), "v"(hi)); return r; }
__device__ __forceinline__ void partialSM(f32x16& p0, f32x16& p1, float& m_reg, float& mn, float& alpha) {
  constexpr float C = 1.4426950408889634f;
  float pmax = p0[0];
#pragma unroll
  for (int r = 1; r < 16; ++r) pmax = fmaxf(pmax, p0[r]);
#pragma unroll
  for (int r = 0; r < 16; ++r) pmax = fmaxf(pmax, p1[r]);
  { auto rr = __builtin_amdgcn_permlane32_swap(__float_as_uint(pmax), __float_as_uint(pmax), false, false);
    pmax = fmaxf(__uint_as_float(rr[0]), __uint_as_float(rr[1])); }
  if (__builtin_expect(__all(pmax - m_reg <= THR), 1)) { mn = m_reg; alpha = 1.f; }
  else { mn = fmaxf(m_reg, pmax); alpha = __builtin_amdgcn_exp2f((m_reg - mn) * C); m_reg = mn; }
  const float mnC = -mn * C;
#pragma unroll
  for (int r = 0; r < 16; ++r) p0[r] = fmaf(p0[r], C, mnC);
#pragma unroll
  for (int r = 0; r < 16; ++r) p1[r] = fmaf(p1[r], C, mnC);
#pragma unroll
  for (int r = 0; r < 16; ++r) p0[r] = __builtin_amdgcn_exp2f(p0[r]);
}
__device__ __forceinline__ void finishSM(f32x16& p0, f32x16& p1, float alpha, float& l_reg, bf16x8& pa0, bf16x8& pa1, bf16x8& pa2, bf16x8& pa3) {
#pragma unroll
  for (int r = 0; r < 16; ++r) p1[r] = __builtin_amdgcn_exp2f(p1[r]);
  float ps = 0;
#pragma unroll
  for (int r = 0; r < 16; ++r) ps += p0[r];
#pragma unroll
  for (int r = 0; r < 16; ++r) ps += p1[r];
  { auto rr = __builtin_amdgcn_permlane32_swap(__float_as_uint(ps), __float_as_uint(ps), false, false);
    ps = __uint_as_float(rr[0]) + __uint_as_float(rr[1]); }
  l_reg = l_reg * alpha + ps;
#define PK4(P, BASE, OUT) do { unsigned a0 = cvtpk(P[BASE + 0], P[BASE + 1]), a1 = cvtpk(P[BASE + 2], P[BASE + 3]);   \
    unsigned b0 = cvtpk(P[BASE + 4], P[BASE + 5]), b1 = cvtpk(P[BASE + 6], P[BASE + 7]);                              \
    auto r0 = __builtin_amdgcn_permlane32_swap(a0, b0, false, false); auto r1 = __builtin_amdgcn_permlane32_swap(a1, b1, false, false); \
    u32x4 w = {r0[0], r1[0], r0[1], r1[1]}; OUT = *reinterpret_cast<bf16x8*>(&w); } while (0)
  PK4(p0, 0, pa0); PK4(p0, 8, pa1); PK4(p1, 0, pa2); PK4(p1, 8, pa3);
#undef PK4
}
__device__ __forceinline__ void qkt(f32x16& p0, f32x16& p1, const char* Ks, const bf16x8* qr, int r32, int hi) {
  p0 = f32x16{}; p1 = f32x16{};
#pragma unroll
  for (int d0 = 0; d0 < ND0; ++d0) { const int cb = (d0 * 16 + hi * 8) * 2;
    bf16x8 b0 = *reinterpret_cast<const bf16x8*>(Ks + KSWZ(r32, cb));
    bf16x8 b1 = *reinterpret_cast<const bf16x8*>(Ks + KSWZ(32 + r32, cb));
    p0 = __builtin_amdgcn_mfma_f32_32x32x16_bf16(b0, qr[d0], p0, 0, 0, 0);
    p1 = __builtin_amdgcn_mfma_f32_32x32x16_bf16(b1, qr[d0], p1, 0, 0, 0); }
}
__device__ __forceinline__ int v_st(int k, int c) { const int kk = (k & ~0xC) | ((k & 4) << 1) | ((k & 8) >> 1); return ((kk >> 3) * NDV + (c >> 5)) * 512 + ((kk & 7) * 32 + (c & 31)) * 2; }
__device__ __forceinline__ int v_rd_base(int lane) { return ((lane & 3) << 3) | (((lane >> 2) & 3) << 6) | (((lane >> 4) & 1) << 5) | (((lane >> 5) & 1) << 8); }
constexpr int v_rd_off(int d0, int ks, int half) { return d0 * 512 + ks * (2 * NDV * 512) + half * (NDV * 512); }
template <int OFF> __device__ __forceinline__ s16x4 tr_read(int vb) { s16x4 r; asm volatile("ds_read_b64_tr_b16 %0, %1 offset:%2" : "=&v"(r) : "v"(vb), "i"(OFF) : "memory"); return r; }
template <int D0> __device__ __forceinline__ void pv_one(f32x16& od, int vb, bf16x8 pa0, bf16x8 pa1, bf16x8 pa2, bf16x8 pa3) {
  const s16x4 l0 = tr_read<v_rd_off(D0, 0, 0)>(vb), h0 = tr_read<v_rd_off(D0, 0, 1)>(vb), l1 = tr_read<v_rd_off(D0, 1, 0)>(vb), h1 = tr_read<v_rd_off(D0, 1, 1)>(vb);
  const s16x4 l2 = tr_read<v_rd_off(D0, 2, 0)>(vb), h2 = tr_read<v_rd_off(D0, 2, 1)>(vb), l3 = tr_read<v_rd_off(D0, 3, 0)>(vb), h3 = tr_read<v_rd_off(D0, 3, 1)>(vb);
  asm volatile("s_waitcnt lgkmcnt(0)" ::: "memory"); SBAR();
#define PK(L, H) (bf16x8){L[0], L[1], L[2], L[3], H[0], H[1], H[2], H[3]}
  od = __builtin_amdgcn_mfma_f32_32x32x16_bf16(pa0, PK(l0, h0), od, 0, 0, 0);
  od = __builtin_amdgcn_mfma_f32_32x32x16_bf16(pa1, PK(l1, h1), od, 0, 0, 0);
  od = __builtin_amdgcn_mfma_f32_32x32x16_bf16(pa2, PK(l2, h2), od, 0, 0, 0);
  od = __builtin_amdgcn_mfma_f32_32x32x16_bf16(pa3, PK(l3, h3), od, 0, 0, 0);
#undef PK
}
__device__ __forceinline__ void pv_d0(f32x16* o, int vb, bf16x8 pa0, bf16x8 pa1, bf16x8 pa2, bf16x8 pa3) {
  pv_one<0>(o[0], vb, pa0, pa1, pa2, pa3); pv_one<1>(o[1], vb, pa0, pa1, pa2, pa3);
}
__device__ __forceinline__ void attn_body(const bf16_t* __restrict__ Qb, const bf16_t* __restrict__ Kh, const bf16_t* __restrict__ Vh, float* __restrict__ Ob, int seq, char* lds) {
  const int tid = otid(), wid = tid >> 6, lane = tid & 63, r32 = lane & 31, hi = lane >> 5;
  char* V_lds = lds; char* K_lds = lds + 2 * SHM_V;
  float* ws = (float*)(lds + 2 * SHM_V + 2 * SHM_K) + wid * 64; float* li_l = ws; float* al_l = ws + 32;
  float m_reg = -1e30f, l_reg = 0; f32x16 o[NDV] = {}; bf16x8 qr[ND0];
  const bf16_t* Qw = Qb + (long)(wid * QBLK + r32) * LDQ + hi * 8;
#pragma unroll
  for (int d0 = 0; d0 < ND0; ++d0) qr[d0] = *reinterpret_cast<const bf16x8*>(Qw + d0 * 16);
  const int sr = tid >> 4, sc = (tid & 15) * 8;
  const int vr = tid >> 3, vc = (tid & 7) * 8, vst0 = v_st(vr, vc);
  const int vb0 = (int)(uintptr_t)V_lds + v_rd_base(lane);
  struct { bf16x8 vs0, ks0, ks1; } sr_[2];
#define SLOAD(i, k0) do { sr_[i].vs0 = *reinterpret_cast<const bf16x8*>(&Vh[(long)((k0) + vr) * LDV + vc]); \
    sr_[i].ks0 = *reinterpret_cast<const bf16x8*>(&Kh[(long)((k0) + sr) * LDKK + sc]); sr_[i].ks1 = *reinterpret_cast<const bf16x8*>(&Kh[(long)((k0) + 32 + sr) * LDKK + sc]); } while (0)
#define SWRITE(b, i) do { *(bf16x8*)(V_lds + (b) * SHM_V + vst0) = sr_[i].vs0; const int kc = sc * 2;               \
    *(bf16x8*)(K_lds + (b) * SHM_K + KSWZ(sr, kc)) = sr_[i].ks0;                       \
    *(bf16x8*)(K_lds + (b) * SHM_K + KSWZ(32 + sr, kc)) = sr_[i].ks1; } while (0)
#define SWAIT() asm volatile("s_waitcnt vmcnt(3)" ::: "memory")
#define RESC(a) do { if (__any((a) < 1.f)) { if (hi == 0) al_l[r32] = (a); asm volatile("s_waitcnt lgkmcnt(0)" ::: "memory"); \
    _Pragma("unroll") for (int d = 0; d < NDV; ++d) _Pragma("unroll") for (int r = 0; r < 16; ++r) o[d][r] *= al_l[crow(r, hi)]; } } while (0)
  f32x16 pA0, pA1, pB0, pB1; float mnA, mnB, alA, alB; bf16x8 pa0, pa1, pa2, pa3; const int NTL = seq / KVBLK;
  constexpr int SE = 0, SO = 1;
  SLOAD(SE, 0); asm volatile("s_waitcnt vmcnt(0)" ::: "memory"); SWRITE(0, SE); __syncthreads();
  qkt(pA0, pA1, K_lds, qr, r32, hi); partialSM(pA0, pA1, m_reg, mnA, alA);
  SLOAD(SO, KVBLK); if (2 < NTL) SLOAD(SE, 2 * KVBLK);
  SWAIT(); SWRITE(1, SO); __syncthreads();
  for (int j = 1; j + 1 < NTL; j += 2) {
    SBAR(); qkt(pB0, pB1, K_lds + SHM_K, qr, r32, hi);
    finishSM(pA0, pA1, alA, l_reg, pa0, pa1, pa2, pa3); SBAR();
    SLOAD(SO, (j + 2) * KVBLK); SBAR();
    pv_d0(o, vb0, pa0, pa1, pa2, pa3); partialSM(pB0, pB1, m_reg, mnB, alB);
    __syncthreads(); SWAIT(); SWRITE(0, SE);
    RESC(alB); __syncthreads();
    SBAR(); qkt(pA0, pA1, K_lds, qr, r32, hi);
    finishSM(pB0, pB1, alB, l_reg, pa0, pa1, pa2, pa3); SBAR();
    if (j + 3 < NTL) SLOAD(SE, (j + 3) * KVBLK); SBAR();
    pv_d0(o, vb0 + (int)SHM_V, pa0, pa1, pa2, pa3); partialSM(pA0, pA1, m_reg, mnA, alA);
    __syncthreads(); SWAIT(); SWRITE(1, SO);
    RESC(alA); __syncthreads();
  }
  SBAR(); qkt(pB0, pB1, K_lds + SHM_K, qr, r32, hi);
  finishSM(pA0, pA1, alA, l_reg, pa0, pa1, pa2, pa3); SBAR();
  pv_d0(o, vb0, pa0, pa1, pa2, pa3); partialSM(pB0, pB1, m_reg, mnB, alB);
  __syncthreads(); RESC(alB);
  finishSM(pB0, pB1, alB, l_reg, pa0, pa1, pa2, pa3); SBAR();
  pv_d0(o, vb0 + (int)SHM_V, pa0, pa1, pa2, pa3);
  if (hi == 0) li_l[r32] = l_reg; asm volatile("s_waitcnt lgkmcnt(0)" ::: "memory");
  float rli[16];
#pragma unroll
  for (int r = 0; r < 16; ++r) rli[r] = __builtin_amdgcn_rcpf(li_l[crow(r, hi)]);
  float* Ow = Ob + (long)(wid * QBLK) * LDO;
#pragma unroll
  for (int r = 0; r < 16; ++r) { const int orow = crow(r, hi);
#pragma unroll
    for (int d0 = 0; d0 < NDV; ++d0) Ow[(long)orow * LDO + d0 * 32 + r32] = o[d0][r] * rli[r]; }
#undef SLOAD
#undef SWRITE
#undef SWAIT
#undef RESC
}
}

__device__ __forceinline__ void phase_attn(const Params& p, int l) {
  const bool last = (l == DEPTH_ - 1);
  const int c = obid(), G = gridDim.x;
  const int nx = B_ * NH_ * (L_ / 256), nc = last ? 0 : B_ * NH_ * (LC_ / 256);
  char* lds = (char*)SMEM_PTR();
  for (int i = 0; i * G + c < nx + nc; ++i) {
    const int u = i * G + c;
    int b, hh, r0, seq;
    if (u < nx) {
      int pair, qb;
      if (G == 256) { pair = i * 16 + 2 * (c & 7) + ((c >> 3) >> 4); qb = (c >> 3) & 15; } else { pair = u / (L_ / 256); qb = u % (L_ / 256); }
      b = pair / NH_; hh = pair % NH_; r0 = b * L_ + qb * 256; seq = LK_;
    } else { const int v = u - nx; hh = v % NH_; b = v / NH_; r0 = NTOK_ + b * LC_; seq = LC_; }
    __syncthreads();
    fa::attn_body(p.qb + ((size_t)r0 * NH_ + hh) * QK_, p.kb + ((size_t)b * NH_ + hh) * LK_ * KLD_, p.vb + ((size_t)b * NH_ + hh) * LK_ * HD_, p.ob + (size_t)r0 * GWID_ + hh * HD_, seq, lds);
  }
  __syncthreads();
}
#endif


#ifndef CPU_EMU
namespace sc {
typedef float f2 __attribute__((ext_vector_type(2)));
typedef float f4 __attribute__((ext_vector_type(4)));
constexpr int CH = 32, NCHK = LK_ / CH, VECB = CH * HD_ * 4, VOFF = 5 * VECB, BUFB = VOFF + CH * 16 * 4;
static_assert(3 * BUFB <= XBW_OFF_, "scan ring fits LDS");
template <int CTRL> __device__ __forceinline__ float dpp_add(float v) {
  return v + __builtin_bit_cast(float, __builtin_amdgcn_update_dpp(0, __builtin_bit_cast(int, v), CTRL, 0xF, 0xF, true));
}
__device__ __forceinline__ float allreduce16(float v) { v = dpp_add<0xB1>(v); v = dpp_add<0x4E>(v); v = dpp_add<0x141>(v); v = dpp_add<0x140>(v); return v; }
__device__ __forceinline__ int step_row(int s, int b, int d) {
  if (d == 0) return s < LC_ ? NTOK_ + b * LC_ + s : b * L_ + (s - LC_);
  return s < LC_ ? NTOK_ + b * LC_ + (LC_ - 1 - s) : b * L_ + (L_ - 1 - (s - LC_));
}
struct In { f4 kk, kka, w, kt, r; float v; };
}
__device__ __forceinline__ void phase_scan(const Params& p, int l, LAS unsigned char* lds) {
  using namespace sc;
  (void)l;
  const int tid = otid(), wid = __builtin_amdgcn_readfirstlane(tid >> 6), lane = tid & 63;
  const int G = gridDim.x;
  for (int u = obid(); u < B_ * NH_ * 2 * 4; u += G) {
    const int rg = (u >> 3) & 3, pi = (u & 7) + 8 * (u >> 5), d = pi & 1, hh = (pi >> 1) % NH_, b = pi / (2 * NH_);
    __syncthreads();
    if (wid >= 4) {
      const int lw = wid - 4;
      const size_t doff = (size_t)d * NROWS_ * GWID_;
      const float* b0 = p.sc_kk + hh * HD_ + (lane & 15) * 4;
      const float* b1 = p.sc_kka + doff + hh * HD_ + (lane & 15) * 4;
      const float* b2 = p.sc_w + doff + hh * HD_ + (lane & 15) * 4;
      const float* b3 = p.sc_kt + doff + hh * HD_ + (lane & 15) * 4;
      const float* b4 = p.sc_r + hh * HD_ + (lane & 15) * 4;
      const float* bv = p.sc_v + hh * HD_ + rg * 16 + (lane & 3) * 4;
#define SC_ISSUE(chunk) do { const int _ck = (chunk); LAS unsigned char* _buf = lds + (_ck % 3) * BUFB; \
        _Pragma("unroll") for (int k = 0; k < 10; ++k) { const int tg = (k & 1) * 4 + lw; const int srow = step_row(_ck * CH + tg * 4 + (lane >> 4), b, d); \
          const float* bp = (k >> 1) == 0 ? b0 : (k >> 1) == 1 ? b1 : (k >> 1) == 2 ? b2 : (k >> 1) == 3 ? b3 : b4; \
          __builtin_amdgcn_global_load_lds((const unsigned*)(bp + (size_t)srow * GWID_), (LAS unsigned*)(_buf + (k >> 1) * VECB + tg * 1024), 16, 0, 0); } \
        if (lw < 2) { const int srow = step_row(_ck * CH + lw * 16 + (lane >> 2), b, d); \
          __builtin_amdgcn_global_load_lds((const unsigned*)(bv + (size_t)srow * GWID_), (LAS unsigned*)(_buf + VOFF + lw * 1024), 16, 0, 0); } } while (0)
#define SC_WAITK() do { if (lw < 2) asm volatile("s_waitcnt vmcnt(11)" ::: "memory"); else asm volatile("s_waitcnt vmcnt(10)" ::: "memory"); } while (0)
      SC_ISSUE(0); SC_ISSUE(1);
      SC_WAITK();
      __builtin_amdgcn_s_barrier();
      for (int ck = 0; ck < NCHK; ++ck) {
        if (ck + 2 < NCHK) { SC_ISSUE(ck + 2); SC_WAITK(); } else asm volatile("s_waitcnt vmcnt(0)" ::: "memory");
        __builtin_amdgcn_s_barrier();
      }
#undef SC_ISSUE
#undef SC_WAITK
    } else {
      const int seg = lane & 15, rowl = wid * 4 + (lane >> 4);
      f2 s01 = {0.f, 0.f}, s23 = {0.f, 0.f};
      float* yb = p.ys + (size_t)d * NROWS_ * GWID_ + hh * HD_ + rg * 16 + rowl;
      __builtin_amdgcn_s_barrier();
      for (int ck = 0; ck < NCHK; ++ck) {
        const LAS unsigned char* buf = lds + (ck % 3) * BUFB;
        const LAS unsigned char* vb = buf + seg * 16;
        const LAS unsigned char* vv = buf + VOFF + rowl * 4;
        const int row0 = step_row(ck * CH, b, d);
        const long rstep = d == 0 ? (long)GWID_ : -(long)GWID_;
        float* yp = yb + (size_t)row0 * GWID_;
        In in[2];
#define SC_LOAD(dst, t) do { dst.kk = *(const LAS f4*)(vb + 0 * VECB + (t) * 256); dst.kka = *(const LAS f4*)(vb + 1 * VECB + (t) * 256); dst.w = *(const LAS f4*)(vb + 2 * VECB + (t) * 256); \
          dst.kt = *(const LAS f4*)(vb + 3 * VECB + (t) * 256); dst.r = *(const LAS f4*)(vb + 4 * VECB + (t) * 256); dst.v = *(const LAS float*)(vv + (t) * 64); } while (0)
        SC_LOAD(in[0], 0);
#pragma unroll
        for (int t = 0; t < CH; ++t) {
          if (t + 1 < CH) SC_LOAD(in[(t + 1) & 1], t + 1);
          const In& x = in[t & 1];
          f2 p2 = s01 * (f2){x.kk[0], x.kk[1]}; p2 = s23 * (f2){x.kk[2], x.kk[3]} + p2;
          float sa = allreduce16(p2[0] + p2[1]);
          const f2 vv2 = {x.v, x.v};
          s01 = s01 * (f2){x.w[0], x.w[1]} + vv2 * (f2){x.kt[0], x.kt[1]};
          s23 = s23 * (f2){x.w[2], x.w[3]} + vv2 * (f2){x.kt[2], x.kt[3]};
          const f2 nsa = {-sa, -sa};
          s01 = nsa * (f2){x.kka[0], x.kka[1]} + s01;
          s23 = nsa * (f2){x.kka[2], x.kka[3]} + s23;
          f2 y2 = s01 * (f2){x.r[0], x.r[1]}; y2 = s23 * (f2){x.r[2], x.r[3]} + y2;
          const float yy = allreduce16(y2[0] + y2[1]);
          if (seg == 0) yp[(long)t * rstep] = yy;
        }
#undef SC_LOAD
        __builtin_amdgcn_s_barrier();
      }
    }
  }
  __syncthreads();
}
#endif

__device__ __forceinline__ void phase_post(const Params& p, int l) {
  float (*sm)[RCH_ + 2 * HD_] = (float (*)[RCH_ + 2 * HD_])SMEM_PTR();
  const int tid = otid(), wave = tid >> 6, lane = tid & 63;
  float* ws = sm[wave];
  const bool last = (l == DEPTH_ - 1);
  const int nrow = last ? NTOK_ : NROWS_;
  for (int row = obid() * NWAVE + wave; row < nrow; row += gridDim.x * NWAVE) {
    const int pos = row_pos(row), b = row_batch(row); const bool isx = row < NTOK_;
    {
      float t[GWID_ / 64]; float ss = 0.f;
#pragma unroll
      for (int i = 0; i < GWID_ / 64; ++i) { t[i] = p.ob[(size_t)row * GWID_ + i * 64 + lane]; ss += t[i] * t[i]; }
      ss = wave_sum(ss); const float rstd = rsqrtf(ss / (float)GWID_ + 1e-6f);
#pragma unroll
      for (int i = 0; i < GWID_ / 64; ++i) p.y[(size_t)row * D_ + GWID_ + i * 64 + lane] = f2bf(t[i] * rstd * p.g_out_mla[l * GWID_ + i * 64 + lane]);
    }
    {
#pragma unroll
      for (int i = 0; i < GWID_ / 64; ++i) {
        const int ch = i * 64 + lane; const size_t o = (size_t)row * GWID_ + ch;
        const float yv = p.ys[o] + p.ys[(size_t)NROWS_ * GWID_ + o];
        float s1 = yv;
        for (int m = 1; m < HD_ && m < 64; m <<= 1) s1 += __shfl_xor(s1, m);
        const float mean = s1 / (float)HD_;
        const float dv = yv - mean; float s2 = dv * dv;
        for (int m = 1; m < HD_ && m < 64; m <<= 1) s2 += __shfl_xor(s2, m);
        const float var = s2 / (float)HD_;
        float r = dv * rsqrtf(var + 64e-5f) * p.g_ln_x[l * GWID_ + ch];
        r += p.sc_bonus[(size_t)row * NH_ + ch / HD_] * p.sc_v[o];
        p.y[(size_t)row * D_ + 2 * GWID_ + ch] = f2bf(r * p.sc_gate[o]);
      }
    }
    {
      const int n = isx ? NCC_ + pos / RCH_ : pos / RCH_, c = pos % RCH_;
      const int r0 = chunk_row0(b, n);
      for (int hh = 0; hh < NH_; ++hh) {
        const float lg = ret_lg(hh);
        for (int j = lane; j < RCH_; j += 64) {
          float sdot = 0.f;
          for (int e = 0; e < HD_; ++e) sdot += bf2f(p.rq[(size_t)row * GWID_ + hh * HD_ + e]) * bf2f(p.rk[(size_t)(r0 + j) * GWID_ + hh * HD_ + e]);
          const int dist = c > j ? c - j : j - c;
          ws[j] = sdot * expf((float)dist * lg);
        }
        for (int e = lane; e < HD_; e += 64) ws[RCH_ + e] = bf2f(p.rq[(size_t)row * GWID_ + hh * HD_ + e]);
        __builtin_amdgcn_wave_barrier();
        float yv = 0.f;
        const int vc = lane % HD_;
        for (int j = 0; j < RCH_; ++j) yv += ws[j] * bf2f(p.rv[(size_t)(r0 + j) * GWID_ + hh * HD_ + vc]);
        const float xf = expf((float)(c + 1) * lg), xb = expf((float)(RCH_ - c) * lg);
        const float* sf = p.rs + ((((size_t)b * NH_ + hh) * NCH_ + n) * 2 + 0) * HD_ * HD_;
        const float* sb = sf + HD_ * HD_;
        float cf = 0.f, cb = 0.f;
        for (int k = 0; k < HD_; ++k) { const float qk = ws[RCH_ + k]; cf += qk * sf[k * HD_ + vc]; cb += qk * sb[k * HD_ + vc]; }
        yv += xf * cf + xb * cb;
        float s2 = yv * yv;
        for (int m = 1; m < HD_ && m < 64; m <<= 1) s2 += __shfl_xor(s2, m);
        const float rstd = rsqrtf(s2 / (float)HD_ + 1e-6f);
        const int ch = hh * HD_ + vc;
        const float g = bf2f(p.z[(size_t)row * ZLD_ + RT0_ + 3 * GWID_ + ch]);
        if (lane < HD_) p.y[(size_t)row * D_ + 3 * GWID_ + ch] = f2bf(siluf_(g) * yv * rstd * p.g_ret_norm[l * GWID_ + ch]);
        __builtin_amdgcn_wave_barrier();
      }
    }
  }
}

__device__ __forceinline__ void phase_topk(const Params& p, int l) {
  unsigned* vals = (unsigned*)SMEM_PTR();
  int* hist = (int*)(vals + (L_ > LC_ ? L_ : LC_));
  int* scan_gt = hist + 256; int* scan_eq = scan_gt + NT + 1;
  unsigned& s_prefix = *(unsigned*)(scan_eq + NT + 1); int& s_need = *(scan_eq + NT + 2);
  const int tid = otid();
  const bool last = (l == DEPTH_ - 1);
  const int nunits = (last ? B_ : 2 * B_) * NEXP_;
  for (int u = obid(); u < nunits; u += gridDim.x) {
    const int e = u % NEXP_, set = u / NEXP_; const bool isx = set < B_; const int b = isx ? set : set - B_;
    const int N = isx ? L_ : LC_, cap = isx ? CAP_ : CAPC_;
    const int row0 = isx ? b * L_ : NTOK_ + b * LC_;
    __syncthreads();
    for (int i = tid; i < N; i += NT) { union { float f; unsigned u; } x; x.f = p.aff[(size_t)(row0 + i) * NEXP_ + e]; vals[i] = x.u; }
    if (tid == 0) { s_prefix = 0u; s_need = cap; }
    __syncthreads();
    for (int pass = 0; pass < 4; ++pass) {
      const int shift = 24 - 8 * pass;
      for (int i = tid; i < 256; i += NT) hist[i] = 0;
      __syncthreads();
      const unsigned prefix = s_prefix; const unsigned himask = pass == 0 ? 0u : (0xFFFFFFFFu << (shift + 8));
      for (int i = tid; i < N; i += NT) { const unsigned v = vals[i]; if ((v & himask) == prefix) atomicAdd(&hist[(v >> shift) & 255], 1); }
      __syncthreads();
      if (tid == 0) {
        int need = s_need, bin = 255;
        for (; bin > 0; --bin) { if (hist[bin] >= need) break; need -= hist[bin]; }
        s_prefix = prefix | ((unsigned)bin << shift); s_need = need;
      }
      __syncthreads();
    }
    const unsigned T = s_prefix; const int need_eq = s_need;
    const int per = (N + NT - 1) / NT;
    int cg = 0, ce = 0;
    for (int j = 0; j < per; ++j) { const int i = tid * per + j; if (i < N) { const unsigned v = vals[i]; cg += v > T; ce += v == T; } }
    scan_gt[tid + 1] = cg; scan_eq[tid + 1] = ce;
    __syncthreads();
    if (tid == 0) { scan_gt[0] = 0; scan_eq[0] = 0; for (int i = 1; i <= NT; ++i) { scan_gt[i] += scan_gt[i - 1]; scan_eq[i] += scan_eq[i - 1]; } }
    __syncthreads();
    int rg = scan_gt[tid], re = scan_eq[tid];
    const int slot0 = isx ? (e * B_ + b) * CAP_ : XSLOTS_ + (e * B_ + b) * CAPC_;
    for (int j = 0; j < per; ++j) {
      const int i = tid * per + j; if (i >= N) break;
      const unsigned v = vals[i];
      int slot = -1;
      if (v > T) { slot = rg + (re < need_eq ? re : need_eq); ++rg; }
      else if (v == T) { if (re < need_eq) slot = rg + re; ++re; }
      if (slot >= 0) { union { float f; unsigned u; } x; x.u = v; p.sel_idx[slot0 + slot] = row0 + i; p.sel_gate[slot0 + slot] = x.f; }
      p.inv[(size_t)(row0 + i) * NEXP_ + e] = slot >= 0 ? slot0 + slot : -1;
    }
  }
}

#ifndef CPU_EMU
#define XB_SPIN_CAP (1u << 24)
#endif
__device__ __forceinline__ void grid_sync(const Params& p) { (void)p; }

template <int PH> __device__ __forceinline__ void run_phase(const Params& p, int l) {
  if (PH == PH_MOD) phase_mod(p);
  if (PH == PH_NORM1) phase_norm<0>(p, l);
  if (PH == PH_GEMM_IN) phase_gemm_in(p, l);
  if (PH == PH_PREP) phase_prep(p, l);
  if (PH == PH_RETD) phase_retd(p, l);
  if (PH == PH_MIX) phase_mix<true, true>(p, l);
  if (PH == PH_POST) phase_post(p, l);
  if (PH == PH_GEMM_OUT) phase_gemm_out(p, l);
  if (PH == PH_NORM2) phase_norm<1>(p, l);
  if (PH == PH_TOPK) phase_topk(p, l);
  if (PH == PH_MOE1) phase_moe1(p, l);
  if (PH == PH_MOE2) phase_moe2(p, l);
  if (PH == PH_FINAL) phase_norm<2>(p, l);
}
template <int PH> __global__ void __launch_bounds__(NT) k_phase(Params p, int l) { run_phase<PH>(p, l); }

#ifndef CPU_EMU
#define XB_TMO      128
#define XB_XCNT(j)  (256  + 64 * (j))
#define XB_XSUB(j)  (1280 + 64 * (j))
#define XB_XGEN(j)  (2304 + 64 * (j))
#define XB_TOP      3328
#define XB_TOPGEN   3392
#define XCD_BAR_WORDS 3456
#define XB_SPIN_CAP (1u << 23)
__device__ __forceinline__ unsigned xb_ld(unsigned* p)              { return __hip_atomic_load(p, __ATOMIC_RELAXED, __HIP_MEMORY_SCOPE_AGENT); }
__device__ __forceinline__ unsigned xb_add(unsigned* p, unsigned v) { return __hip_atomic_fetch_add(p, v, __ATOMIC_RELAXED, __HIP_MEMORY_SCOPE_AGENT); }
__device__ __forceinline__ unsigned xb_xcc_id() { return (unsigned)__builtin_amdgcn_s_getreg((3 << 11) | 20) & 0xFu; }
#define XB_SPIN(cond, bar) do { unsigned _sp = 0; while (cond) { __builtin_amdgcn_s_sleep(1); \
    if ((++_sp & 255u) == 0u) { if (xb_ld(&(bar)[XB_TMO])) break; if (_sp > XB_SPIN_CAP) { atomicAdd(&(bar)[XB_TMO], 1u); break; } } } } while (0)
struct XcdBarrier { unsigned* bar; unsigned x; volatile LAS unsigned* st; };
__device__ __forceinline__ XcdBarrier xcd_barrier_post(unsigned* bar, volatile LAS unsigned* st) {
    XcdBarrier b; b.bar = bar; b.x = xb_xcc_id(); b.st = st;
    if (threadIdx.x == 0) (void)xb_add(&bar[XB_XCNT(b.x)], 1u);
    return b;
}
__device__ __forceinline__ void xcd_barrier_complete(unsigned* bar, unsigned x, unsigned& nloc, unsigned& nx) {
    const unsigned G = gridDim.x * gridDim.y * gridDim.z;
    unsigned sum, cnt, mine, sp = 0u;
    for (;;) {
        sum = 0u; cnt = 0u; mine = 0u;
#pragma unroll
        for (unsigned j = 0; j < 16; ++j) { const unsigned c = xb_ld(&bar[XB_XCNT(j)]); sum += c; cnt += (c > 0u) ? 1u : 0u; mine = (j == x) ? c : mine; }
        if (sum == G) break;
        __builtin_amdgcn_s_sleep(1);
        if ((++sp & 255u) == 0u) { if (xb_ld(&bar[XB_TMO])) break; if (sp > XB_SPIN_CAP) { atomicAdd(&bar[XB_TMO], 1u); break; } }
    }
    nloc = mine > 0u ? mine : 1u; nx = cnt > 0u ? cnt : 1u;
}
__device__ __forceinline__ void xcd_barrier(const XcdBarrier& b) {
    asm volatile("s_waitcnt vmcnt(0)" ::: "memory");
    __syncthreads();
    if (threadIdx.x == 0) {
        unsigned* bar = b.bar; unsigned bx = b.x;
        asm volatile("" : "+s"(bx));
        __builtin_amdgcn_s_waitcnt(0);
        unsigned nloc = b.st[0], nx = b.st[1];
        if (nloc == 0u) { xcd_barrier_complete(bar, bx, nloc, nx); b.st[0] = nloc; b.st[1] = nx; }
        const unsigned old = xb_add(&bar[XB_XSUB(bx)], 1u);
        const unsigned gen = old / nloc;
        if (old + 1u == (gen + 1u) * nloc) {
            __builtin_amdgcn_fence(__ATOMIC_RELEASE, "agent");
            asm volatile("s_waitcnt vmcnt(0)" ::: "memory");
            const unsigned og = xb_add(&bar[XB_TOP], 1u);
            const unsigned tg = og / nx;
            if (og + 1u == (tg + 1u) * nx) xb_add(&bar[XB_TOPGEN], 1u);
            else XB_SPIN(xb_ld(&bar[XB_TOPGEN]) == tg, bar);
            __builtin_amdgcn_fence(__ATOMIC_ACQUIRE, "agent");
            xb_add(&bar[XB_XGEN(bx)], 1u);
            asm volatile("s_waitcnt vmcnt(0)" ::: "memory");
        } else {
            XB_SPIN(xb_ld(&bar[XB_XGEN(bx)]) == gen, bar);
            __builtin_amdgcn_fence(__ATOMIC_ACQUIRE, "agent");
            asm volatile("s_waitcnt vmcnt(0)" ::: "memory");
        }
    }
    __syncthreads();
}
typedef const Params __attribute__((address_space(4))) * KParamsPtr;
__device__ __forceinline__ const Params& kparams() { KParamsPtr kp = (KParamsPtr)__builtin_amdgcn_kernarg_segment_ptr(); asm volatile("" : "+s"(kp)); return *(const Params*)kp; }
#define KP kparams()
__global__ void __launch_bounds__(NT, 2) mega(Params p_unused) {
  (void)p_unused;
  LAS unsigned char* lds = (LAS unsigned char*)smem_dyn;
  if (threadIdx.x < 4) ((LAS unsigned*)(lds + XBW_OFF_))[threadIdx.x] = 0u;
  __syncthreads();
  XcdBarrier bar = xcd_barrier_post(KP.bar, (volatile LAS unsigned*)(lds + XBW_OFF_));
  phase_mod(KP);
  phase_cvt_static(KP);
  xcd_barrier(bar);
  for (int l = 0; l < DEPTH_; ++l) {
    phase_norm<0>(KP, l); xcd_barrier(bar);
    phase_gemm_in_mfma(KP, l, lds); xcd_barrier(bar);
    phase_prep(KP, l); xcd_barrier(bar);
    phase_retd(KP, l); xcd_barrier(bar);
    phase_mix<false, false>(KP, l); phase_attn(KP, l); phase_scan(KP, l, lds); xcd_barrier(bar);
    phase_post(KP, l); xcd_barrier(bar);
    phase_gemm_out_mfma(KP, l, lds); xcd_barrier(bar);
    phase_norm<1>(KP, l); phase_cvt_moe(KP, l); xcd_barrier(bar);
    phase_topk(KP, l); xcd_barrier(bar);
    phase_moe1_mfma(KP, l, lds); xcd_barrier(bar);
    phase_moe2_mfma(KP, l, lds); xcd_barrier(bar);
  }
  phase_norm<2>(KP, DEPTH_ - 1);
}
#endif

#ifdef CPU_EMU
#define LAUNCH(PH, grid, p, l) emu_launch(dim3(grid), dim3(NT), LDS_BYTES_, [=]() { k_phase<PH>(p, l); })
#else
#define LAUNCH(PH, grid, p, l) hipLaunchKernelGGL(k_phase<PH>, dim3(grid), dim3(NT), LDS_BYTES_, stream, p, l)
#endif

static size_t align_up(size_t v) { return (v + 255) & ~(size_t)255; }

extern "C" void kernel_launch(void* const* d_in, const int* in_sizes, int n_in, void* d_out, int out_size, void* d_ws, size_t ws_size, hipStream_t stream) {
  (void)in_sizes; (void)n_in; (void)out_size; (void)ws_size;
  Params p;
  memset(&p, 0, sizeof(p));
  const float** ip = (const float**)&p.x;
  for (int i = 0; i < 34; ++i) ip[i] = (const float*)d_in[i];
  p.out = (float*)d_out;
  char* w = (char*)d_ws; size_t off = 0;
#define CARVE(field, type, count) do { p.field = (type*)(w + off); off = align_up(off + sizeof(type) * (size_t)(count)); } while (0)
  CARVE(bar, unsigned, 4096);
  CARVE(modv, float, (size_t)DEPTH_ * (B_ + 1) * 6 * D_);
  CARVE(xc, float, (size_t)NCTX_ * D_);
  CARVE(h, bf16_t, (size_t)NROWS_ * D_);
  CARVE(z, bf16_t, (size_t)NROWS_ * ZLD_);
  CARVE(y, bf16_t, (size_t)NROWS_ * D_);
  CARVE(qb, bf16_t, (size_t)NROWS_ * NH_ * QK_);
  CARVE(kb, bf16_t, (size_t)B_ * NH_ * LK_ * KLD_);
  CARVE(vb, bf16_t, (size_t)B_ * NH_ * LK_ * HD_);
  CARVE(sc_r, float, (size_t)NROWS_ * GWID_);
  CARVE(sc_v, float, (size_t)NROWS_ * GWID_);
  CARVE(sc_kk, float, (size_t)NROWS_ * GWID_);
  CARVE(sc_w, float, (size_t)2 * NROWS_ * GWID_);
  CARVE(sc_kka, float, (size_t)2 * NROWS_ * GWID_);
  CARVE(sc_kt, float, (size_t)2 * NROWS_ * GWID_);
  CARVE(sc_gate, float, (size_t)NROWS_ * GWID_);
  CARVE(sc_bonus, float, (size_t)NROWS_ * NH_);
  CARVE(ys, float, (size_t)2 * NROWS_ * GWID_);
  CARVE(ob, float, (size_t)NROWS_ * GWID_);
  CARVE(rq, bf16_t, (size_t)NROWS_ * GWID_);
  CARVE(rk, bf16_t, (size_t)NROWS_ * GWID_);
  CARVE(rv, bf16_t, (size_t)NROWS_ * GWID_);
  CARVE(rd, float, (size_t)B_ * NH_ * NCH_ * 2 * HD_ * HD_);
  CARVE(rs, float, (size_t)B_ * NH_ * NCH_ * 2 * HD_ * HD_);
  CARVE(tab_mla, float, (size_t)L_ * ROPE_);
  CARVE(tab_ret, float, (size_t)L_ * HD_);
  CARVE(aff, float, (size_t)NROWS_ * NEXP_);
  CARVE(sel_idx, int, (size_t)XSLOTS_ + CSLOTS_);
  CARVE(sel_gate, float, (size_t)XSLOTS_ + CSLOTS_);
  CARVE(inv, int, (size_t)NROWS_ * NEXP_);
  CARVE(wb_in, bf16_t, (size_t)DEPTH_ * ZLD_ * D_);
  CARVE(wb_out, bf16_t, (size_t)DEPTH_ * D_ * D_);
  p.hid = (bf16_t*)p.z;
  p.ye = (bf16_t*)p.sc_w;
  p.wb_moe1 = (bf16_t*)p.ys;
  p.wb_moe2 = p.wb_moe1 + (size_t)NEXP_ * 2 * D_ * D_;
#undef CARVE
#ifndef CPU_EMU
  {
    static int grid = 0;
    if (!grid) {
      int dev = 0, cus = 0, per_cu = 0;
      hipGetDevice(&dev);
      hipDeviceGetAttribute(&cus, hipDeviceAttributeMultiprocessorCount, dev);
      hipFuncSetAttribute((const void*)mega, hipFuncAttributeMaxDynamicSharedMemorySize, LDS_BYTES_);
      hipOccupancyMaxActiveBlocksPerMultiprocessor(&per_cu, mega, NT, LDS_BYTES_);
      grid = cus * (per_cu < 1 ? per_cu : 1);
    }
    hipMemsetAsync(p.bar, 0, XCD_BAR_WORDS * sizeof(unsigned), stream);
    hipLaunchKernelGGL(mega, dim3(grid), dim3(NT), LDS_BYTES_, stream, p);
    return;
  }
#else
  const int grid = 256;
  LAUNCH(PH_MOD, grid, p, 0);
  for (int l = 0; l < DEPTH_; ++l) {
    LAUNCH(PH_NORM1, grid, p, l);
    LAUNCH(PH_GEMM_IN, grid, p, l);
    LAUNCH(PH_PREP, grid, p, l);
    LAUNCH(PH_RETD, grid, p, l);
    LAUNCH(PH_MIX, grid, p, l);
    LAUNCH(PH_POST, grid, p, l);
    LAUNCH(PH_GEMM_OUT, grid, p, l);
    LAUNCH(PH_NORM2, grid, p, l);
    LAUNCH(PH_TOPK, grid, p, l);
    LAUNCH(PH_MOE1, grid, p, l);
    LAUNCH(PH_MOE2, grid, p, l);
    if (l == DEPTH_ - 1) LAUNCH(PH_FINAL, grid, p, l);
  }
#endif
}
```

```cpp
#include <hip/hip_runtime.h>
#include <stdint.h>
#include <math.h>
#include <string.h>

#if defined(MED_CFG)
#define D_ 1024
#define B_ 1
#define L_ 128
#define DEPTH_ 2
#define LC_ 128
#define GRIDW_ 64
#define HD_ 64
#define KVR_ 128
#define DLORA_ 64
#define ALORA_ 64
#define GLORA_ 128
#define NEXP_ 2
#elif defined(SMALL_CFG)
#define D_ 256
#define B_ 2
#define L_ 256
#define DEPTH_ 2
#define LC_ 128
#define GRIDW_ 64
#define HD_ 32
#define KVR_ 32
#define DLORA_ 16
#define ALORA_ 16
#define GLORA_ 32
#define NEXP_ 4
#else
#define D_ 1024
#define B_ 8
#define L_ 4096
#define DEPTH_ 4
#define LC_ 256
#define GRIDW_ 64
#define HD_ 64
#define KVR_ 128
#define DLORA_ 64
#define ALORA_ 64
#define GLORA_ 128
#define NEXP_ 16
#endif
#define CAPF_ 2
#define AUXW_ 384
#define ZS2W_ 1792
#define GWID_ (D_ / 4)
#define NH_ (GWID_ / HD_)
#define ROPE_ (HD_ / 2)
#define QK_ (HD_ + ROPE_)
#define NTOK_ (B_ * L_)
#define NCTX_ (B_ * LC_)
#define NROWS_ (NTOK_ + NCTX_)
#define LK_ (LC_ + L_)
#define COLS_MLA_ (NH_ * QK_ + KVR_ + ROPE_)
#define COLS_RWKV_ (3 * GWID_ + DLORA_ + ALORA_ + GLORA_)
#define MLA0_ (3 * GWID_)
#define RW0_ (MLA0_ + COLS_MLA_)
#define RT0_ (RW0_ + COLS_RWKV_)
#define INCOLS_ (RT0_ + 4 * GWID_)
#define ZLD_ (((INCOLS_ + 255) / 256) * 256)
#define CAP_ (CAPF_ * L_ / NEXP_)
#define CAPC_ (CAPF_ * LC_ / NEXP_)
#define XSLOTS_ (B_ * NEXP_ * CAP_)
#define CSLOTS_ (B_ * NEXP_ * CAPC_)
#define RCH_ 128
#define NCC_ (LC_ / RCH_)
#define NCX_ (L_ / RCH_)
#define NCH_ (NCC_ + NCX_)
#define KLD_ (((QK_ + 63) / 64) * 64)
#define NT 512
#define NWAVE (NT / 64)

typedef unsigned short bf16_t;

__device__ __forceinline__ float bf2f(bf16_t v) { union { unsigned u; float f; } x; x.u = ((unsigned)v) << 16; return x.f; }
__device__ __forceinline__ bf16_t f2bf(float f) { union { unsigned u; float f; } x; x.f = f; unsigned u = x.u; u += 0x7FFFu + ((u >> 16) & 1u); return (bf16_t)(u >> 16); }
__device__ __forceinline__ float wave_sum(float v) { for (int m = 32; m >= 1; m >>= 1) v += __shfl_xor(v, m); return v; }
__device__ __forceinline__ float wave_max(float v) { for (int m = 32; m >= 1; m >>= 1) v = fmaxf(v, __shfl_xor(v, m)); return v; }
__device__ __forceinline__ float sigmoidf_(float x) { return 1.0f / (1.0f + expf(-x)); }
__device__ __forceinline__ float siluf_(float x) { return x / (1.0f + expf(-x)); }


#ifdef CPU_EMU
__device__ __forceinline__ int otid() { return threadIdx.x; }
__device__ __forceinline__ int obid() { return blockIdx.x; }
#else
__device__ __forceinline__ int otid() { int t = threadIdx.x; asm volatile("" : "+v"(t)); return t; }
__device__ __forceinline__ int obid() { int b = blockIdx.x; asm volatile("" : "+s"(b)); return b; }
#endif

#define LDS_BYTES_ (132 * 1024)
#define XBW_OFF_ (128 * 1024)
#ifdef CPU_EMU
#define SMEM_PTR() ((unsigned char*)emu_dynshm())
#else
extern __shared__ __attribute__((aligned(16))) unsigned char smem_dyn[];
#define SMEM_PTR() (smem_dyn)
#endif
struct Params {
  const float *x, *c, *ctx, *c_ctx, *w_ada, *b_ada, *g_norm1, *g_norm2, *w_in, *w_out, *conv_w, *g_out_conv, *g_kv_norm, *w_uk, *w_uv,
      *g_q_norm, *g_k_norm, *g_out_mla, *rwkv_mu, *rwkv_w0, *rwkv_w2, *rwkv_a0, *rwkv_a2, *rwkv_g2, *rwkv_k_k, *rwkv_k_a, *rwkv_r_k, *g_ln_x,
      *g_ret_norm, *w_router, *b_router, *w_gate, *w_up, *w_down;
  float* out;
  unsigned* bar;
  float* modv;
  float* xc;
  bf16_t* h;
  bf16_t* z;
  bf16_t* y;
  bf16_t* qb;
  bf16_t* kb;
  bf16_t* vb;
  float* ob;
  float* sc_r;
  float* sc_v;
  float* sc_kk;
  float* sc_w;
  float* sc_kka;
  float* sc_kt;
  float* sc_gate;
  float* sc_bonus;
  bf16_t* aux;
  bf16_t* kbuf;
  bf16_t* krp;
  float* kr2;
  bf16_t* bts;
  bf16_t* zs2;
  bf16_t* rg;
  float* ys;
  bf16_t* rq;
  bf16_t* rk;
  bf16_t* rv;
  float* rd;
  float* rs;
  float* tab_mla;
  float* tab_ret;
  float* aff;
  int* sel_idx;
  float* sel_gate;
  int* inv;
  bf16_t* hid;
  bf16_t* ye;
  bf16_t* wb_in;
  bf16_t* wb_out;
  bf16_t* wb_moe1;
  bf16_t* wb_moe2;
};

enum { PH_MOD = 0, PH_NORM1, PH_GEMM_IN, PH_PREP, PH_RETD, PH_PREPC, PH_MIX, PH_POST, PH_GEMM_OUT, PH_NORM2, PH_TOPK, PH_MOE1, PH_MOE2, PH_FINAL, PH_COUNT };

__device__ __forceinline__ int row_batch(int row) { return row < NTOK_ ? row / L_ : (row - NTOK_) / LC_; }
__device__ __forceinline__ int row_modidx(int row) { return row < NTOK_ ? row / L_ : B_; }
__device__ __forceinline__ int row_pos(int row) { return row < NTOK_ ? row % L_ : (row - NTOK_) % LC_; }
__device__ __forceinline__ int row_len(int row) { return row < NTOK_ ? L_ : LC_; }

__device__ __forceinline__ void phase_mod(const Params& p) {
  const int tid = otid();
  for (int idx = obid() * NT + tid; idx < DEPTH_ * 6 * D_; idx += gridDim.x * NT) {
    const int l = idx / (6 * D_), col = idx % (6 * D_);
    float acc[B_ + 1];
#pragma unroll
    for (int r = 0; r <= B_; ++r) acc[r] = 0.f;
    const float* w = p.w_ada + (size_t)l * D_ * 6 * D_ + col;
    for (int k = 0; k < D_; ++k) {
      const float wv = w[(size_t)k * 6 * D_];
#pragma unroll
      for (int r = 0; r < B_; ++r) acc[r] += siluf_(p.c[r * D_ + k]) * wv;
      acc[B_] += siluf_(p.c_ctx[k]) * wv;
    }
    const float bb = p.b_ada[l * 6 * D_ + col];
#pragma unroll
    for (int r = 0; r <= B_; ++r) p.modv[((size_t)l * (B_ + 1) + r) * 6 * D_ + col] = acc[r] + bb;
  }
  const int NF = ROPE_ / 4;
  for (int idx = obid() * NT + tid; idx < L_ * NF; idx += gridDim.x * NT) {
    const int t = idx / NF, i = idx % NF;
    const float inv = powf(10000.0f, -(float)(2 * i) / (float)(ROPE_ / 2));
    const float ar = (float)(t / GRIDW_) * inv, ac = (float)(t % GRIDW_) * inv;
    float* o = p.tab_mla + (size_t)t * 4 * NF;
    o[0 * NF + i] = cosf(ar); o[1 * NF + i] = sinf(ar); o[2 * NF + i] = cosf(ac); o[3 * NF + i] = sinf(ac);
  }
  const int NR = HD_ / 2;
  for (int idx = obid() * NT + tid; idx < L_ * NR; idx += gridDim.x * NT) {
    const int t = idx / NR, i = idx % NR;
    const float theta = 1.0f / powf(10000.0f, (float)i / (float)(NR - 1));
    const float a = (float)t * theta;
    p.tab_ret[(size_t)t * 2 * NR + i] = cosf(a); p.tab_ret[(size_t)t * 2 * NR + NR + i] = sinf(a);
  }
}

template <int MODE> __device__ __forceinline__ void phase_norm(const Params& p, int l) {
  const int tid = otid(), wave = tid >> 6, lane = tid & 63;
  const bool last = (l == DEPTH_ - 1);
  for (int row = obid() * NWAVE + wave; row < NROWS_; row += gridDim.x * NWAVE) {
    const bool isx = row < NTOK_;
    if (MODE == 2 && !isx) continue;
    if (MODE == 1 && !isx && last) continue;
    const int mi = row_modidx(row);
    float* xrow = isx ? p.out + (size_t)row * D_ : p.xc + (size_t)(row - NTOK_) * D_;
    const float* src = xrow;
    if (MODE == 0 && l == 0) src = isx ? p.x + (size_t)row * D_ : p.ctx + (size_t)(row - NTOK_) * D_;
    float v[D_ / 64];
    float ss = 0.f;
    const bool combine = (MODE == 0 && l > 0) || MODE == 2;
    const int lprev = (MODE == 2) ? l : l - 1;
#pragma unroll
    for (int i = 0; i < D_ / 256; ++i) {
      const int col = (i * 64 + lane) * 4;
      float a0 = src[col], a1 = src[col + 1], a2 = src[col + 2], a3 = src[col + 3];
      if (combine) {
        float s0 = 0.f, s1 = 0.f, s2 = 0.f, s3 = 0.f;
        for (int e = 0; e < NEXP_; ++e) {
          const int slot = p.inv[(size_t)row * NEXP_ + e];
          if (slot >= 0) { const bf16_t* yr = p.ye + (size_t)slot * D_ + col; s0 += bf2f(yr[0]); s1 += bf2f(yr[1]); s2 += bf2f(yr[2]); s3 += bf2f(yr[3]); }
        }
        const float* ga2 = p.modv + ((size_t)lprev * (B_ + 1) + mi) * 6 * D_ + 5 * D_ + col;
        a0 += ga2[0] * s0; a1 += ga2[1] * s1; a2 += ga2[2] * s2; a3 += ga2[3] * s3;
      }
      v[i * 4 + 0] = a0; v[i * 4 + 1] = a1; v[i * 4 + 2] = a2; v[i * 4 + 3] = a3;
      ss += a0 * a0 + a1 * a1 + a2 * a2 + a3 * a3;
      if (combine || (MODE == 0 && l == 0)) { xrow[col] = a0; xrow[col + 1] = a1; xrow[col + 2] = a2; xrow[col + 3] = a3; }
    }
    if (MODE == 2) continue;
    ss = wave_sum(ss);
    const float rstd = rsqrtf(ss / (float)D_ + 1e-6f);
    const float* g = (MODE == 0 ? p.g_norm1 : p.g_norm2) + (size_t)l * D_;
    const float* mv = p.modv + ((size_t)l * (B_ + 1) + mi) * 6 * D_ + (MODE == 0 ? 0 : 3 * D_);
    float lg[NEXP_];
#pragma unroll
    for (int e = 0; e < NEXP_; ++e) lg[e] = 0.f;
#pragma unroll
    for (int i = 0; i < D_ / 256; ++i) {
      const int col = (i * 64 + lane) * 4;
#pragma unroll
      for (int j = 0; j < 4; ++j) {
        const float hv = v[i * 4 + j] * rstd * g[col + j] * (1.0f + mv[D_ + col + j]) + mv[col + j];
        p.h[(size_t)row * D_ + col + j] = f2bf(hv);
        if (MODE == 1) {
          const float* wr = p.w_router + ((size_t)l * D_ + col + j) * NEXP_;
#pragma unroll
          for (int e = 0; e < NEXP_; ++e) lg[e] += hv * wr[e];
        }
      }
    }
    if (MODE == 1) {
      float mx = -1e30f;
#pragma unroll
      for (int e = 0; e < NEXP_; ++e) { lg[e] = wave_sum(lg[e]) + p.b_router[l * NEXP_ + e]; mx = fmaxf(mx, lg[e]); }
      float sum = 0.f;
#pragma unroll
      for (int e = 0; e < NEXP_; ++e) { lg[e] = expf(lg[e] - mx); sum += lg[e]; }
      const float is = 1.0f / sum;
      if (lane == 0) {
#pragma unroll
        for (int e = 0; e < NEXP_; ++e) p.aff[(size_t)row * NEXP_ + e] = lg[e] * is;
      }
    }
  }
}

struct GemmDesc { const bf16_t* A; int lda; const int* amap; const float* W; const float* W2; int ldw; int M, N, K; };
template <bool DUAL, class Epi> __device__ __forceinline__ void gemm_tile_f32(const GemmDesc& g, int tm, int tn, const Epi& epi) {
  float (*As)[132] = (float (*)[132])SMEM_PTR();
  float (*Bs)[64] = (float (*)[64])(SMEM_PTR() + 16 * 132 * 4);
  float (*Bs2)[64] = (float (*)[64])(SMEM_PTR() + 16 * 132 * 4 + 16 * 64 * 4);
  const int tid = otid(), ty = tid >> 4, tx = tid & 15;
  float acc[4][4], acc2[4][4];
#pragma unroll
  for (int i = 0; i < 4; ++i)
#pragma unroll
    for (int j = 0; j < 4; ++j) { acc[i][j] = 0.f; acc2[i][j] = 0.f; }
  const int ar = tid >> 2, ak = (tid & 3) * 4;
  int arow = tm * 128 + ar; if (arow >= g.M) arow = g.M - 1;
  const size_t asrc = (size_t)(g.amap ? g.amap[arow] : arow) * g.lda;
  const int bk = tid >> 5, bn = (tid & 31) * 2;
  for (int k0 = 0; k0 < g.K; k0 += 16) {
    __syncthreads();
#pragma unroll
    for (int j = 0; j < 4; ++j) As[ak + j][ar] = bf2f(g.A[asrc + k0 + ak + j]);
#pragma unroll
    for (int j = 0; j < 2; ++j) {
      const int n = tn * 64 + bn + j;
      Bs[bk][bn + j] = n < g.N ? g.W[(size_t)(k0 + bk) * g.ldw + n] : 0.f;
      if (DUAL) Bs2[bk][bn + j] = n < g.N ? g.W2[(size_t)(k0 + bk) * g.ldw + n] : 0.f;
    }
    __syncthreads();
#pragma unroll
    for (int kk = 0; kk < 16; ++kk) {
      float a[4], b[4], b2[4];
#pragma unroll
      for (int i = 0; i < 4; ++i) a[i] = As[kk][ty * 4 + i];
#pragma unroll
      for (int j = 0; j < 4; ++j) { b[j] = Bs[kk][tx * 4 + j]; if (DUAL) b2[j] = Bs2[kk][tx * 4 + j]; }
#pragma unroll
      for (int i = 0; i < 4; ++i)
#pragma unroll
        for (int j = 0; j < 4; ++j) { acc[i][j] += a[i] * b[j]; if (DUAL) acc2[i][j] += a[i] * b2[j]; }
    }
  }
#pragma unroll
  for (int i = 0; i < 4; ++i) {
    const int m = tm * 128 + ty * 4 + i;
    if (m >= g.M) continue;
#pragma unroll
    for (int j = 0; j < 4; ++j) { const int n = tn * 64 + tx * 4 + j; if (n < g.N) epi(m, n, acc[i][j], acc2[i][j]); }
  }
}

struct EpiZ { bf16_t* z; __device__ void operator()(int m, int n, float a, float) const { z[(size_t)m * ZLD_ + n] = f2bf(a); } };
struct EpiOut { const float* modv; float* out; float* xc; int l; __device__ void operator()(int m, int n, float a, float) const {
    const int mi = row_modidx(m); const float ga1 = modv[((size_t)l * (B_ + 1) + mi) * 6 * D_ + 2 * D_ + n];
    float* xr = m < NTOK_ ? out + (size_t)m * D_ : xc + (size_t)(m - NTOK_) * D_; xr[n] += ga1 * a; } };
struct EpiHid { bf16_t* hid; int row0; __device__ void operator()(int m, int n, float a, float b) const { hid[(size_t)(row0 + m) * D_ + n] = f2bf(siluf_(a) * b); } };
struct EpiYe { bf16_t* ye; const float* gate; int row0; __device__ void operator()(int m, int n, float a, float) const { ye[(size_t)(row0 + m) * D_ + n] = f2bf(a * gate[row0 + m]); } };

__device__ __forceinline__ void phase_gemm_in(const Params& p, int l) {
  GemmDesc g; g.A = p.h; g.lda = D_; g.amap = nullptr; g.W = p.w_in + (size_t)l * D_ * INCOLS_; g.W2 = nullptr; g.ldw = INCOLS_; g.M = NROWS_; g.N = INCOLS_; g.K = D_;
  EpiZ epi{p.z};
  const int ntm = (NROWS_ + 127) / 128, ntn = (INCOLS_ + 63) / 64;
  for (int u = obid(); u < ntm * ntn; u += gridDim.x) gemm_tile_f32<false>(g, u / ntn, u % ntn, epi);
}
__device__ __forceinline__ void phase_gemm_out(const Params& p, int l) {
  const bool last = (l == DEPTH_ - 1);
  GemmDesc g; g.A = p.y; g.lda = D_; g.amap = nullptr; g.W = p.w_out + (size_t)l * D_ * D_; g.W2 = nullptr; g.ldw = D_; g.M = last ? NTOK_ : NROWS_; g.N = D_; g.K = D_;
  EpiOut epi{p.modv, p.out, p.xc, l};
  const int ntm = (g.M + 127) / 128, ntn = D_ / 64;
  for (int u = obid(); u < ntm * ntn; u += gridDim.x) gemm_tile_f32<false>(g, u / ntn, u % ntn, epi);
}
__device__ __forceinline__ int slot_expert(int slotrow) { return slotrow < XSLOTS_ ? slotrow / (B_ * CAP_) : (slotrow - XSLOTS_) / (B_ * CAPC_); }
__device__ __forceinline__ void phase_moe1(const Params& p, int l) {
  const bool last = (l == DEPTH_ - 1);
  const int M = last ? XSLOTS_ : XSLOTS_ + CSLOTS_;
  const int ntm = M / 128, ntn = D_ / 64;
  for (int u = obid(); u < ntm * ntn; u += gridDim.x) {
    const int tm = u / ntn, tn = u % ntn, e = slot_expert(tm * 128);
    GemmDesc g; g.A = p.h; g.lda = D_; g.amap = p.sel_idx + tm * 128; g.W = p.w_gate + ((size_t)l * NEXP_ + e) * D_ * D_; g.W2 = p.w_up + ((size_t)l * NEXP_ + e) * D_ * D_;
    g.ldw = D_; g.M = 128; g.N = D_; g.K = D_;
    EpiHid epi{p.hid, tm * 128};
    gemm_tile_f32<true>(g, 0, tn, epi);
  }
}
__device__ __forceinline__ void phase_moe2(const Params& p, int l) {
  const bool last = (l == DEPTH_ - 1);
  const int M = last ? XSLOTS_ : XSLOTS_ + CSLOTS_;
  const int ntm = M / 128, ntn = D_ / 64;
  for (int u = obid(); u < ntm * ntn; u += gridDim.x) {
    const int tm = u / ntn, tn = u % ntn, e = slot_expert(tm * 128);
    GemmDesc g; g.A = p.hid + (size_t)tm * 128 * D_; g.lda = D_; g.amap = nullptr; g.W = p.w_down + ((size_t)l * NEXP_ + e) * D_ * D_; g.W2 = nullptr;
    g.ldw = D_; g.M = 128; g.N = D_; g.K = D_;
    EpiYe epi{p.ye, p.sel_gate, tm * 128};
    gemm_tile_f32<false>(g, 0, tn, epi);
  }
}


#ifndef CPU_EMU
#define LAS __attribute__((address_space(3)))
namespace pg8 {
typedef short bf16x8 __attribute__((ext_vector_type(8)));
typedef float f32x4 __attribute__((ext_vector_type(4)));
typedef unsigned u32x4 __attribute__((ext_vector_type(4)));
constexpr int BM = 256, BK = 64, HALF = 128, HTB = HALF * BK * 2, STAGE_BYTES = 8 * HTB, NXCD = 8, WGM = 8;
__device__ __forceinline__ int lds_byte(int r, int c) { const int st = (r >> 4) * 2 + (c >> 5), rr = r & 15, cc = c & 31, ob = rr * 64 + cc * 2; return st * 1024 + (ob ^ (((ob >> 9) & 1) << 5)); }
__device__ __forceinline__ void stage_rc(int b, int& R, int& C) { const int st = b / 1024, sb = b % 1024, swz = sb ^ (((sb >> 9) & 1) << 5); R = (st >> 1) * 16 + swz / 64; C = (st & 1) * 32 + (swz % 64) / 2; }
__device__ __forceinline__ int perm32(int rho) { const int n = rho >> 4, i = rho & 15; return 8 * (i >> 2) + 4 * n + (i & 3); }
struct Unit { int pm, pn; };
__device__ __forceinline__ bool static_order(int i, int nM, int nN, int G, int c, Unit& u) {
    const int nwg = nM * nN; const long L = (long)i * G + c; if (L >= nwg) return false;
    int wgid = (int)L; { const int q = nwg / NXCD, r = nwg % NXCD, xcd = wgid % NXCD, off = wgid / NXCD; wgid = (xcd < r ? xcd * (q + 1) : r * (q + 1) + (xcd - r) * q) + off; }
    const int nig = WGM * nN, gid = wgid / nig, fm = gid * WGM, gsz = (nM - fm) < WGM ? (nM - fm) : WGM;
    u.pm = fm + ((wgid % nig) % gsz); u.pn = (wgid % nig) / gsz; return true;
}
__device__ __forceinline__ unsigned cvt_pk_bf16(float lo, float hi) { unsigned r; asm volatile("v_cvt_pk_bf16_f32 %0, %1, %2" : "=v"(r) : "v"(lo), "v"(hi)); return r; }

template <class P> __device__ __forceinline__ void gemm_phase(LAS unsigned char* lds, const P& prob) {
    const int tid = otid(), wid = __builtin_amdgcn_readfirstlane(tid >> 6), lane = tid & 63, wr = wid >> 2, wc = wid & 3, fr = lane & 15, fq = lane >> 4;
    constexpr int K = P::KDIM, nt = K / BK;
    unsigned voffB[2]; int sR[2], sC[2];
#pragma unroll
    for (int i = 0; i < 2; ++i) { int R, C; stage_rc(tid * 16 + i * 8192, R, C); sR[i] = R; sC[i] = C; const int Rb = P::PERM ? ((R & ~31) + perm32(R & 31)) : R; voffB[i] = (unsigned)(Rb * K + C) * 2u; }
    constexpr size_t kstep = (size_t)(BK * 2);
    constexpr size_t hstep = (size_t)HALF * K * 2;
    const unsigned ldsw = (unsigned)wid * 1024u;
    const int aoff = lds_byte(wr * 64 + fr, fq * 8), boff = lds_byte(wc * 32 + fr, fq * 8);
#define PG8_SA(b, h) (((b) * 2 + (h)) * HTB)
#define PG8_SB(b, h) ((4 + (b) * 2 + (h)) * HTB)
#define PG8_STAGE(bufoff, gbase, voff) do { _Pragma("unroll") for (int _i = 0; _i < 2; ++_i) \
        __builtin_amdgcn_global_load_lds((const unsigned*)((const char*)(gbase) + (voff)[_i]), (LAS unsigned*)(lds + (bufoff) + ldsw + _i * 8192), 16, 0, 0); } while (0)
#define PG8_LDA(dst, b, h) do { _Pragma("unroll") for (int m = 0; m < 4; ++m) _Pragma("unroll") for (int k = 0; k < 2; ++k) dst[m][k] = *(const LAS bf16x8*)(lds + PG8_SA(b, h) + aoff + m * 2048 + k * 1024); } while (0)
#define PG8_LDB(dst, b, h) do { _Pragma("unroll") for (int n = 0; n < 2; ++n) _Pragma("unroll") for (int k = 0; k < 2; ++k) dst[n][k] = *(const LAS bf16x8*)(lds + PG8_SB(b, h) + boff + n * 2048 + k * 1024); } while (0)
#define PG8_MMA(ai, bj, At, Bt) do { __builtin_amdgcn_s_setprio(1); _Pragma("unroll") for (int m = 0; m < 4; ++m) _Pragma("unroll") for (int n = 0; n < 2; ++n) _Pragma("unroll") for (int k = 0; k < 2; ++k) \
        acc[ai][bj][m][n] = __builtin_amdgcn_mfma_f32_16x16x32_bf16(Bt[n][k], At[m][k], acc[ai][bj][m][n], 0, 0, 0); __builtin_amdgcn_s_setprio(0); } while (0)
#define PG8_WAIT_V(n) asm volatile("s_waitcnt vmcnt(" #n ")" ::: "memory")
#define PG8_WAIT_L(n) asm volatile("s_waitcnt lgkmcnt(" #n ")" ::: "memory")
#define PG8_BAR __builtin_amdgcn_s_barrier()
#define PG8_SCHED __builtin_amdgcn_sched_barrier(0)
    Unit cur, nxt; int ui = 0;
    if (!prob.unit(0, cur)) return;
    f32x4 acc[2][2][4][2];
#pragma unroll
    for (int a = 0; a < 2; ++a)
#pragma unroll
        for (int b = 0; b < 2; ++b)
#pragma unroll
            for (int m = 0; m < 4; ++m)
#pragma unroll
                for (int n = 0; n < 2; ++n) acc[a][b][m][n] = (f32x4){0.f, 0.f, 0.f, 0.f};
    bf16x8 At[4][2], B0[2][2], B1[2][2];
    unsigned vc[2][2], vn[2][2];
#pragma unroll
    for (int h = 0; h < 2; ++h)
#pragma unroll
        for (int i = 0; i < 2; ++i) vc[h][i] = prob.a_voff(cur, h * HALF + sR[i], sC[i]);
    const char* Ab = prob.a_base();
    const char* cB = prob.b_base(cur);
    PG8_STAGE(PG8_SB(0, 0), cB, voffB); PG8_STAGE(PG8_SA(0, 0), Ab, vc[0]); PG8_STAGE(PG8_SB(0, 1), cB + hstep, voffB); PG8_STAGE(PG8_SA(0, 1), Ab, vc[1]);
    if (wr == 1) PG8_BAR;
    PG8_WAIT_V(4); PG8_BAR;
    PG8_STAGE(PG8_SB(1, 0), cB + kstep, voffB); PG8_STAGE(PG8_SA(1, 0), Ab + kstep, vc[0]); PG8_STAGE(PG8_SB(1, 1), cB + hstep + kstep, voffB);
    PG8_WAIT_V(6); PG8_BAR;
    for (;;) {
        const bool has_next = prob.unit(ui + 1, nxt);
        const char* nB = has_next ? prob.b_base(nxt) : cB;
#pragma unroll
        for (int h = 0; h < 2; ++h)
#pragma unroll
            for (int i = 0; i < 2; ++i) vn[h][i] = has_next ? prob.a_voff(nxt, h * HALF + sR[i], sC[i]) : vc[h][i];
        for (int t = 0; t < nt; t += 2) {
            const bool last = (t == nt - 2);
            const char* a1 = Ab + (size_t)(t + 1) * kstep;
            const char* a2 = last ? Ab : Ab + (size_t)(t + 2) * kstep; const char* b2 = last ? nB : cB + (size_t)(t + 2) * kstep;
            const char* a3 = a2 + kstep; const char* b3 = b2 + kstep;
            unsigned v2[2][2];
#pragma unroll
            for (int h = 0; h < 2; ++h)
#pragma unroll
                for (int i = 0; i < 2; ++i) v2[h][i] = last ? vn[h][i] : vc[h][i];
            PG8_LDB(B0, 0, 0); PG8_SCHED; PG8_LDA(At, 0, 0); PG8_STAGE(PG8_SA(1, 1), a1, vc[1]);
            PG8_WAIT_L(8); PG8_BAR; PG8_WAIT_L(0); PG8_MMA(0, 0, At, B0); PG8_BAR; PG8_SCHED;
            PG8_LDB(B1, 0, 1); PG8_STAGE(PG8_SB(0, 0), b2, voffB);
            PG8_BAR; PG8_WAIT_L(0); PG8_MMA(0, 1, At, B1); PG8_BAR;
            PG8_LDA(At, 0, 1); PG8_STAGE(PG8_SA(0, 0), a2, v2[0]);
            PG8_BAR; PG8_WAIT_L(0); PG8_MMA(1, 0, At, B0); PG8_BAR; PG8_SCHED;
            PG8_STAGE(PG8_SB(0, 1), b2 + hstep, voffB);
            PG8_WAIT_V(6); PG8_BAR; PG8_MMA(1, 1, At, B1); PG8_BAR;
            PG8_LDB(B0, 1, 0); PG8_SCHED; PG8_LDA(At, 1, 0); PG8_STAGE(PG8_SA(0, 1), a2, v2[1]);
            PG8_WAIT_L(8); PG8_BAR; PG8_WAIT_L(0); PG8_MMA(0, 0, At, B0); PG8_BAR; PG8_SCHED;
            PG8_LDB(B1, 1, 1); PG8_STAGE(PG8_SB(1, 0), b3, voffB);
            PG8_BAR; PG8_WAIT_L(0); PG8_MMA(0, 1, At, B1); PG8_BAR;
            PG8_LDA(At, 1, 1); PG8_STAGE(PG8_SA(1, 0), a3, v2[0]);
            PG8_BAR; PG8_WAIT_L(0); PG8_MMA(1, 0, At, B0); PG8_BAR; PG8_SCHED;
            PG8_STAGE(PG8_SB(1, 1), b3 + hstep, voffB);
            PG8_WAIT_V(6); PG8_BAR; PG8_MMA(1, 1, At, B1); PG8_BAR;
        }
        prob.epi(acc, cur, wr, wc, fr, fq);
        if (!has_next) break;
#pragma unroll
        for (int a = 0; a < 2; ++a)
#pragma unroll
            for (int b = 0; b < 2; ++b)
#pragma unroll
                for (int m = 0; m < 4; ++m)
#pragma unroll
                    for (int n = 0; n < 2; ++n) acc[a][b][m][n] = (f32x4){0.f, 0.f, 0.f, 0.f};
        cur = nxt; cB = nB; ++ui;
#pragma unroll
        for (int h = 0; h < 2; ++h)
#pragma unroll
            for (int i = 0; i < 2; ++i) vc[h][i] = vn[h][i];
    }
    PG8_WAIT_V(0);
    if (wr == 0) PG8_BAR;
    PG8_BAR;
#undef PG8_SA
#undef PG8_SB
#undef PG8_STAGE
#undef PG8_LDA
#undef PG8_LDB
#undef PG8_MMA
#undef PG8_WAIT_V
#undef PG8_WAIT_L
#undef PG8_BAR
#undef PG8_SCHED
}
typedef f32x4 Acc[2][2][4][2];

template <int KD, int LDC, int NTN> struct ProbBf16 {
    static constexpr int KDIM = KD;
    static constexpr bool PERM = true;
    const bf16_t* A; const bf16_t* Bt; bf16_t* z; int G, c;
    __device__ __forceinline__ bool unit(int i, Unit& u) const { return static_order(i, NROWS_ / BM, NTN, G, c, u); }
    __device__ __forceinline__ const char* a_base() const { return (const char*)A; }
    __device__ __forceinline__ unsigned a_voff(const Unit& u, int r, int cc) const { return (unsigned)((u.pm * BM + r) * KD + cc) * 2u; }
    __device__ __forceinline__ const char* b_base(const Unit& u) const { return (const char*)Bt + (size_t)u.pn * BM * KD * 2; }
    __device__ __forceinline__ void epi(const Acc& acc, const Unit& u, int wr, int wc, int fr, int fq) const {
        const int row0 = u.pm * BM + wr * 64 + fr, col0 = u.pn * BM + wc * 32 + 8 * fq;
#pragma unroll
        for (int ai = 0; ai < 2; ++ai)
#pragma unroll
            for (int m = 0; m < 4; ++m) { bf16_t* rowp = z + (size_t)(row0 + ai * HALF + m * 16) * LDC + col0;
#pragma unroll
                for (int bj = 0; bj < 2; ++bj) { const f32x4 v0 = acc[ai][bj][m][0], v1 = acc[ai][bj][m][1];
                    u32x4 w; w.x = cvt_pk_bf16(v0[0], v0[1]); w.y = cvt_pk_bf16(v0[2], v0[3]); w.z = cvt_pk_bf16(v1[0], v1[1]); w.w = cvt_pk_bf16(v1[2], v1[3]);
                    *(u32x4*)(rowp + bj * HALF) = w; } }
    }
};
typedef ProbBf16<D_, ZLD_, ZLD_ / BM> ProbIn;
struct ProbOut {
    static constexpr int KDIM = D_;
    static constexpr bool PERM = false;
    const bf16_t* A; const bf16_t* Bt; float* out; float* xc; const float* modv_l; int nM, G, c;
    __device__ __forceinline__ bool unit(int i, Unit& u) const { return static_order(i, nM, D_ / BM, G, c, u); }
    __device__ __forceinline__ const char* a_base() const { return (const char*)A; }
    __device__ __forceinline__ unsigned a_voff(const Unit& u, int r, int cc) const { return (unsigned)((u.pm * BM + r) * D_ + cc) * 2u; }
    __device__ __forceinline__ const char* b_base(const Unit& u) const { return (const char*)Bt + (size_t)u.pn * BM * D_ * 2; }
    __device__ __forceinline__ void epi(const Acc& acc, const Unit& u, int wr, int wc, int fr, int fq) const {
        const int rt = u.pm * BM; const bool isx = rt < NTOK_;
        const int mi = isx ? rt / L_ : B_;
        float* xb = isx ? out + (size_t)rt * D_ : xc + (size_t)(rt - NTOK_) * D_;
        const int rl = wr * 64 + fr, col0 = u.pn * BM + wc * 32 + 4 * fq;
        const float* gp = modv_l + (size_t)mi * 6 * D_ + 2 * D_ + col0;
        f32x4 ga[2][2];
#pragma unroll
        for (int bj = 0; bj < 2; ++bj)
#pragma unroll
            for (int n = 0; n < 2; ++n) ga[bj][n] = *(const f32x4*)(gp + bj * HALF + n * 16);
#pragma unroll
        for (int ai = 0; ai < 2; ++ai)
#pragma unroll
            for (int m = 0; m < 4; ++m) { float* rowp = xb + (size_t)(rl + ai * HALF + m * 16) * D_ + col0;
#pragma unroll
                for (int bj = 0; bj < 2; ++bj)
#pragma unroll
                    for (int n = 0; n < 2; ++n) { f32x4* q = (f32x4*)(rowp + bj * HALF + n * 16); *q = *q + ga[bj][n] * acc[ai][bj][m][n]; } }
    }
};
struct ProbMoe1 {
    static constexpr int KDIM = D_;
    static constexpr bool PERM = true;
    const bf16_t* A; const bf16_t* Bt; const int* sel; bf16_t* hid; int nM, G, c;
    __device__ __forceinline__ bool unit(int i, Unit& u) const { return static_order(i, nM, 2 * D_ / BM, G, c, u); }
    __device__ __forceinline__ const char* a_base() const { return (const char*)A; }
    __device__ __forceinline__ unsigned a_voff(const Unit& u, int r, int cc) const { return (unsigned)(sel[u.pm * BM + r] * D_ + cc) * 2u; }
    __device__ __forceinline__ const char* b_base(const Unit& u) const { const int rt = u.pm * BM; const int e = rt < XSLOTS_ ? rt / (B_ * CAP_) : (rt - XSLOTS_) / (B_ * CAPC_);
        return (const char*)Bt + ((size_t)e * 2 * D_ + (size_t)u.pn * BM) * D_ * 2; }
    __device__ __forceinline__ void epi(const Acc& acc, const Unit& u, int wr, int wc, int fr, int fq) const {
        const int row0 = u.pm * BM + wr * 64 + fr, col0 = u.pn * HALF + wc * 32 + 8 * fq;
#pragma unroll
        for (int ai = 0; ai < 2; ++ai)
#pragma unroll
            for (int m = 0; m < 4; ++m) { bf16_t* rowp = hid + (size_t)(row0 + ai * HALF + m * 16) * D_ + col0;
                float r[8];
#pragma unroll
                for (int n = 0; n < 2; ++n)
#pragma unroll
                    for (int j = 0; j < 4; ++j) { const float g = acc[ai][0][m][n][j], uu = acc[ai][1][m][n][j]; r[n * 4 + j] = g * __builtin_amdgcn_rcpf(1.0f + __expf(-g)) * uu; }
                u32x4 w; w.x = cvt_pk_bf16(r[0], r[1]); w.y = cvt_pk_bf16(r[2], r[3]); w.z = cvt_pk_bf16(r[4], r[5]); w.w = cvt_pk_bf16(r[6], r[7]);
                *(u32x4*)rowp = w; }
    }
};
struct ProbMoe2 {
    static constexpr int KDIM = D_;
    static constexpr bool PERM = true;
    const bf16_t* A; const bf16_t* Bt; const float* gate; bf16_t* ye; int nM, G, c;
    __device__ __forceinline__ bool unit(int i, Unit& u) const { return static_order(i, nM, D_ / BM, G, c, u); }
    __device__ __forceinline__ const char* a_base() const { return (const char*)A; }
    __device__ __forceinline__ unsigned a_voff(const Unit& u, int r, int cc) const { return (unsigned)((u.pm * BM + r) * D_ + cc) * 2u; }
    __device__ __forceinline__ const char* b_base(const Unit& u) const { const int rt = u.pm * BM; const int e = rt < XSLOTS_ ? rt / (B_ * CAP_) : (rt - XSLOTS_) / (B_ * CAPC_);
        return (const char*)Bt + ((size_t)e * D_ + (size_t)u.pn * BM) * D_ * 2; }
    __device__ __forceinline__ void epi(const Acc& acc, const Unit& u, int wr, int wc, int fr, int fq) const {
        const int row0 = u.pm * BM + wr * 64 + fr, col0 = u.pn * BM + wc * 32 + 8 * fq;
#pragma unroll
        for (int ai = 0; ai < 2; ++ai)
#pragma unroll
            for (int m = 0; m < 4; ++m) { const int row = row0 + ai * HALF + m * 16; const float gt = gate[row]; bf16_t* rowp = ye + (size_t)row * D_ + col0;
#pragma unroll
                for (int bj = 0; bj < 2; ++bj) { const f32x4 v0 = acc[ai][bj][m][0] * gt, v1 = acc[ai][bj][m][1] * gt;
                    u32x4 w; w.x = cvt_pk_bf16(v0[0], v0[1]); w.y = cvt_pk_bf16(v0[2], v0[3]); w.z = cvt_pk_bf16(v1[0], v1[1]); w.w = cvt_pk_bf16(v1[2], v1[3]);
                    *(u32x4*)(rowp + bj * HALF) = w; } }
    }
};

}

__device__ __forceinline__ void cvt_tile(const float* src, int ld, int nvalid, int k0, int n0, bf16_t* dst, int dst_row0) {
  float (*tile)[65] = (float (*)[65])SMEM_PTR();
  const int tid = otid();
#pragma unroll
  for (int j = 0; j < 8; ++j) { const int k = j * 8 + (tid >> 6), n = tid & 63; tile[k][n] = (n0 + n < nvalid) ? src[(size_t)(k0 + k) * ld + n0 + n] : 0.f; }
  __syncthreads();
#pragma unroll
  for (int j = 0; j < 4; ++j) { const int n = j * 16 + (tid >> 5), k2 = tid & 31;
    const unsigned v = (unsigned)f2bf(tile[2 * k2][n]) | ((unsigned)f2bf(tile[2 * k2 + 1][n]) << 16);
    *(unsigned*)(dst + (size_t)(dst_row0 + n) * D_ + k0 + 2 * k2) = v; }
  __syncthreads();
}
__device__ __forceinline__ void phase_cvt_static(const Params& p) {
  const int nin = DEPTH_ * (D_ / 64) * (ZLD_ / 64), nout = DEPTH_ * (D_ / 64) * (D_ / 64);
  for (int u = obid(); u < nin + nout; u += gridDim.x) {
    if (u < nin) { const int l = u / ((D_ / 64) * (ZLD_ / 64)), r = u % ((D_ / 64) * (ZLD_ / 64)), kt = r / (ZLD_ / 64), ntl = r % (ZLD_ / 64);
      cvt_tile(p.w_in + (size_t)l * D_ * INCOLS_, INCOLS_, INCOLS_, kt * 64, ntl * 64, p.wb_in + (size_t)l * ZLD_ * D_, ntl * 64); }
    else { const int v = u - nin; const int l = v / ((D_ / 64) * (D_ / 64)), r = v % ((D_ / 64) * (D_ / 64)), kt = r / (D_ / 64), ntl = r % (D_ / 64);
      cvt_tile(p.w_out + (size_t)l * D_ * D_, D_, D_, kt * 64, ntl * 64, p.wb_out + (size_t)l * D_ * D_, ntl * 64); }
  }
}
__device__ __forceinline__ void phase_cvt_moe(const Params& p, int l) {
  const int per = (D_ / 64) * (D_ / 64);
  for (int u = obid(); u < 3 * NEXP_ * per; u += gridDim.x) {
    const int mat = u / (NEXP_ * per), e = (u / per) % NEXP_, r = u % per, kt = r / (D_ / 64), ntl = r % (D_ / 64);
    const size_t so = ((size_t)l * NEXP_ + e) * D_ * D_;
    const int n0 = ntl * 64;
    if (mat == 0) cvt_tile(p.w_gate + so, D_, D_, kt * 64, n0, p.wb_moe1 + (size_t)e * 2 * D_ * D_, (n0 / 128) * 256 + (n0 % 128));
    else if (mat == 1) cvt_tile(p.w_up + so, D_, D_, kt * 64, n0, p.wb_moe1 + (size_t)e * 2 * D_ * D_, (n0 / 128) * 256 + 128 + (n0 % 128));
    else cvt_tile(p.w_down + so, D_, D_, kt * 64, n0, p.wb_moe2 + (size_t)e * D_ * D_, n0);
  }
}

__device__ __forceinline__ void phase_cvt_small(const Params& p) {
  const int tid = otid();
  const size_t total = (size_t)DEPTH_ * ZS2W_ * AUXW_;
  for (size_t idx = (size_t)obid() * NT + tid; idx < total; idx += (size_t)gridDim.x * NT) {
    const int k = (int)(idx % AUXW_), n = (int)((idx / AUXW_) % ZS2W_), l = (int)(idx / ((size_t)AUXW_ * ZS2W_));
    const int pn = n >> 8, ch = n & 255;
    float v = 0.f;
    if (pn == 0) { if (k < 128) v = p.w_uk[((size_t)l * KVR_ + k) * GWID_ + ch]; }
    else if (pn == 1) { if (k < 128) v = p.w_uv[((size_t)l * KVR_ + k) * GWID_ + ch]; }
    else if (pn <= 3) { if (k >= 128 && k < 192) v = p.rwkv_w2[(((size_t)l * 2 + (pn - 2)) * DLORA_ + (k - 128)) * GWID_ + ch]; }
    else if (pn <= 5) { if (k >= 192 && k < 256) v = p.rwkv_a2[(((size_t)l * 2 + (pn - 4)) * ALORA_ + (k - 192)) * GWID_ + ch]; }
    else { if (k >= 256) v = p.rwkv_g2[((size_t)l * GLORA_ + (k - 256)) * GWID_ + ch]; }
    p.bts[idx] = f2bf(v);
  }
}
__device__ __forceinline__ void phase_gemm_small_mfma(const Params& p, int l, LAS unsigned char* lds) {
  pg8::ProbBf16<AUXW_, ZS2W_, ZS2W_ / 256> pr; pr.A = p.aux; pr.Bt = p.bts + (size_t)l * ZS2W_ * AUXW_; pr.z = p.zs2; pr.G = gridDim.x; pr.c = obid();
  pg8::gemm_phase(lds, pr);
}
__device__ __forceinline__ void phase_gemm_in_mfma(const Params& p, int l, LAS unsigned char* lds) {
  pg8::ProbIn pr; pr.A = p.h; pr.Bt = p.wb_in + (size_t)l * ZLD_ * D_; pr.z = p.z; pr.G = gridDim.x; pr.c = obid();
  pg8::gemm_phase(lds, pr);
}
__device__ __forceinline__ void phase_gemm_out_mfma(const Params& p, int l, LAS unsigned char* lds) {
  pg8::ProbOut pr; pr.A = p.y; pr.Bt = p.wb_out + (size_t)l * D_ * D_; pr.out = p.out; pr.xc = p.xc; pr.modv_l = p.modv + (size_t)l * (B_ + 1) * 6 * D_;
  pr.nM = (l == DEPTH_ - 1 ? NTOK_ : NROWS_) / 256; pr.G = gridDim.x; pr.c = obid();
  pg8::gemm_phase(lds, pr);
}
__device__ __forceinline__ void phase_moe1_mfma(const Params& p, int l, LAS unsigned char* lds) {
  pg8::ProbMoe1 pr; pr.A = p.h; pr.Bt = p.wb_moe1; pr.sel = p.sel_idx; pr.hid = p.hid; pr.nM = (l == DEPTH_ - 1 ? XSLOTS_ : XSLOTS_ + CSLOTS_) / 256; pr.G = gridDim.x; pr.c = obid();
  pg8::gemm_phase(lds, pr);
}
__device__ __forceinline__ void phase_moe2_mfma(const Params& p, int l, LAS unsigned char* lds) {
  pg8::ProbMoe2 pr; pr.A = p.hid; pr.Bt = p.wb_moe2; pr.gate = p.sel_gate; pr.ye = p.ye; pr.nM = (l == DEPTH_ - 1 ? XSLOTS_ : XSLOTS_ + CSLOTS_) / 256; pr.G = gridDim.x; pr.c = obid();
  pg8::gemm_phase(lds, pr);
}
#endif


#if D_ == 1024 && HD_ == 64 && KVR_ == 128 && DLORA_ == 64 && ALORA_ == 64 && GLORA_ == 128
#define HAVE_PREPA 1
struct U2_ { unsigned x, y; };
struct U4_ { unsigned x, y, z, w; };
__device__ __forceinline__ float bflo(unsigned u) { union { unsigned u; float f; } x; x.u = u << 16; return x.f; }
__device__ __forceinline__ float bfhi(unsigned u) { union { unsigned u; float f; } x; x.u = u & 0xFFFF0000u; return x.f; }
__device__ __forceinline__ unsigned pk2(float a, float b) { return (unsigned)f2bf(a) | ((unsigned)f2bf(b) << 16); }
__device__ __forceinline__ void ld2(const bf16_t* p, float* o) { const unsigned u = *(const unsigned*)p; o[0] = bflo(u); o[1] = bfhi(u); }
__device__ __forceinline__ void ld4(const bf16_t* p, float* o) { const U2_ u = *(const U2_*)p; o[0] = bflo(u.x); o[1] = bfhi(u.x); o[2] = bflo(u.y); o[3] = bfhi(u.y); }
__device__ __forceinline__ void ld8(const bf16_t* p, float* o) { const U4_ u = *(const U4_*)p; o[0] = bflo(u.x); o[1] = bfhi(u.x); o[2] = bflo(u.y); o[3] = bfhi(u.y); o[4] = bflo(u.z); o[5] = bfhi(u.z); o[6] = bflo(u.w); o[7] = bfhi(u.w); }
__device__ __forceinline__ void st2(bf16_t* p, const float* v) { *(unsigned*)p = pk2(v[0], v[1]); }
__device__ __forceinline__ void st4(bf16_t* p, const float* v) { U2_ u; u.x = pk2(v[0], v[1]); u.y = pk2(v[2], v[3]); *(U2_*)p = u; }
__device__ __forceinline__ void st8(bf16_t* p, const float* v) { U4_ u; u.x = pk2(v[0], v[1]); u.y = pk2(v[2], v[3]); u.z = pk2(v[4], v[5]); u.w = pk2(v[6], v[7]); *(U4_*)p = u; }
__device__ __forceinline__ void phase_prepA(const Params& p, int l) {
  const int tid = otid(), wave = tid >> 6, lane = tid & 63;
  const bool last = (l == DEPTH_ - 1);
  for (int row = obid() * NWAVE + wave; row < NROWS_; row += gridDim.x * NWAVE) {
    const bool isx = row < NTOK_;
    const int pos = row_pos(row), len = row_len(row);
    const bf16_t* zr = p.z + (size_t)row * ZLD_;
    const bool hasp = pos > 0, hasn = pos < len - 1;
    const bf16_t* zp = hasp ? zr - ZLD_ : zr; const bf16_t* zn = hasn ? zr + ZLD_ : zr;
    const float fp = hasp ? 1.f : 0.f, fn = hasn ? 1.f : 0.f;
    const bool need_out = isx || !last;
    if (need_out) {
      const int c4 = 4 * lane;
      float bb[4], cg[4], hh[4], cgp[4], hp[4], cgn[4], hn[4], t[4];
      ld4(zr + c4, bb); ld4(zr + GWID_ + c4, cg); ld4(zr + 2 * GWID_ + c4, hh);
      ld4(zp + GWID_ + c4, cgp); ld4(zp + 2 * GWID_ + c4, hp); ld4(zn + GWID_ + c4, cgn); ld4(zn + 2 * GWID_ + c4, hn);
      const float* cw = p.conv_w + (size_t)l * 3 * GWID_ + c4;
      float ss = 0.f;
#pragma unroll
      for (int j = 0; j < 4; ++j) { const float yv = cw[j] * (fp * cgp[j] * hp[j]) + cw[GWID_ + j] * (cg[j] * hh[j]) + cw[2 * GWID_ + j] * (fn * cgn[j] * hn[j]); t[j] = bb[j] * yv; ss += t[j] * t[j]; }
      ss = wave_sum(ss);
      const float rstd = rsqrtf(ss / (float)GWID_ + 1e-6f);
#pragma unroll
      for (int j = 0; j < 4; ++j) t[j] = t[j] * rstd * p.g_out_conv[l * GWID_ + c4 + j];
      st4(p.y + (size_t)row * D_ + c4, t);
    }
    const bf16_t* zm = zr + MLA0_;
    const float* tab = p.tab_mla + (size_t)pos * 32;
    {
      const int head = lane >> 4, sub = lane & 15;
      float qn[4], qr[2];
      ld4(zm + head * HD_ + 4 * sub, qn); ld2(zm + NH_ * HD_ + head * ROPE_ + 2 * sub, qr);
      float ss = qn[0] * qn[0] + qn[1] * qn[1] + qn[2] * qn[2] + qn[3] * qn[3] + qr[0] * qr[0] + qr[1] * qr[1];
      ss += __shfl_xor(ss, 1); ss += __shfl_xor(ss, 2); ss += __shfl_xor(ss, 4); ss += __shfl_xor(ss, 8);
      const float rs = rsqrtf(ss / (float)QK_ + 1e-6f) * 0.10206207261596575f;
      const float* gq = p.g_q_norm + (size_t)l * QK_;
#pragma unroll
      for (int j = 0; j < 4; ++j) qn[j] = qn[j] * rs * gq[4 * sub + j];
      float v0 = qr[0] * rs * gq[HD_ + 2 * sub], v1 = qr[1] * rs * gq[HD_ + 2 * sub + 1];
      const float p0 = __shfl_xor(v0, 4), p1 = __shfl_xor(v1, 4);
      if (isx) {
        const int ax = sub >> 3, half = (sub >> 2) & 1, f0 = (2 * sub) & 7;
        const float c0 = tab[(ax * 2) * 8 + f0], s0 = tab[(ax * 2 + 1) * 8 + f0], c1 = tab[(ax * 2) * 8 + f0 + 1], s1 = tab[(ax * 2 + 1) * 8 + f0 + 1];
        v0 = half == 0 ? v0 * c0 - p0 * s0 : p0 * s0 + v0 * c0;
        v1 = half == 0 ? v1 * c1 - p1 * s1 : p1 * s1 + v1 * c1;
      }
      if (need_out) { bf16_t* qd = p.qb + ((size_t)row * NH_ + head) * QK_; st4(qd + 4 * sub, qn); float o2[2] = {v0, v1}; st2(qd + HD_ + 2 * sub, o2); }
    }
    {
      float c2[2]; ld2(zm + NH_ * QK_ + 2 * lane, c2);
      const float ss = wave_sum(c2[0] * c2[0] + c2[1] * c2[1]);
      const float rstd = rsqrtf(ss / (float)KVR_ + 1e-6f);
      float o2[2] = {c2[0] * rstd * p.g_kv_norm[l * KVR_ + 2 * lane], c2[1] * rstd * p.g_kv_norm[l * KVR_ + 2 * lane + 1]};
      st2(p.aux + (size_t)row * AUXW_ + 2 * lane, o2);
      const int sub = lane & 15;
      float kr[2]; ld2(zm + NH_ * QK_ + KVR_ + 2 * sub, kr);
      float s2 = kr[0] * kr[0] + kr[1] * kr[1];
      s2 += __shfl_xor(s2, 1); s2 += __shfl_xor(s2, 2); s2 += __shfl_xor(s2, 4); s2 += __shfl_xor(s2, 8);
      const float* gk = p.g_k_norm + (size_t)l * QK_ + HD_;
      float v0 = kr[0] * gk[2 * sub], v1 = kr[1] * gk[2 * sub + 1];
      const float p0 = __shfl_xor(v0, 4), p1 = __shfl_xor(v1, 4);
      if (isx) {
        const int ax = sub >> 3, half = (sub >> 2) & 1, f0 = (2 * sub) & 7;
        const float c0 = tab[(ax * 2) * 8 + f0], s0 = tab[(ax * 2 + 1) * 8 + f0], c1 = tab[(ax * 2) * 8 + f0 + 1], s1 = tab[(ax * 2 + 1) * 8 + f0 + 1];
        v0 = half == 0 ? v0 * c0 - p0 * s0 : p0 * s0 + v0 * c0;
        v1 = half == 0 ? v1 * c1 - p1 * s1 : p1 * s1 + v1 * c1;
      }
      if (lane < 16) { float o[2] = {v0, v1}; st2(p.krp + (size_t)row * ROPE_ + 2 * sub, o); if (lane == 0) p.kr2[row] = s2; }
    }
    {
      const bf16_t* zw = zr + RW0_; const bf16_t* zwp = zp + RW0_; const bf16_t* zwn = zn + RW0_;
      const float* mu = p.rwkv_mu + (size_t)l * COLS_RWKV_;
      float a[8], ap[8], an[8], bq[8], bp[8], bn[8];
      ld8(zw + 8 * lane, a); ld8(zwp + 8 * lane, ap); ld8(zwn + 8 * lane, an);
      ld8(zw + 512 + 8 * lane, bq); ld8(zwp + 512 + 8 * lane, bp); ld8(zwn + 512 + 8 * lane, bn);
#pragma unroll
      for (int j = 0; j < 8; ++j) { a[j] = a[j] + mu[8 * lane + j] * (0.5f * (fp * ap[j] + fn * an[j]) - a[j]); bq[j] = bq[j] + mu[512 + 8 * lane + j] * (0.5f * (fp * bp[j] + fn * bn[j]) - bq[j]); }
      {
        const int kch = 8 * (lane & 31);
        float kkr[8]; float s2 = 0.f;
#pragma unroll
        for (int j = 0; j < 8; ++j) { kkr[j] = a[j] * p.rwkv_k_k[l * GWID_ + kch + j]; s2 += kkr[j] * kkr[j]; }
        s2 += __shfl_xor(s2, 1); s2 += __shfl_xor(s2, 2); s2 += __shfl_xor(s2, 4);
        const float inv = rsqrtf(s2 + 1e-12f);
        if (lane < 32) { float* d = p.sc_r + (size_t)row * GWID_ + kch;
#pragma unroll
          for (int j = 0; j < 8; ++j) d[j] = a[j]; }
        else { st8(p.kbuf + (size_t)row * GWID_ + kch, a); float* d = p.sc_kk + (size_t)row * GWID_ + kch;
#pragma unroll
          for (int j = 0; j < 8; ++j) d[j] = kkr[j] * inv; }
      }
      if (lane < 32) { float* d = p.sc_v + (size_t)row * GWID_ + 8 * lane;
#pragma unroll
        for (int j = 0; j < 8; ++j) d[j] = bq[j]; }
      else {
        float o[8];
        if (lane < 40) {
#pragma unroll
          for (int j = 0; j < 8; ++j) o[j] = tanhf(bq[j]); }
        else if (lane < 48) {
#pragma unroll
          for (int j = 0; j < 8; ++j) o[j] = bq[j]; }
        else {
#pragma unroll
          for (int j = 0; j < 8; ++j) o[j] = sigmoidf_(bq[j]); }
        st8(p.aux + (size_t)row * AUXW_ + KVR_ + 8 * (lane - 32), o);
      }
    }
    {
      const bf16_t* zt = zr + RT0_;
      float q[4], k[4];
      ld4(zt + 4 * lane, q); ld4(zt + GWID_ + 4 * lane, k);
      const U2_ vraw = *(const U2_*)(zt + 2 * GWID_ + 4 * lane);
#pragma unroll
      for (int j = 0; j < 4; ++j) q[j] *= 0.125f;
      float pq[4], pk[4];
#pragma unroll
      for (int j = 0; j < 4; ++j) { pq[j] = __shfl_xor(q[j], 8); pk[j] = __shfl_xor(k[j], 8); }
      if (isx) {
        const int half = (lane >> 3) & 1, f0 = 4 * (lane & 7);
        const float* tr = p.tab_ret + (size_t)pos * HD_;
#pragma unroll
        for (int j = 0; j < 4; ++j) { const float cs = tr[f0 + j], sn = tr[HD_ / 2 + f0 + j];
          q[j] = half == 0 ? q[j] * cs - pq[j] * sn : pq[j] * sn + q[j] * cs;
          k[j] = half == 0 ? k[j] * cs - pk[j] * sn : pk[j] * sn + k[j] * cs; }
      }
      st4(p.rq + (size_t)row * GWID_ + 4 * lane, q); st4(p.rk + (size_t)row * GWID_ + 4 * lane, k);
      *(U2_*)(p.rv + (size_t)row * GWID_ + 4 * lane) = vraw;
      float g4[4]; ld4(zt + 3 * GWID_ + 4 * lane, g4);
#pragma unroll
      for (int j = 0; j < 4; ++j) g4[j] = siluf_(g4[j]);
      st4(p.rg + (size_t)row * GWID_ + 4 * lane, g4);
    }
  }
}
__device__ __forceinline__ void phase_prepB_naive(const Params& p, int l) {
  const int tid = otid(), wave = tid >> 6, lane = tid & 63;
  for (int row = obid() * NWAVE + wave; row < NROWS_; row += gridDim.x * NWAVE) {
    const bf16_t* ax = p.aux + (size_t)row * AUXW_;
    for (int n = lane; n < ZS2W_; n += 64) {
      const int pn = n >> 8, ch = n & 255; float acc = 0.f;
      if (pn == 0) for (int k = 0; k < 128; ++k) acc += bf2f(ax[k]) * p.w_uk[((size_t)l * KVR_ + k) * GWID_ + ch];
      else if (pn == 1) for (int k = 0; k < 128; ++k) acc += bf2f(ax[k]) * p.w_uv[((size_t)l * KVR_ + k) * GWID_ + ch];
      else if (pn <= 3) for (int k = 0; k < 64; ++k) acc += bf2f(ax[128 + k]) * p.rwkv_w2[(((size_t)l * 2 + (pn - 2)) * DLORA_ + k) * GWID_ + ch];
      else if (pn <= 5) for (int k = 0; k < 64; ++k) acc += bf2f(ax[192 + k]) * p.rwkv_a2[(((size_t)l * 2 + (pn - 4)) * ALORA_ + k) * GWID_ + ch];
      else for (int k = 0; k < 128; ++k) acc += bf2f(ax[256 + k]) * p.rwkv_g2[((size_t)l * GLORA_ + k) * GWID_ + ch];
      p.zs2[(size_t)row * ZS2W_ + n] = f2bf(acc);
    }
  }
}
__device__ __forceinline__ void phase_prepC(const Params& p, int l) {
  const int tid = otid(), wave = tid >> 6, lane = tid & 63;
  for (int row = obid() * NWAVE + wave; row < NROWS_; row += gridDim.x * NWAVE) {
    const bool isx = row < NTOK_; const int pos = row_pos(row), b = row_batch(row);
    const int kpos = isx ? LC_ + pos : pos;
    const int head = lane >> 4, sub = lane & 15, ch = 64 * head + 4 * sub;
    const bf16_t* zs = p.zs2 + (size_t)row * ZS2W_;
    {
      float kn[4]; ld4(zs + ch, kn);
      float ss = kn[0] * kn[0] + kn[1] * kn[1] + kn[2] * kn[2] + kn[3] * kn[3];
      ss += __shfl_xor(ss, 1); ss += __shfl_xor(ss, 2); ss += __shfl_xor(ss, 4); ss += __shfl_xor(ss, 8);
      const float rstd = rsqrtf((ss + p.kr2[row]) / (float)QK_ + 1e-6f);
      bf16_t* kd = p.kb + (((size_t)b * NH_ + head) * LK_ + kpos) * KLD_;
      const float* gk = p.g_k_norm + (size_t)l * QK_ + 4 * sub;
#pragma unroll
      for (int j = 0; j < 4; ++j) kn[j] = kn[j] * rstd * gk[j];
      st4(kd + 4 * sub, kn);
      float kr[2]; ld2(p.krp + (size_t)row * ROPE_ + 2 * sub, kr); kr[0] *= rstd; kr[1] *= rstd;
      st2(kd + HD_ + 2 * sub, kr);
      *(unsigned*)(kd + QK_ + 2 * sub) = 0u;
      *(U2_*)(p.vb + (((size_t)b * NH_ + head) * LK_ + kpos) * HD_ + 4 * sub) = *(const U2_*)(zs + 256 + ch);
    }
    {
      float kk[4], rr[4], k0[4];
#pragma unroll
      for (int j = 0; j < 4; ++j) { kk[j] = p.sc_kk[(size_t)row * GWID_ + ch + j]; rr[j] = p.sc_r[(size_t)row * GWID_ + ch + j]; }
      ld4(p.kbuf + (size_t)row * GWID_ + ch, k0);
      float bsum = 0.f;
#pragma unroll
      for (int d = 0; d < 2; ++d) {
        float lw[4], la[4];
        ld4(zs + 512 + d * 256 + ch, lw); ld4(zs + 1024 + d * 256 + ch, la);
        float* ow = p.sc_w + ((size_t)d * NROWS_ + row) * GWID_ + ch; float* oka = p.sc_kka + ((size_t)d * NROWS_ + row) * GWID_ + ch; float* okt = p.sc_kt + ((size_t)d * NROWS_ + row) * GWID_ + ch;
#pragma unroll
        for (int j = 0; j < 4; ++j) {
          const float x = lw[j] + p.rwkv_w0[(l * 2 + d) * GWID_ + ch + j];
          const float sp = (-x > 20.f) ? -x : log1pf(expf(-x));
          ow[j] = expf(-expf(-sp - 0.5f));
          const float a = sigmoidf_(la[j] + p.rwkv_a0[(l * 2 + d) * GWID_ + ch + j]);
          const float kt = k0[j] * (1.0f + (a - 1.0f) * p.rwkv_k_a[l * GWID_ + ch + j]);
          oka[j] = kk[j] * a; okt[j] = kt; bsum += rr[j] * kt * p.rwkv_r_k[l * GWID_ + ch + j];
        }
      }
      bsum += __shfl_xor(bsum, 1); bsum += __shfl_xor(bsum, 2); bsum += __shfl_xor(bsum, 4); bsum += __shfl_xor(bsum, 8);
      if (sub == 0) { p.sc_bonus[(size_t)row * NH_ + head] = bsum; p.sc_bonus[(size_t)(NROWS_ + row) * NH_ + head] = 0.f; }
      float g4[4]; ld4(zs + 1536 + ch, g4);
      float* og = p.sc_gate + (size_t)row * GWID_ + ch;
#pragma unroll
      for (int j = 0; j < 4; ++j) og[j] = g4[j];
    }
  }
}
#endif

__device__ __forceinline__ void phase_prep(const Params& p, int l) {
  float (*sm)[COLS_RWKV_ + 64] = (float (*)[COLS_RWKV_ + 64])SMEM_PTR();
  const int tid = otid(), wave = tid >> 6, lane = tid & 63;
  float* ws = sm[wave];
  const bool last = (l == DEPTH_ - 1);
  for (int row = obid() * NWAVE + wave; row < NROWS_; row += gridDim.x * NWAVE) {
    const bool isx = row < NTOK_;
    const int pos = row_pos(row), len = row_len(row), b = row_batch(row);
    const bf16_t* zr = p.z + (size_t)row * ZLD_;
    const bool hasp = pos > 0, hasn = pos < len - 1;
    const bf16_t* zp = zr - ZLD_; const bf16_t* zn = zr + ZLD_;
    const bool need_out = isx || !last;
    if (need_out) {
      const float* cw = p.conv_w + (size_t)l * 3 * GWID_;
      float t[GWID_ / 64]; float ss = 0.f;
#pragma unroll
      for (int i = 0; i < GWID_ / 64; ++i) {
        const int ch = i * 64 + lane;
        const float bv = bf2f(zr[ch]);
        const float u0 = bf2f(zr[GWID_ + ch]) * bf2f(zr[2 * GWID_ + ch]);
        const float up = hasp ? bf2f(zp[GWID_ + ch]) * bf2f(zp[2 * GWID_ + ch]) : 0.f;
        const float un = hasn ? bf2f(zn[GWID_ + ch]) * bf2f(zn[2 * GWID_ + ch]) : 0.f;
        const float yv = cw[ch] * up + cw[GWID_ + ch] * u0 + cw[2 * GWID_ + ch] * un;
        t[i] = bv * yv; ss += t[i] * t[i];
      }
      ss = wave_sum(ss);
      const float rstd = rsqrtf(ss / (float)GWID_ + 1e-6f);
#pragma unroll
      for (int i = 0; i < GWID_ / 64; ++i) { const int ch = i * 64 + lane; p.y[(size_t)row * D_ + ch] = f2bf(t[i] * rstd * p.g_out_conv[l * GWID_ + ch]); }
    }
    {
      const bf16_t* zm = zr + MLA0_;
      const int NF = ROPE_ / 4;
      const float* tab = p.tab_mla + (size_t)pos * 4 * NF;
      if (need_out) {
        for (int hh = 0; hh < NH_; ++hh) {
          float q0 = 0.f, q1 = 0.f;
          { const int e = lane; if (e < QK_) q0 = bf2f(e < HD_ ? zm[hh * HD_ + e] : zm[NH_ * HD_ + hh * ROPE_ + (e - HD_)]); }
          { const int e = lane + 64; if (e < QK_) q1 = bf2f(e < HD_ ? zm[hh * HD_ + e] : zm[NH_ * HD_ + hh * ROPE_ + (e - HD_)]); }
          const float ss = wave_sum(q0 * q0 + q1 * q1);
          const float rstd = rsqrtf(ss / (float)QK_ + 1e-6f);
          if (lane < QK_) ws[lane] = q0 * rstd * p.g_q_norm[l * QK_ + lane];
          if (lane + 64 < QK_) ws[lane + 64] = q1 * rstd * p.g_q_norm[l * QK_ + lane + 64];
          __builtin_amdgcn_wave_barrier();
          const float scale = 1.0f / sqrtf((float)QK_);
          for (int e = lane; e < QK_; e += 64) {
            float v = ws[e];
            if (isx && e >= HD_) {
              const int r = e - HD_; const int ax = r / (ROPE_ / 2), ri = r % (ROPE_ / 2); const int half = ri / NF, fi = ri % NF;
              const float cs = tab[(ax * 2 + 0) * NF + fi], sn = tab[(ax * 2 + 1) * NF + fi];
              const int base = HD_ + ax * (ROPE_ / 2);
              const float t1 = ws[base + fi], t2 = ws[base + NF + fi];
              v = half == 0 ? t1 * cs - t2 * sn : t1 * sn + t2 * cs;
            }
            p.qb[((size_t)row * NH_ + hh) * QK_ + e] = f2bf(v * scale);
          }
          __builtin_amdgcn_wave_barrier();
        }
      }
      float cs2 = 0.f;
      for (int e = lane; e < KVR_; e += 64) { const float v = bf2f(zm[NH_ * QK_ + e]); cs2 += v * v; }
      cs2 = wave_sum(cs2);
      const float crstd = rsqrtf(cs2 / (float)KVR_ + 1e-6f);
      for (int e = lane; e < KVR_; e += 64) ws[e] = bf2f(zm[NH_ * QK_ + e]) * crstd * p.g_kv_norm[l * KVR_ + e];
      __builtin_amdgcn_wave_barrier();
      float kn[GWID_ / 64], vv[GWID_ / 64];
#pragma unroll
      for (int i = 0; i < GWID_ / 64; ++i) { kn[i] = 0.f; vv[i] = 0.f; }
      const float* wuk = p.w_uk + (size_t)l * KVR_ * GWID_; const float* wuv = p.w_uv + (size_t)l * KVR_ * GWID_;
#pragma unroll 4
      for (int k = 0; k < KVR_; ++k) {
        const float cv = ws[k];
#pragma unroll
        for (int i = 0; i < GWID_ / 64; ++i) { kn[i] += cv * wuk[k * GWID_ + i * 64 + lane]; vv[i] += cv * wuv[k * GWID_ + i * 64 + lane]; }
      }
      __builtin_amdgcn_wave_barrier();
      const int kpos = isx ? LC_ + pos : pos;
#pragma unroll
      for (int i = 0; i < GWID_ / 64; ++i) {
        const int cidx = i * 64 + lane, hh = cidx / HD_, e = cidx % HD_;
        p.vb[(((size_t)b * NH_ + hh) * LK_ + kpos) * HD_ + e] = f2bf(vv[i]);
        ws[64 + cidx] = kn[i];
      }
      for (int e = lane; e < ROPE_; e += 64) ws[64 + GWID_ + e] = bf2f(zm[NH_ * QK_ + KVR_ + e]);
      __builtin_amdgcn_wave_barrier();
      float kr2 = 0.f;
      for (int e = lane; e < ROPE_; e += 64) { const float v = ws[64 + GWID_ + e]; kr2 += v * v; }
      kr2 = wave_sum(kr2);
      for (int hh = 0; hh < NH_; ++hh) {
        float s2 = 0.f;
        for (int e = lane; e < HD_; e += 64) { const float v = ws[64 + hh * HD_ + e]; s2 += v * v; }
        s2 = wave_sum(s2) + kr2;
        const float rstd = rsqrtf(s2 / (float)QK_ + 1e-6f);
        for (int e = lane; e < QK_; e += 64) {
          float v;
          if (e < HD_) v = ws[64 + hh * HD_ + e] * rstd * p.g_k_norm[l * QK_ + e];
          else {
            const int r = e - HD_;
            if (!isx) v = ws[64 + GWID_ + r] * rstd * p.g_k_norm[l * QK_ + e];
            else {
              const int ax = r / (ROPE_ / 2), ri = r % (ROPE_ / 2); const int half = ri / NF, fi = ri % NF;
              const float cs = tab[(ax * 2 + 0) * NF + fi], sn = tab[(ax * 2 + 1) * NF + fi];
              const int i1 = ax * (ROPE_ / 2) + fi, i2 = i1 + NF;
              const float t1 = ws[64 + GWID_ + i1] * rstd * p.g_k_norm[l * QK_ + HD_ + i1], t2 = ws[64 + GWID_ + i2] * rstd * p.g_k_norm[l * QK_ + HD_ + i2];
              v = half == 0 ? t1 * cs - t2 * sn : t1 * sn + t2 * cs;
            }
          }
          p.kb[(((size_t)b * NH_ + hh) * LK_ + kpos) * KLD_ + e] = f2bf(v);
        }
        for (int e = QK_ + lane; e < KLD_; e += 64) p.kb[(((size_t)b * NH_ + hh) * LK_ + kpos) * KLD_ + e] = 0;
      }
      __builtin_amdgcn_wave_barrier();
    }
    {
      const bf16_t* zw = zr + RW0_; const bf16_t* zwp = zp + RW0_; const bf16_t* zwn = zn + RW0_;
      const float* mu = p.rwkv_mu + (size_t)l * COLS_RWKV_;
      for (int e = lane; e < COLS_RWKV_; e += 64) {
        const float zc = bf2f(zw[e]); const float pv = hasp ? bf2f(zwp[e]) : 0.f; const float nv = hasn ? bf2f(zwn[e]) : 0.f;
        ws[e] = zc + mu[e] * (0.5f * (pv + nv) - zc);
      }
      __builtin_amdgcn_wave_barrier();
      for (int j = lane; j < DLORA_; j += 64) ws[3 * GWID_ + j] = tanhf(ws[3 * GWID_ + j]);
      for (int j = lane; j < GLORA_; j += 64) ws[3 * GWID_ + DLORA_ + ALORA_ + j] = sigmoidf_(ws[3 * GWID_ + DLORA_ + ALORA_ + j]);
      __builtin_amdgcn_wave_barrier();
      const float* zs = ws;
      const float* w2 = p.rwkv_w2 + (size_t)l * 2 * DLORA_ * GWID_; const float* a2 = p.rwkv_a2 + (size_t)l * 2 * ALORA_ * GWID_; const float* g2 = p.rwkv_g2 + (size_t)l * GLORA_ * GWID_;
      float bon[GWID_ / 64];
#pragma unroll
      for (int i = 0; i < GWID_ / 64; ++i) {
        const int ch = i * 64 + lane;
        const float rr = zs[ch], kk0 = zs[GWID_ + ch], vvv = zs[2 * GWID_ + ch];
        const float kkr = kk0 * p.rwkv_k_k[l * GWID_ + ch];
        float s2 = kkr * kkr;
        for (int m = 1; m < HD_ && m < 64; m <<= 1) s2 += __shfl_xor(s2, m);
        const float kkn = kkr * rsqrtf(s2 + 1e-12f);
        float gacc = 0.f;
#pragma unroll 4
        for (int j = 0; j < GLORA_; ++j) gacc += zs[3 * GWID_ + DLORA_ + ALORA_ + j] * g2[j * GWID_ + ch];
        float ksum = 0.f;
#pragma unroll 1
        for (int d = 0; d < 2; ++d) {
          float lw = p.rwkv_w0[(l * 2 + d) * GWID_ + ch], la = p.rwkv_a0[(l * 2 + d) * GWID_ + ch];
#pragma unroll 4
          for (int j = 0; j < DLORA_; ++j) lw += zs[3 * GWID_ + j] * w2[(d * DLORA_ + j) * GWID_ + ch];
#pragma unroll 4
          for (int j = 0; j < ALORA_; ++j) la += zs[3 * GWID_ + DLORA_ + j] * a2[(d * ALORA_ + j) * GWID_ + ch];
          const float sp = (-lw > 20.f) ? -lw : log1pf(expf(-lw));
          const float wdec = expf(-expf(-sp - 0.5f));
          const float a = sigmoidf_(la);
          const float kt = kk0 * (1.0f + (a - 1.0f) * p.rwkv_k_a[l * GWID_ + ch]);
          const size_t o = ((size_t)d * NROWS_ + row) * GWID_ + ch;
          p.sc_w[o] = wdec; p.sc_kka[o] = kkn * a; p.sc_kt[o] = kt; ksum += kt;
        }
        const size_t o = (size_t)row * GWID_ + ch;
        p.sc_r[o] = rr; p.sc_v[o] = vvv; p.sc_kk[o] = kkn; p.sc_gate[o] = gacc;
        float bs = rr * ksum * p.rwkv_r_k[l * GWID_ + ch];
        for (int m = 1; m < HD_ && m < 64; m <<= 1) bs += __shfl_xor(bs, m);
        bon[i] = bs;
      }
#pragma unroll
      for (int i = 0; i < GWID_ / 64; ++i) {
        const int ch = i * 64 + lane;
        if ((ch % HD_) == 0) { p.sc_bonus[(size_t)row * NH_ + ch / HD_] = bon[i]; p.sc_bonus[(size_t)(NROWS_ + row) * NH_ + ch / HD_] = 0.f; }
      }
      __builtin_amdgcn_wave_barrier();
    }
    {
      const bf16_t* zt = zr + RT0_;
      const int NR = HD_ / 2;
      const float* tab = p.tab_ret + (size_t)pos * 2 * NR;
      const float qs = 1.0f / sqrtf((float)HD_);
#pragma unroll
      for (int i = 0; i < GWID_ / 64; ++i) {
        const int ch = i * 64 + lane, hh = ch / HD_, e = ch % HD_;
        float q = bf2f(zt[ch]) * qs, k = bf2f(zt[GWID_ + ch]);
        if (isx) {
          const int fi = e % NR; const int half = e / NR;
          const int c1 = hh * HD_ + fi, c2 = c1 + NR;
          const float q1 = bf2f(zt[c1]) * qs, q2 = bf2f(zt[c2]) * qs, k1 = bf2f(zt[GWID_ + c1]), k2 = bf2f(zt[GWID_ + c2]);
          const float cs = tab[fi], sn = tab[NR + fi];
          q = half == 0 ? q1 * cs - q2 * sn : q1 * sn + q2 * cs;
          k = half == 0 ? k1 * cs - k2 * sn : k1 * sn + k2 * cs;
        }
        p.rq[(size_t)row * GWID_ + ch] = f2bf(q); p.rk[(size_t)row * GWID_ + ch] = f2bf(k); p.rv[(size_t)row * GWID_ + ch] = zt[2 * GWID_ + ch];
      }
    }
  }
}

__device__ __forceinline__ int chunk_row0(int b, int n) { return n < NCC_ ? NTOK_ + b * LC_ + n * RCH_ : b * L_ + (n - NCC_) * RCH_; }
__device__ __forceinline__ float ret_lg(int hh) { return log1pf(-exp2f(-5.0f - (float)hh)); }

__device__ __forceinline__ void phase_retd(const Params& p, int l) {
  const int tid = otid();
  const int nunits = B_ * NH_ * NCH_ * 2;
  for (int u = obid(); u < nunits; u += gridDim.x) {
    const int d = u & 1, n = (u >> 1) % NCH_, hh = ((u >> 1) / NCH_) % NH_, b = (u >> 1) / (NCH_ * NH_);
    const int r0 = chunk_row0(b, n);
    const float lg = ret_lg(hh);
    float* o = p.rd + ((((size_t)b * NH_ + hh) * NCH_ + n) * 2 + d) * HD_ * HD_;
    for (int e = tid; e < HD_ * HD_; e += NT) {
      const int kc = e / HD_, vc = e % HD_;
      float acc = 0.f;
      for (int c = 0; c < RCH_; ++c) {
        const float zeta = expf((d == 0 ? (float)(RCH_ - 1 - c) : (float)c) * lg);
        acc += zeta * bf2f(p.rk[(size_t)(r0 + c) * GWID_ + hh * HD_ + kc]) * bf2f(p.rv[(size_t)(r0 + c) * GWID_ + hh * HD_ + vc]);
      }
      o[e] = acc;
    }
  }
}

template <bool WITH_ATTN, bool WITH_SCAN, bool RS_BF16 = false> __device__ __forceinline__ void phase_mix(const Params& p, int l) {
  const int tid = otid(), wave = tid >> 6, lane = tid & 63;
  const bool last = (l == DEPTH_ - 1);
  for (int u = obid(); u < B_ * NH_ * 2; u += gridDim.x) {
    const int d = u & 1, hh = (u >> 1) % NH_, b = (u >> 1) / NH_;
    const float dec = expf((float)RCH_ * ret_lg(hh));
    for (int e = tid; e < HD_ * HD_; e += NT) {
      float st = 0.f;
      for (int i = 0; i < NCH_; ++i) {
        int n;
        if (d == 0) n = i; else n = i < NCC_ ? (NCC_ - 1 - i) : (NCC_ + (NCH_ - 1 - i));
        const size_t o = ((((size_t)b * NH_ + hh) * NCH_ + n) * 2 + d) * HD_ * HD_ + e;
        if (RS_BF16) ((bf16_t*)p.rs)[o] = f2bf(st); else p.rs[o] = st;
        st = st * dec + p.rd[o];
      }
    }
  }
  if (WITH_SCAN) for (int u = obid() * NWAVE + wave; u < B_ * NH_ * 2; u += gridDim.x * NWAVE) {
    const int d = u & 1, hh = (u >> 1) % NH_, b = (u >> 1) / NH_;
    float s[HD_];
#pragma unroll
    for (int k = 0; k < HD_; ++k) s[k] = 0.f;
    const int vr = lane % HD_;
    for (int i = 0; i < LK_; ++i) {
      int row;
      if (d == 0) row = i < LC_ ? NTOK_ + b * LC_ + i : b * L_ + (i - LC_);
      else row = i < LC_ ? NTOK_ + b * LC_ + (LC_ - 1 - i) : b * L_ + (L_ - 1 - (i - LC_));
      const size_t o1 = (size_t)row * GWID_ + hh * HD_, o2 = ((size_t)d * NROWS_ + row) * GWID_ + hh * HD_;
      const float vt = p.sc_v[o1 + vr];
      float sa = 0.f;
#pragma unroll
      for (int k = 0; k < HD_; ++k) sa += s[k] * p.sc_kk[o1 + k];
      float yv = 0.f;
#pragma unroll
      for (int k = 0; k < HD_; ++k) { s[k] = s[k] * p.sc_w[o2 + k] - sa * p.sc_kka[o2 + k] + vt * p.sc_kt[o2 + k]; yv += s[k] * p.sc_r[o1 + k]; }
      if (lane < HD_) p.ys[o2 + vr] = yv;
    }
  }
  if (WITH_ATTN) {
    const int nq = last ? NTOK_ : NROWS_;
    for (int idx = obid() * NT + tid; idx < ((nq + NT - 1) / NT) * NT * NH_; idx += gridDim.x * NT) {
      const int blk = idx / (NT * NH_), rem = idx % (NT * NH_), hh = rem / NT, row = blk * NT + rem % NT;
      if (row >= nq) continue;
      const bool isx = row < NTOK_; const int b = row_batch(row);
      const int nk = isx ? LK_ : LC_;
      unsigned q[QK_ / 2]; float o[HD_];
      { const unsigned* qp = (const unsigned*)(p.qb + ((size_t)row * NH_ + hh) * QK_);
#pragma unroll
        for (int e = 0; e < QK_ / 2; ++e) q[e] = qp[e]; }
#pragma unroll
      for (int e = 0; e < HD_; ++e) o[e] = 0.f;
      float m = -1e30f, lsum = 0.f;
      const bf16_t* kbase = p.kb + ((size_t)b * NH_ + hh) * LK_ * KLD_; const bf16_t* vbase = p.vb + ((size_t)b * NH_ + hh) * LK_ * HD_;
      for (int j = 0; j < nk; ++j) {
        float sdot = 0.f;
        const unsigned* kp = (const unsigned*)(kbase + (size_t)j * KLD_);
#pragma unroll
        for (int e = 0; e < QK_ / 2; ++e) { const unsigned kq = kp[e], qq = q[e];
          union { unsigned u; float f; } a0, a1, b0, b1; a0.u = qq << 16; a1.u = qq & 0xFFFF0000u; b0.u = kq << 16; b1.u = kq & 0xFFFF0000u;
          sdot += a0.f * b0.f + a1.f * b1.f; }
        if (sdot > m) { const float corr = expf(m - sdot); lsum *= corr;
#pragma unroll
          for (int e = 0; e < HD_; ++e) o[e] *= corr;
          m = sdot; }
        const float pj = expf(sdot - m); lsum += pj;
#pragma unroll
        for (int e = 0; e < HD_; ++e) o[e] += pj * bf2f(vbase[(size_t)j * HD_ + e]);
      }
      const float il = 1.0f / lsum;
#pragma unroll
      for (int e = 0; e < HD_; ++e) p.ob[(size_t)row * GWID_ + hh * HD_ + e] = o[e] * il;
    }
  }
}


#ifndef CPU_EMU
namespace fa {
using bf16x8 = __attribute__((ext_vector_type(8))) short;
using s16x4  = __attribute__((ext_vector_type(4))) short;
using f32x16 = __attribute__((ext_vector_type(16))) float;
using u32x4  = __attribute__((ext_vector_type(4))) unsigned;
constexpr int NW = 8, QBLK = 32, KVBLK = 64, ND0 = QK_ / 16, NDV = HD_ / 32;
constexpr float THR = 8.f;
constexpr int LDQ = NH_ * QK_, LDKK = KLD_, LDV = HD_, LDO = GWID_;
constexpr size_t SHM_V = KVBLK * HD_ * 2, SHM_K = KVBLK * KLD_ * 2, SHM_ATTN = 2 * SHM_V + 2 * SHM_K + NW * 64 * 4;
#define KSWZ(row, colB) ((row) * 256 + ((colB) ^ (((row) & 7) << 4)))
#define SBAR() __builtin_amdgcn_sched_barrier(0)
__device__ __forceinline__ int crow(int r, int hi) { return (r & 3) + 8 * (r >> 2) + 4 * hi; }
__device__ __forceinline__ unsigned cvtpk(float lo, float hi) { unsigned r; asm volatile("v_cvt_pk_bf16_f32 %0, %1, %2" : "=v"(r) : "v"(lo), "v"(hi)); return r; }
__device__ __forceinline__ void partialSM(f32x16& p0, f32x16& p1, float& m_reg, float& mn, float& alpha) {
  constexpr float C = 1.4426950408889634f;
  float pmax = p0[0];
#pragma unroll
  for (int r = 1; r < 16; ++r) pmax = fmaxf(pmax, p0[r]);
#pragma unroll
  for (int r = 0; r < 16; ++r) pmax = fmaxf(pmax, p1[r]);
  { auto rr = __builtin_amdgcn_permlane32_swap(__float_as_uint(pmax), __float_as_uint(pmax), false, false);
    pmax = fmaxf(__uint_as_float(rr[0]), __uint_as_float(rr[1])); }
  if (__builtin_expect(__all(pmax - m_reg <= THR), 1)) { mn = m_reg; alpha = 1.f; }
  else { mn = fmaxf(m_reg, pmax); alpha = __builtin_amdgcn_exp2f((m_reg - mn) * C); m_reg = mn; }
  const float mnC = -mn * C;
#pragma unroll
  for (int r = 0; r < 16; ++r) p0[r] = fmaf(p0[r], C, mnC);
#pragma unroll
  for (int r = 0; r < 16; ++r) p1[r] = fmaf(p1[r], C, mnC);
#pragma unroll
  for (int r = 0; r < 16; ++r) p0[r] = __builtin_amdgcn_exp2f(p0[r]);
}
__device__ __forceinline__ void finishSM(f32x16& p0, f32x16& p1, float alpha, float& l_reg, bf16x8& pa0, bf16x8& pa1, bf16x8& pa2, bf16x8& pa3) {
#pragma unroll
  for (int r = 0; r < 16; ++r) p1[r] = __builtin_amdgcn_exp2f(p1[r]);
  float ps = 0;
#pragma unroll
  for (int r = 0; r < 16; ++r) ps += p0[r];
#pragma unroll
  for (int r = 0; r < 16; ++r) ps += p1[r];
  { auto rr = __builtin_amdgcn_permlane32_swap(__float_as_uint(ps), __float_as_uint(ps), false, false);
    ps = __uint_as_float(rr[0]) + __uint_as_float(rr[1]); }
  l_reg = l_reg * alpha + ps;
#define PK4(P, BASE, OUT) do { unsigned a0 = cvtpk(P[BASE + 0], P[BASE + 1]), a1 = cvtpk(P[BASE + 2], P[BASE + 3]);   \
    unsigned b0 = cvtpk(P[BASE + 4], P[BASE + 5]), b1 = cvtpk(P[BASE + 6], P[BASE + 7]);                              \
    auto r0 = __builtin_amdgcn_permlane32_swap(a0, b0, false, false); auto r1 = __builtin_amdgcn_permlane32_swap(a1, b1, false, false); \
    u32x4 w = {r0[0], r1[0], r0[1], r1[1]}; OUT = *reinterpret_cast<bf16x8*>(&w); } while (0)
  PK4(p0, 0, pa0); PK4(p0, 8, pa1); PK4(p1, 0, pa2); PK4(p1, 8, pa3);
#undef PK4
}
__device__ __forceinline__ void qkt(f32x16& p0, f32x16& p1, const char* Ks, const bf16x8* qr, int r32, int hi) {
  p0 = f32x16{}; p1 = f32x16{};
#pragma unroll
  for (int d0 = 0; d0 < ND0; ++d0) { const int cb = (d0 * 16 + hi * 8) * 2;
    bf16x8 b0 = *reinterpret_cast<const bf16x8*>(Ks + KSWZ(r32, cb));
    bf16x8 b1 = *reinterpret_cast<const bf16x8*>(Ks + KSWZ(32 + r32, cb));
    p0 = __builtin_amdgcn_mfma_f32_32x32x16_bf16(b0, qr[d0], p0, 0, 0, 0);
    p1 = __builtin_amdgcn_mfma_f32_32x32x16_bf16(b1, qr[d0], p1, 0, 0, 0); }
}
__device__ __forceinline__ int v_st(int k, int c) { const int kk = (k & ~0xC) | ((k & 4) << 1) | ((k & 8) >> 1); return ((kk >> 3) * NDV + (c >> 5)) * 512 + ((kk & 7) * 32 + (c & 31)) * 2; }
__device__ __forceinline__ int v_rd_base(int lane) { return ((lane & 3) << 3) | (((lane >> 2) & 3) << 6) | (((lane >> 4) & 1) << 5) | (((lane >> 5) & 1) << 8); }
constexpr int v_rd_off(int d0, int ks, int half) { return d0 * 512 + ks * (2 * NDV * 512) + half * (NDV * 512); }
template <int OFF> __device__ __forceinline__ s16x4 tr_read(int vb) { s16x4 r; asm volatile("ds_read_b64_tr_b16 %0, %1 offset:%2" : "=&v"(r) : "v"(vb), "i"(OFF) : "memory"); return r; }
template <int D0> __device__ __forceinline__ void pv_one(f32x16& od, int vb, bf16x8 pa0, bf16x8 pa1, bf16x8 pa2, bf16x8 pa3) {
  const s16x4 l0 = tr_read<v_rd_off(D0, 0, 0)>(vb), h0 = tr_read<v_rd_off(D0, 0, 1)>(vb), l1 = tr_read<v_rd_off(D0, 1, 0)>(vb), h1 = tr_read<v_rd_off(D0, 1, 1)>(vb);
  const s16x4 l2 = tr_read<v_rd_off(D0, 2, 0)>(vb), h2 = tr_read<v_rd_off(D0, 2, 1)>(vb), l3 = tr_read<v_rd_off(D0, 3, 0)>(vb), h3 = tr_read<v_rd_off(D0, 3, 1)>(vb);
  asm volatile("s_waitcnt lgkmcnt(0)" ::: "memory"); SBAR();
#define PK(L, H) (bf16x8){L[0], L[1], L[2], L[3], H[0], H[1], H[2], H[3]}
  od = __builtin_amdgcn_mfma_f32_32x32x16_bf16(pa0, PK(l0, h0), od, 0, 0, 0);
  od = __builtin_amdgcn_mfma_f32_32x32x16_bf16(pa1, PK(l1, h1), od, 0, 0, 0);
  od = __builtin_amdgcn_mfma_f32_32x32x16_bf16(pa2, PK(l2, h2), od, 0, 0, 0);
  od = __builtin_amdgcn_mfma_f32_32x32x16_bf16(pa3, PK(l3, h3), od, 0, 0, 0);
#undef PK
}
__device__ __forceinline__ void pv_d0(f32x16* o, int vb, bf16x8 pa0, bf16x8 pa1, bf16x8 pa2, bf16x8 pa3) {
  pv_one<0>(o[0], vb, pa0, pa1, pa2, pa3); pv_one<1>(o[1], vb, pa0, pa1, pa2, pa3);
}
__device__ __forceinline__ void attn_body(const bf16_t* __restrict__ Qb, const bf16_t* __restrict__ Kh, const bf16_t* __restrict__ Vh, float* __restrict__ Ob, int seq, char* lds) {
  const int tid = otid(), wid = tid >> 6, lane = tid & 63, r32 = lane & 31, hi = lane >> 5;
  char* V_lds = lds; char* K_lds = lds + 2 * SHM_V;
  float* ws = (float*)(lds + 2 * SHM_V + 2 * SHM_K) + wid * 64; float* li_l = ws; float* al_l = ws + 32;
  float m_reg = -1e30f, l_reg = 0; f32x16 o[NDV] = {}; bf16x8 qr[ND0];
  const bf16_t* Qw = Qb + (long)(wid * QBLK + r32) * LDQ + hi * 8;
#pragma unroll
  for (int d0 = 0; d0 < ND0; ++d0) qr[d0] = *reinterpret_cast<const bf16x8*>(Qw + d0 * 16);
  const int sr = tid >> 4, sc = (tid & 15) * 8;
  const int vr = tid >> 3, vc = (tid & 7) * 8, vst0 = v_st(vr, vc);
  const int vb0 = (int)(uintptr_t)V_lds + v_rd_base(lane);
  struct { bf16x8 vs0, ks0, ks1; } sr_[2];
#define SLOAD(i, k0) do { sr_[i].vs0 = *reinterpret_cast<const bf16x8*>(&Vh[(long)((k0) + vr) * LDV + vc]); \
    sr_[i].ks0 = *reinterpret_cast<const bf16x8*>(&Kh[(long)((k0) + sr) * LDKK + sc]); sr_[i].ks1 = *reinterpret_cast<const bf16x8*>(&Kh[(long)((k0) + 32 + sr) * LDKK + sc]); } while (0)
#define SWRITE(b, i) do { *(bf16x8*)(V_lds + (b) * SHM_V + vst0) = sr_[i].vs0; const int kc = sc * 2;               \
    *(bf16x8*)(K_lds + (b) * SHM_K + KSWZ(sr, kc)) = sr_[i].ks0;                       \
    *(bf16x8*)(K_lds + (b) * SHM_K + KSWZ(32 + sr, kc)) = sr_[i].ks1; } while (0)
#define SWAIT() asm volatile("s_waitcnt vmcnt(3)" ::: "memory")
#define RESC(a) do { if (__any((a) < 1.f)) { if (hi == 0) al_l[r32] = (a); asm volatile("s_waitcnt lgkmcnt(0)" ::: "memory"); \
    _Pragma("unroll") for (int d = 0; d < NDV; ++d) _Pragma("unroll") for (int r = 0; r < 16; ++r) o[d][r] *= al_l[crow(r, hi)]; } } while (0)
  f32x16 pA0, pA1, pB0, pB1; float mnA, mnB, alA, alB; bf16x8 pa0, pa1, pa2, pa3; const int NTL = seq / KVBLK;
  constexpr int SE = 0, SO = 1;
  SLOAD(SE, 0); asm volatile("s_waitcnt vmcnt(0)" ::: "memory"); SWRITE(0, SE); __syncthreads();
  qkt(pA0, pA1, K_lds, qr, r32, hi); partialSM(pA0, pA1, m_reg, mnA, alA);
  SLOAD(SO, KVBLK); if (2 < NTL) SLOAD(SE, 2 * KVBLK);
  SWAIT(); SWRITE(1, SO); __syncthreads();
  for (int j = 1; j + 1 < NTL; j += 2) {
    SBAR(); qkt(pB0, pB1, K_lds + SHM_K, qr, r32, hi);
    finishSM(pA0, pA1, alA, l_reg, pa0, pa1, pa2, pa3); SBAR();
    SLOAD(SO, (j + 2) * KVBLK); SBAR();
    pv_d0(o, vb0, pa0, pa1, pa2, pa3); partialSM(pB0, pB1, m_reg, mnB, alB);
    __syncthreads(); SWAIT(); SWRITE(0, SE);
    RESC(alB); __syncthreads();
    SBAR(); qkt(pA0, pA1, K_lds, qr, r32, hi);
    finishSM(pB0, pB1, alB, l_reg, pa0, pa1, pa2, pa3); SBAR();
    if (j + 3 < NTL) SLOAD(SE, (j + 3) * KVBLK); SBAR();
    pv_d0(o, vb0 + (int)SHM_V, pa0, pa1, pa2, pa3); partialSM(pA0, pA1, m_reg, mnA, alA);
    __syncthreads(); SWAIT(); SWRITE(1, SO);
    RESC(alA); __syncthreads();
  }
  SBAR(); qkt(pB0, pB1, K_lds + SHM_K, qr, r32, hi);
  finishSM(pA0, pA1, alA, l_reg, pa0, pa1, pa2, pa3); SBAR();
  pv_d0(o, vb0, pa0, pa1, pa2, pa3); partialSM(pB0, pB1, m_reg, mnB, alB);
  __syncthreads(); RESC(alB);
  finishSM(pB0, pB1, alB, l_reg, pa0, pa1, pa2, pa3); SBAR();
  pv_d0(o, vb0 + (int)SHM_V, pa0, pa1, pa2, pa3);
  if (hi == 0) li_l[r32] = l_reg; asm volatile("s_waitcnt lgkmcnt(0)" ::: "memory");
  float rli[16];
#pragma unroll
  for (int r = 0; r < 16; ++r) rli[r] = __builtin_amdgcn_rcpf(li_l[crow(r, hi)]);
  float* Ow = Ob + (long)(wid * QBLK) * LDO;
#pragma unroll
  for (int r = 0; r < 16; ++r) { const int orow = crow(r, hi);
#pragma unroll
    for (int d0 = 0; d0 < NDV; ++d0) Ow[(long)orow * LDO + d0 * 32 + r32] = o[d0][r] * rli[r]; }
#undef SLOAD
#undef SWRITE
#undef SWAIT
#undef RESC
}
}

__device__ __forceinline__ void phase_attn(const Params& p, int l) {
  const bool last = (l == DEPTH_ - 1);
  const int c = obid(), G = gridDim.x;
  const int nx = B_ * NH_ * (L_ / 256), nc = last ? 0 : B_ * NH_ * (LC_ / 256);
  char* lds = (char*)SMEM_PTR();
  for (int i = 0; i * G + c < nx + nc; ++i) {
    const int u = i * G + c;
    int b, hh, r0, seq;
    if (u < nx) {
      int pair, qb;
      if (G == 256) { pair = i * 16 + 2 * (c & 7) + ((c >> 3) >> 4); qb = (c >> 3) & 15; } else { pair = u / (L_ / 256); qb = u % (L_ / 256); }
      b = pair / NH_; hh = pair % NH_; r0 = b * L_ + qb * 256; seq = LK_;
    } else { const int v = u - nx; hh = v % NH_; b = v / NH_; r0 = NTOK_ + b * LC_; seq = LC_; }
    __syncthreads();
    fa::attn_body(p.qb + ((size_t)r0 * NH_ + hh) * QK_, p.kb + ((size_t)b * NH_ + hh) * LK_ * KLD_, p.vb + ((size_t)b * NH_ + hh) * LK_ * HD_, p.ob + (size_t)r0 * GWID_ + hh * HD_, seq, lds);
  }
  __syncthreads();
}
#endif


#ifndef CPU_EMU
namespace sc {
typedef float f2 __attribute__((ext_vector_type(2)));
typedef float f4 __attribute__((ext_vector_type(4)));
constexpr int CH = 32, NCHK = LK_ / CH, VECB = CH * HD_ * 4, VOFF = 5 * VECB, BUFB = VOFF + CH * 16 * 4;
static_assert(3 * BUFB <= XBW_OFF_, "scan ring fits LDS");
template <int CTRL> __device__ __forceinline__ float dpp_add(float v) {
  return v + __builtin_bit_cast(float, __builtin_amdgcn_update_dpp(0, __builtin_bit_cast(int, v), CTRL, 0xF, 0xF, true));
}
__device__ __forceinline__ float allreduce16(float v) { v = dpp_add<0xB1>(v); v = dpp_add<0x4E>(v); v = dpp_add<0x141>(v); v = dpp_add<0x140>(v); return v; }
__device__ __forceinline__ int step_row(int s, int b, int d) {
  if (d == 0) return s < LC_ ? NTOK_ + b * LC_ + s : b * L_ + (s - LC_);
  return s < LC_ ? NTOK_ + b * LC_ + (LC_ - 1 - s) : b * L_ + (L_ - 1 - (s - LC_));
}
struct In { f4 kk, kka, w, kt, r; float v; };
}
__device__ __forceinline__ void phase_scan(const Params& p, int l, LAS unsigned char* lds) {
  using namespace sc;
  (void)l;
  const int tid = otid(), wid = __builtin_amdgcn_readfirstlane(tid >> 6), lane = tid & 63;
  const int G = gridDim.x;
  for (int u = obid(); u < B_ * NH_ * 2 * 4; u += G) {
    const int rg = (u >> 3) & 3, pi = (u & 7) + 8 * (u >> 5), d = pi & 1, hh = (pi >> 1) % NH_, b = pi / (2 * NH_);
    __syncthreads();
    if (wid >= 4) {
      const int lw = wid - 4;
      const size_t doff = (size_t)d * NROWS_ * GWID_;
      const float* b0 = p.sc_kk + hh * HD_ + (lane & 15) * 4;
      const float* b1 = p.sc_kka + doff + hh * HD_ + (lane & 15) * 4;
      const float* b2 = p.sc_w + doff + hh * HD_ + (lane & 15) * 4;
      const float* b3 = p.sc_kt + doff + hh * HD_ + (lane & 15) * 4;
      const float* b4 = p.sc_r + hh * HD_ + (lane & 15) * 4;
      const float* bv = p.sc_v + hh * HD_ + rg * 16 + (lane & 3) * 4;
#define SC_ISSUE(chunk) do { const int _ck = (chunk); LAS unsigned char* _buf = lds + (_ck % 3) * BUFB; \
        _Pragma("unroll") for (int k = 0; k < 10; ++k) { const int tg = (k & 1) * 4 + lw; const int srow = step_row(_ck * CH + tg * 4 + (lane >> 4), b, d); \
          const float* bp = (k >> 1) == 0 ? b0 : (k >> 1) == 1 ? b1 : (k >> 1) == 2 ? b2 : (k >> 1) == 3 ? b3 : b4; \
          __builtin_amdgcn_global_load_lds((const unsigned*)(bp + (size_t)srow * GWID_), (LAS unsigned*)(_buf + (k >> 1) * VECB + tg * 1024), 16, 0, 0); } \
        if (lw < 2) { const int srow = step_row(_ck * CH + lw * 16 + (lane >> 2), b, d); \
          __builtin_amdgcn_global_load_lds((const unsigned*)(bv + (size_t)srow * GWID_), (LAS unsigned*)(_buf + VOFF + lw * 1024), 16, 0, 0); } } while (0)
#define SC_WAITK() do { if (lw < 2) asm volatile("s_waitcnt vmcnt(11)" ::: "memory"); else asm volatile("s_waitcnt vmcnt(10)" ::: "memory"); } while (0)
      SC_ISSUE(0); SC_ISSUE(1);
      SC_WAITK();
      __builtin_amdgcn_s_barrier();
      for (int ck = 0; ck < NCHK; ++ck) {
        if (ck + 2 < NCHK) { SC_ISSUE(ck + 2); SC_WAITK(); } else asm volatile("s_waitcnt vmcnt(0)" ::: "memory");
        __builtin_amdgcn_s_barrier();
      }
#undef SC_ISSUE
#undef SC_WAITK
    } else {
      const int seg = lane & 15, rowl = wid * 4 + (lane >> 4);
      f2 s01 = {0.f, 0.f}, s23 = {0.f, 0.f};
      float* yb = p.ys + (size_t)d * NROWS_ * GWID_ + hh * HD_ + rg * 16 + rowl;
      __builtin_amdgcn_s_barrier();
      for (int ck = 0; ck < NCHK; ++ck) {
        const LAS unsigned char* buf = lds + (ck % 3) * BUFB;
        const LAS unsigned char* vb = buf + seg * 16;
        const LAS unsigned char* vv = buf + VOFF + rowl * 4;
        const int row0 = step_row(ck * CH, b, d);
        const long rstep = d == 0 ? (long)GWID_ : -(long)GWID_;
        float* yp = yb + (size_t)row0 * GWID_;
        In in[2];
#define SC_LOAD(dst, t) do { dst.kk = *(const LAS f4*)(vb + 0 * VECB + (t) * 256); dst.kka = *(const LAS f4*)(vb + 1 * VECB + (t) * 256); dst.w = *(const LAS f4*)(vb + 2 * VECB + (t) * 256); \
          dst.kt = *(const LAS f4*)(vb + 3 * VECB + (t) * 256); dst.r = *(const LAS f4*)(vb + 4 * VECB + (t) * 256); dst.v = *(const LAS float*)(vv + (t) * 64); } while (0)
        SC_LOAD(in[0], 0);
#pragma unroll
        for (int t = 0; t < CH; ++t) {
          if (t + 1 < CH) SC_LOAD(in[(t + 1) & 1], t + 1);
          const In& x = in[t & 1];
          f2 p2 = s01 * (f2){x.kk[0], x.kk[1]}; p2 = s23 * (f2){x.kk[2], x.kk[3]} + p2;
          float sa = allreduce16(p2[0] + p2[1]);
          const f2 vv2 = {x.v, x.v};
          s01 = s01 * (f2){x.w[0], x.w[1]} + vv2 * (f2){x.kt[0], x.kt[1]};
          s23 = s23 * (f2){x.w[2], x.w[3]} + vv2 * (f2){x.kt[2], x.kt[3]};
          const f2 nsa = {-sa, -sa};
          s01 = nsa * (f2){x.kka[0], x.kka[1]} + s01;
          s23 = nsa * (f2){x.kka[2], x.kka[3]} + s23;
          f2 y2 = s01 * (f2){x.r[0], x.r[1]}; y2 = s23 * (f2){x.r[2], x.r[3]} + y2;
          const float yy = allreduce16(y2[0] + y2[1]);
          if (seg == 0) yp[(long)t * rstep] = yy;
        }
#undef SC_LOAD
        __builtin_amdgcn_s_barrier();
      }
    }
  }
  __syncthreads();
}
#endif


#ifndef CPU_EMU
namespace rt {
typedef short bf16x8 __attribute__((ext_vector_type(8)));
typedef float f32x4 __attribute__((ext_vector_type(4)));
typedef unsigned u32x4 __attribute__((ext_vector_type(4)));
typedef unsigned u32x2 __attribute__((ext_vector_type(2)));
constexpr int QS = 72, TS = 136;
__device__ __forceinline__ f32x4 mm(bf16x8 a, bf16x8 b, f32x4 c) { return __builtin_amdgcn_mfma_f32_16x16x32_bf16(a, b, c, 0, 0, 0); }
__device__ __forceinline__ float lg2_gamma(int hh) { return __builtin_amdgcn_logf(1.0f - __builtin_amdgcn_exp2f(-5.0f - (float)hh)); }
__device__ __forceinline__ unsigned pkbf(float a, float b) { unsigned r; asm volatile("v_cvt_pk_bf16_f32 %0, %1, %2" : "=v"(r) : "v"(a), "v"(b)); return r; }
}
__device__ __forceinline__ void phase_retA_mfma(const Params& p, LAS unsigned char* lds) {
  using namespace rt;
  const int tid = otid(), wid = tid >> 6, lane = tid & 63, fr = lane & 15, fq = lane >> 4;
  LAS bf16_t* Kf = (LAS bf16_t*)lds; LAS bf16_t* Kb = Kf + 64 * TS; LAS bf16_t* Vt = Kb + 64 * TS;
  for (int u = obid(); u < B_ * NH_ * NCH_; u += gridDim.x) {
    const int n = u % NCH_, hh = (u / NCH_) % NH_, b = u / (NCH_ * NH_);
    const int r0 = chunk_row0(b, n);
    const float lg2 = lg2_gamma(hh);
    __syncthreads();
    {
      const int tok = tid >> 2, part = tid & 3;
      const bf16_t* kp = p.rk + (size_t)(r0 + tok) * GWID_ + hh * HD_ + 16 * part; const bf16_t* vp = p.rv + (size_t)(r0 + tok) * GWID_ + hh * HD_ + 16 * part;
      const u32x4 k0 = *(const u32x4*)kp, k1 = *(const u32x4*)(kp + 8), v0 = *(const u32x4*)vp, v1 = *(const u32x4*)(vp + 8);
      const unsigned kw[8] = {k0.x, k0.y, k0.z, k0.w, k1.x, k1.y, k1.z, k1.w}, vw[8] = {v0.x, v0.y, v0.z, v0.w, v1.x, v1.y, v1.z, v1.w};
      const float zf = __builtin_amdgcn_exp2f((float)(RCH_ - 1 - tok) * lg2), zb = __builtin_amdgcn_exp2f((float)tok * lg2);
#pragma unroll
      for (int j = 0; j < 8; ++j) {
        const float ka = __uint_as_float(kw[j] << 16), kc = __uint_as_float(kw[j] & 0xFFFF0000u);
        const unsigned f = pkbf(ka * zf, kc * zf), g = pkbf(ka * zb, kc * zb);
        const int dd = 16 * part + 2 * j;
        Kf[dd * TS + tok] = (bf16_t)(f & 0xFFFFu); Kf[(dd + 1) * TS + tok] = (bf16_t)(f >> 16);
        Kb[dd * TS + tok] = (bf16_t)(g & 0xFFFFu); Kb[(dd + 1) * TS + tok] = (bf16_t)(g >> 16);
        Vt[dd * TS + tok] = (bf16_t)(vw[j] & 0xFFFFu); Vt[(dd + 1) * TS + tok] = (bf16_t)(vw[j] >> 16);
      }
    }
    __syncthreads();
    {
      const int d = wid >> 2, kt = wid & 3;
      const LAS bf16_t* Kd = d == 0 ? Kf : Kb;
      f32x4 acc[4];
#pragma unroll
      for (int vt = 0; vt < 4; ++vt) acc[vt] = (f32x4){0.f, 0.f, 0.f, 0.f};
#pragma unroll
      for (int ts = 0; ts < 4; ++ts) {
        const bf16x8 kfr = *(const LAS bf16x8*)(Kd + (16 * kt + fr) * TS + 32 * ts + 8 * fq);
#pragma unroll
        for (int vt = 0; vt < 4; ++vt) { const bf16x8 vfr = *(const LAS bf16x8*)(Vt + (16 * vt + fr) * TS + 32 * ts + 8 * fq); acc[vt] = mm(kfr, vfr, acc[vt]); }
      }
      float* o = p.rd + ((((size_t)b * NH_ + hh) * NCH_ + n) * 2 + d) * HD_ * HD_;
#pragma unroll
      for (int vt = 0; vt < 4; ++vt) *(f32x4*)(o + (16 * vt + fr) * HD_ + 16 * kt + 4 * fq) = acc[vt];
    }
  }
  __syncthreads();
}
__device__ __forceinline__ void phase_retB_mfma(const Params& p, int l, LAS unsigned char* lds) {
  using namespace rt;
  const int tid = otid(), wid = tid >> 6, lane = tid & 63, fr = lane & 15, fq = lane >> 4;
  const bool last = (l == DEPTH_ - 1);
  LAS bf16_t* Qs = (LAS bf16_t*)lds; LAS bf16_t* Ks = Qs + 128 * QS; LAS bf16_t* Vt = Ks + 128 * QS; LAS bf16_t* Rt = Vt + 64 * TS; LAS bf16_t* Ss = Rt + 2 * 64 * QS + wid * 16 * TS;
  const bf16_t* rs16 = (const bf16_t*)p.rs;
  for (int u = obid(); u < B_ * NH_ * NCH_; u += gridDim.x) {
    const int n = u % NCH_, hh = (u / NCH_) % NH_, b = u / (NCH_ * NH_);
    if (last && n < NCC_) continue;
    const int r0 = chunk_row0(b, n);
    const float lg2 = lg2_gamma(hh);
    __syncthreads();
    {
      const int tok = tid >> 2, part = tid & 3;
      const size_t go = (size_t)(r0 + tok) * GWID_ + hh * HD_ + 16 * part;
      const u32x4 q0 = *(const u32x4*)(p.rq + go), q1 = *(const u32x4*)(p.rq + go + 8), k0 = *(const u32x4*)(p.rk + go), k1 = *(const u32x4*)(p.rk + go + 8);
      const u32x4 v0 = *(const u32x4*)(p.rv + go), v1 = *(const u32x4*)(p.rv + go + 8);
      *(LAS u32x4*)(Qs + tok * QS + 16 * part) = q0; *(LAS u32x4*)(Qs + tok * QS + 16 * part + 8) = q1;
      *(LAS u32x4*)(Ks + tok * QS + 16 * part) = k0; *(LAS u32x4*)(Ks + tok * QS + 16 * part + 8) = k1;
      const unsigned vw[8] = {v0.x, v0.y, v0.z, v0.w, v1.x, v1.y, v1.z, v1.w};
#pragma unroll
      for (int j = 0; j < 8; ++j) { const int dd = 16 * part + 2 * j; Vt[dd * TS + tok] = (bf16_t)(vw[j] & 0xFFFFu); Vt[(dd + 1) * TS + tok] = (bf16_t)(vw[j] >> 16); }
      const int vi = tid >> 3, k0i = (tid & 7) * 8;
#pragma unroll
      for (int d = 0; d < 2; ++d) {
        const u32x4 rr = *(const u32x4*)(rs16 + ((((size_t)b * NH_ + hh) * NCH_ + n) * 2 + d) * HD_ * HD_ + vi * HD_ + k0i);
        *(LAS u32x4*)(Rt + d * 64 * QS + vi * QS + k0i) = rr;
      }
    }
    __syncthreads();
    const int i0 = 16 * wid, qpos = i0 + fr;
    bf16x8 qf[2];
#pragma unroll
    for (int kc = 0; kc < 2; ++kc) qf[kc] = *(const LAS bf16x8*)(Qs + (i0 + fr) * QS + 32 * kc + 8 * fq);
#pragma unroll
    for (int nt = 0; nt < 8; ++nt) {
      f32x4 sacc = (f32x4){0.f, 0.f, 0.f, 0.f};
#pragma unroll
      for (int kc = 0; kc < 2; ++kc) { const bf16x8 kf = *(const LAS bf16x8*)(Ks + (16 * nt + fr) * QS + 32 * kc + 8 * fq); sacc = mm(kf, qf[kc], sacc); }
      float sv[4];
#pragma unroll
      for (int t = 0; t < 4; ++t) { const int key = 16 * nt + 4 * fq + t; const int dist = qpos > key ? qpos - key : key - qpos; sv[t] = sacc[t] * __builtin_amdgcn_exp2f((float)dist * lg2); }
      u32x2 w; w.x = pkbf(sv[0], sv[1]); w.y = pkbf(sv[2], sv[3]);
      *(LAS u32x2*)(Ss + fr * TS + 16 * nt + 4 * fq) = w;
    }
    f32x4 yv[4], tf[4], tb[4];
#pragma unroll
    for (int vt = 0; vt < 4; ++vt) { yv[vt] = (f32x4){0.f, 0.f, 0.f, 0.f}; tf[vt] = yv[vt]; tb[vt] = yv[vt]; }
#pragma unroll
    for (int ks = 0; ks < 4; ++ks) {
      const bf16x8 sf = *(const LAS bf16x8*)(Ss + fr * TS + 32 * ks + 8 * fq);
#pragma unroll
      for (int vt = 0; vt < 4; ++vt) { const bf16x8 vf = *(const LAS bf16x8*)(Vt + (16 * vt + fr) * TS + 32 * ks + 8 * fq); yv[vt] = mm(vf, sf, yv[vt]); }
    }
#pragma unroll
    for (int kc = 0; kc < 2; ++kc)
#pragma unroll
      for (int vt = 0; vt < 4; ++vt) {
        const bf16x8 rf = *(const LAS bf16x8*)(Rt + (16 * vt + fr) * QS + 32 * kc + 8 * fq), rb = *(const LAS bf16x8*)(Rt + 64 * QS + (16 * vt + fr) * QS + 32 * kc + 8 * fq);
        tf[vt] = mm(rf, qf[kc], tf[vt]); tb[vt] = mm(rb, qf[kc], tb[vt]);
      }
    const float xf = __builtin_amdgcn_exp2f((float)(qpos + 1) * lg2), xb = __builtin_amdgcn_exp2f((float)(RCH_ - qpos) * lg2);
    float ss = 0.f;
#pragma unroll
    for (int vt = 0; vt < 4; ++vt)
#pragma unroll
      for (int t = 0; t < 4; ++t) { const float v = yv[vt][t] + xf * tf[vt][t] + xb * tb[vt][t]; yv[vt][t] = v; ss += v * v; }
    ss += __shfl_xor(ss, 16); ss += __shfl_xor(ss, 32);
    const float rstd = rsqrtf(ss * (1.0f / (float)HD_) + 1e-6f);
    const int row = r0 + qpos;
#pragma unroll
    for (int vt = 0; vt < 4; ++vt) {
      const int ch = hh * HD_ + 16 * vt + 4 * fq;
      const f32x4 g = *(const f32x4*)(p.g_ret_norm + (size_t)l * GWID_ + ch);
      const u32x2 rgw = *(const u32x2*)(p.rg + (size_t)row * GWID_ + ch);
      const float o0 = yv[vt][0] * rstd * g[0] * __uint_as_float(rgw.x << 16), o1 = yv[vt][1] * rstd * g[1] * __uint_as_float(rgw.x & 0xFFFF0000u);
      const float o2 = yv[vt][2] * rstd * g[2] * __uint_as_float(rgw.y << 16), o3 = yv[vt][3] * rstd * g[3] * __uint_as_float(rgw.y & 0xFFFF0000u);
      u32x2 w; w.x = pkbf(o0, o1); w.y = pkbf(o2, o3);
      *(u32x2*)(p.y + (size_t)row * D_ + 3 * GWID_ + ch) = w;
    }
  }
  __syncthreads();
}
#endif

template <bool WITH_RET> __device__ __forceinline__ void phase_post(const Params& p, int l) {
  float (*sm)[RCH_ + 2 * HD_] = (float (*)[RCH_ + 2 * HD_])SMEM_PTR();
  const int tid = otid(), wave = tid >> 6, lane = tid & 63;
  float* ws = sm[wave];
  const bool last = (l == DEPTH_ - 1);
  const int nrow = last ? NTOK_ : NROWS_;
  for (int row = obid() * NWAVE + wave; row < nrow; row += gridDim.x * NWAVE) {
    const int pos = row_pos(row), b = row_batch(row); const bool isx = row < NTOK_;
    {
      float t[GWID_ / 64]; float ss = 0.f;
#pragma unroll
      for (int i = 0; i < GWID_ / 64; ++i) { t[i] = p.ob[(size_t)row * GWID_ + i * 64 + lane]; ss += t[i] * t[i]; }
      ss = wave_sum(ss); const float rstd = rsqrtf(ss / (float)GWID_ + 1e-6f);
#pragma unroll
      for (int i = 0; i < GWID_ / 64; ++i) p.y[(size_t)row * D_ + GWID_ + i * 64 + lane] = f2bf(t[i] * rstd * p.g_out_mla[l * GWID_ + i * 64 + lane]);
    }
    {
#pragma unroll
      for (int i = 0; i < GWID_ / 64; ++i) {
        const int ch = i * 64 + lane; const size_t o = (size_t)row * GWID_ + ch;
        const float yv = p.ys[o] + p.ys[(size_t)NROWS_ * GWID_ + o];
        float s1 = yv;
        for (int m = 1; m < HD_ && m < 64; m <<= 1) s1 += __shfl_xor(s1, m);
        const float mean = s1 / (float)HD_;
        const float dv = yv - mean; float s2 = dv * dv;
        for (int m = 1; m < HD_ && m < 64; m <<= 1) s2 += __shfl_xor(s2, m);
        const float var = s2 / (float)HD_;
        float r = dv * rsqrtf(var + 64e-5f) * p.g_ln_x[l * GWID_ + ch];
        r += (p.sc_bonus[(size_t)row * NH_ + ch / HD_] + p.sc_bonus[(size_t)(NROWS_ + row) * NH_ + ch / HD_]) * p.sc_v[o];
        p.y[(size_t)row * D_ + 2 * GWID_ + ch] = f2bf(r * p.sc_gate[o]);
      }
    }
    if (WITH_RET) {
      const int n = isx ? NCC_ + pos / RCH_ : pos / RCH_, c = pos % RCH_;
      const int r0 = chunk_row0(b, n);
      for (int hh = 0; hh < NH_; ++hh) {
        const float lg = ret_lg(hh);
        for (int j = lane; j < RCH_; j += 64) {
          float sdot = 0.f;
          for (int e = 0; e < HD_; ++e) sdot += bf2f(p.rq[(size_t)row * GWID_ + hh * HD_ + e]) * bf2f(p.rk[(size_t)(r0 + j) * GWID_ + hh * HD_ + e]);
          const int dist = c > j ? c - j : j - c;
          ws[j] = sdot * expf((float)dist * lg);
        }
        for (int e = lane; e < HD_; e += 64) ws[RCH_ + e] = bf2f(p.rq[(size_t)row * GWID_ + hh * HD_ + e]);
        __builtin_amdgcn_wave_barrier();
        float yv = 0.f;
        const int vc = lane % HD_;
        for (int j = 0; j < RCH_; ++j) yv += ws[j] * bf2f(p.rv[(size_t)(r0 + j) * GWID_ + hh * HD_ + vc]);
        const float xf = expf((float)(c + 1) * lg), xb = expf((float)(RCH_ - c) * lg);
        const float* sf = p.rs + ((((size_t)b * NH_ + hh) * NCH_ + n) * 2 + 0) * HD_ * HD_;
        const float* sb = sf + HD_ * HD_;
        float cf = 0.f, cb = 0.f;
        for (int k = 0; k < HD_; ++k) { const float qk = ws[RCH_ + k]; cf += qk * sf[k * HD_ + vc]; cb += qk * sb[k * HD_ + vc]; }
        yv += xf * cf + xb * cb;
        float s2 = yv * yv;
        for (int m = 1; m < HD_ && m < 64; m <<= 1) s2 += __shfl_xor(s2, m);
        const float rstd = rsqrtf(s2 / (float)HD_ + 1e-6f);
        const int ch = hh * HD_ + vc;
#ifdef HAVE_PREPA
        const float sg = bf2f(p.rg[(size_t)row * GWID_ + ch]);
#else
        const float sg = siluf_(bf2f(p.z[(size_t)row * ZLD_ + RT0_ + 3 * GWID_ + ch]));
#endif
        if (lane < HD_) p.y[(size_t)row * D_ + 3 * GWID_ + ch] = f2bf(sg * yv * rstd * p.g_ret_norm[l * GWID_ + ch]);
        __builtin_amdgcn_wave_barrier();
      }
    }
  }
}

__device__ __forceinline__ void phase_topk(const Params& p, int l) {
  unsigned* vals = (unsigned*)SMEM_PTR();
  int* hist = (int*)(vals + (L_ > LC_ ? L_ : LC_));
  int* scan_gt = hist + 256; int* scan_eq = scan_gt + NT + 1;
  unsigned& s_prefix = *(unsigned*)(scan_eq + NT + 1); int& s_need = *(scan_eq + NT + 2);
  const int tid = otid();
  const bool last = (l == DEPTH_ - 1);
  const int nunits = (last ? B_ : 2 * B_) * NEXP_;
  for (int u = obid(); u < nunits; u += gridDim.x) {
    const int e = u % NEXP_, set = u / NEXP_; const bool isx = set < B_; const int b = isx ? set : set - B_;
    const int N = isx ? L_ : LC_, cap = isx ? CAP_ : CAPC_;
    const int row0 = isx ? b * L_ : NTOK_ + b * LC_;
    __syncthreads();
    for (int i = tid; i < N; i += NT) { union { float f; unsigned u; } x; x.f = p.aff[(size_t)(row0 + i) * NEXP_ + e]; vals[i] = x.u; }
    if (tid == 0) { s_prefix = 0u; s_need = cap; }
    __syncthreads();
    for (int pass = 0; pass < 4; ++pass) {
      const int shift = 24 - 8 * pass;
      for (int i = tid; i < 256; i += NT) hist[i] = 0;
      __syncthreads();
      const unsigned prefix = s_prefix; const unsigned himask = pass == 0 ? 0u : (0xFFFFFFFFu << (shift + 8));
      for (int i = tid; i < N; i += NT) { const unsigned v = vals[i]; if ((v & himask) == prefix) atomicAdd(&hist[(v >> shift) & 255], 1); }
      __syncthreads();
      if (tid == 0) {
        int need = s_need, bin = 255;
        for (; bin > 0; --bin) { if (hist[bin] >= need) break; need -= hist[bin]; }
        s_prefix = prefix | ((unsigned)bin << shift); s_need = need;
      }
      __syncthreads();
    }
    const unsigned T = s_prefix; const int need_eq = s_need;
    const int per = (N + NT - 1) / NT;
    int cg = 0, ce = 0;
    for (int j = 0; j < per; ++j) { const int i = tid * per + j; if (i < N) { const unsigned v = vals[i]; cg += v > T; ce += v == T; } }
    scan_gt[tid + 1] = cg; scan_eq[tid + 1] = ce;
    __syncthreads();
    if (tid == 0) { scan_gt[0] = 0; scan_eq[0] = 0; for (int i = 1; i <= NT; ++i) { scan_gt[i] += scan_gt[i - 1]; scan_eq[i] += scan_eq[i - 1]; } }
    __syncthreads();
    int rg = scan_gt[tid], re = scan_eq[tid];
    const int slot0 = isx ? (e * B_ + b) * CAP_ : XSLOTS_ + (e * B_ + b) * CAPC_;
    for (int j = 0; j < per; ++j) {
      const int i = tid * per + j; if (i >= N) break;
      const unsigned v = vals[i];
      int slot = -1;
      if (v > T) { slot = rg + (re < need_eq ? re : need_eq); ++rg; }
      else if (v == T) { if (re < need_eq) slot = rg + re; ++re; }
      if (slot >= 0) { union { float f; unsigned u; } x; x.u = v; p.sel_idx[slot0 + slot] = row0 + i; p.sel_gate[slot0 + slot] = x.f; }
      p.inv[(size_t)(row0 + i) * NEXP_ + e] = slot >= 0 ? slot0 + slot : -1;
    }
  }
}

#ifndef CPU_EMU
#define XB_SPIN_CAP (1u << 24)
#endif
__device__ __forceinline__ void grid_sync(const Params& p) { (void)p; }

template <int PH> __device__ __forceinline__ void run_phase(const Params& p, int l) {
  if (PH == PH_MOD) phase_mod(p);
  if (PH == PH_NORM1) phase_norm<0>(p, l);
  if (PH == PH_GEMM_IN) phase_gemm_in(p, l);
#ifdef HAVE_PREPA
  if (PH == PH_PREP) phase_prepA(p, l);
  if (PH == PH_RETD) phase_prepB_naive(p, l);
  if (PH == PH_PREPC) phase_prepC(p, l);
#else
  if (PH == PH_PREP) phase_prep(p, l);
#endif
  if (PH == PH_RETD) phase_retd(p, l);
  if (PH == PH_MIX) phase_mix<true, true>(p, l);
  if (PH == PH_POST) phase_post<true>(p, l);
  if (PH == PH_GEMM_OUT) phase_gemm_out(p, l);
  if (PH == PH_NORM2) phase_norm<1>(p, l);
  if (PH == PH_TOPK) phase_topk(p, l);
  if (PH == PH_MOE1) phase_moe1(p, l);
  if (PH == PH_MOE2) phase_moe2(p, l);
  if (PH == PH_FINAL) phase_norm<2>(p, l);
}
template <int PH> __global__ void __launch_bounds__(NT) k_phase(Params p, int l) { run_phase<PH>(p, l); }

#ifndef CPU_EMU
#define XB_TMO      128
#define XB_XCNT(j)  (256  + 64 * (j))
#define XB_XSUB(j)  (1280 + 64 * (j))
#define XB_XGEN(j)  (2304 + 64 * (j))
#define XB_TOP      3328
#define XB_TOPGEN   3392
#define XCD_BAR_WORDS 3456
#define XB_SPIN_CAP (1u << 23)
__device__ __forceinline__ unsigned xb_ld(unsigned* p)              { return __hip_atomic_load(p, __ATOMIC_RELAXED, __HIP_MEMORY_SCOPE_AGENT); }
__device__ __forceinline__ unsigned xb_add(unsigned* p, unsigned v) { return __hip_atomic_fetch_add(p, v, __ATOMIC_RELAXED, __HIP_MEMORY_SCOPE_AGENT); }
__device__ __forceinline__ unsigned xb_xcc_id() { return (unsigned)__builtin_amdgcn_s_getreg((3 << 11) | 20) & 0xFu; }
#define XB_SPIN(cond, bar) do { unsigned _sp = 0; while (cond) { __builtin_amdgcn_s_sleep(1); \
    if ((++_sp & 255u) == 0u) { if (xb_ld(&(bar)[XB_TMO])) break; if (_sp > XB_SPIN_CAP) { atomicAdd(&(bar)[XB_TMO], 1u); break; } } } } while (0)
struct XcdBarrier { unsigned* bar; unsigned x; volatile LAS unsigned* st; };
__device__ __forceinline__ XcdBarrier xcd_barrier_post(unsigned* bar, volatile LAS unsigned* st) {
    XcdBarrier b; b.bar = bar; b.x = xb_xcc_id(); b.st = st;
    if (threadIdx.x == 0) (void)xb_add(&bar[XB_XCNT(b.x)], 1u);
    return b;
}
__device__ __forceinline__ void xcd_barrier_complete(unsigned* bar, unsigned x, unsigned& nloc, unsigned& nx) {
    const unsigned G = gridDim.x * gridDim.y * gridDim.z;
    unsigned sum, cnt, mine, sp = 0u;
    for (;;) {
        sum = 0u; cnt = 0u; mine = 0u;
#pragma unroll
        for (unsigned j = 0; j < 16; ++j) { const unsigned c = xb_ld(&bar[XB_XCNT(j)]); sum += c; cnt += (c > 0u) ? 1u : 0u; mine = (j == x) ? c : mine; }
        if (sum == G) break;
        __builtin_amdgcn_s_sleep(1);
        if ((++sp & 255u) == 0u) { if (xb_ld(&bar[XB_TMO])) break; if (sp > XB_SPIN_CAP) { atomicAdd(&bar[XB_TMO], 1u); break; } }
    }
    nloc = mine > 0u ? mine : 1u; nx = cnt > 0u ? cnt : 1u;
}
__device__ __forceinline__ void xcd_barrier(const XcdBarrier& b) {
    asm volatile("s_waitcnt vmcnt(0)" ::: "memory");
    __syncthreads();
    if (threadIdx.x == 0) {
        unsigned* bar = b.bar; unsigned bx = b.x;
        asm volatile("" : "+s"(bx));
        __builtin_amdgcn_s_waitcnt(0);
        unsigned nloc = b.st[0], nx = b.st[1];
        if (nloc == 0u) { xcd_barrier_complete(bar, bx, nloc, nx); b.st[0] = nloc; b.st[1] = nx; }
        const unsigned old = xb_add(&bar[XB_XSUB(bx)], 1u);
        const unsigned gen = old / nloc;
        if (old + 1u == (gen + 1u) * nloc) {
            __builtin_amdgcn_fence(__ATOMIC_RELEASE, "agent");
            asm volatile("s_waitcnt vmcnt(0)" ::: "memory");
            const unsigned og = xb_add(&bar[XB_TOP], 1u);
            const unsigned tg = og / nx;
            if (og + 1u == (tg + 1u) * nx) xb_add(&bar[XB_TOPGEN], 1u);
            else XB_SPIN(xb_ld(&bar[XB_TOPGEN]) == tg, bar);
            __builtin_amdgcn_fence(__ATOMIC_ACQUIRE, "agent");
            xb_add(&bar[XB_XGEN(bx)], 1u);
            asm volatile("s_waitcnt vmcnt(0)" ::: "memory");
        } else {
            XB_SPIN(xb_ld(&bar[XB_XGEN(bx)]) == gen, bar);
            __builtin_amdgcn_fence(__ATOMIC_ACQUIRE, "agent");
            asm volatile("s_waitcnt vmcnt(0)" ::: "memory");
        }
    }
    __syncthreads();
}
typedef const Params __attribute__((address_space(4))) * KParamsPtr;
__device__ __forceinline__ const Params& kparams() { KParamsPtr kp = (KParamsPtr)__builtin_amdgcn_kernarg_segment_ptr(); asm volatile("" : "+s"(kp)); return *(const Params*)kp; }
#define KP kparams()
__global__ void __launch_bounds__(NT, 2) mega(Params p_unused) {
  (void)p_unused;
  LAS unsigned char* lds = (LAS unsigned char*)smem_dyn;
  if (threadIdx.x < 4) ((LAS unsigned*)(lds + XBW_OFF_))[threadIdx.x] = 0u;
  __syncthreads();
  XcdBarrier bar = xcd_barrier_post(KP.bar, (volatile LAS unsigned*)(lds + XBW_OFF_));
  phase_mod(KP);
  phase_cvt_static(KP);
  phase_cvt_small(KP);
  xcd_barrier(bar);
  for (int l = 0; l < DEPTH_; ++l) {
    phase_norm<0>(KP, l); xcd_barrier(bar);
    phase_gemm_in_mfma(KP, l, lds); xcd_barrier(bar);
    phase_prepA(KP, l); xcd_barrier(bar);
    phase_gemm_small_mfma(KP, l, lds); phase_retA_mfma(KP, lds); xcd_barrier(bar);
    phase_prepC(KP, l); xcd_barrier(bar);
    phase_mix<false, false, true>(KP, l); phase_attn(KP, l); phase_scan(KP, l, lds); xcd_barrier(bar);
    phase_post<false>(KP, l); phase_retB_mfma(KP, l, lds); xcd_barrier(bar);
    phase_gemm_out_mfma(KP, l, lds); xcd_barrier(bar);
    phase_norm<1>(KP, l); phase_cvt_moe(KP, l); xcd_barrier(bar);
    phase_topk(KP, l); xcd_barrier(bar);
    phase_moe1_mfma(KP, l, lds); xcd_barrier(bar);
    phase_moe2_mfma(KP, l, lds); xcd_barrier(bar);
  }
  phase_norm<2>(KP, DEPTH_ - 1);
}
#endif

#ifdef CPU_EMU
#define LAUNCH(PH, grid, p, l) emu_launch(dim3(grid), dim3(NT), LDS_BYTES_, [=]() { k_phase<PH>(p, l); })
#else
#define LAUNCH(PH, grid, p, l) hipLaunchKernelGGL(k_phase<PH>, dim3(grid), dim3(NT), LDS_BYTES_, stream, p, l)
#endif

static size_t align_up(size_t v) { return (v + 255) & ~(size_t)255; }

extern "C" void kernel_launch(void* const* d_in, const int* in_sizes, int n_in, void* d_out, int out_size, void* d_ws, size_t ws_size, hipStream_t stream) {
  (void)in_sizes; (void)n_in; (void)out_size; (void)ws_size;
  Params p;
  memset(&p, 0, sizeof(p));
  const float** ip = (const float**)&p.x;
  for (int i = 0; i < 34; ++i) ip[i] = (const float*)d_in[i];
  p.out = (float*)d_out;
  char* w = (char*)d_ws; size_t off = 0;
#define CARVE(field, type, count) do { p.field = (type*)(w + off); off = align_up(off + sizeof(type) * (size_t)(count)); } while (0)
  CARVE(bar, unsigned, 4096);
  CARVE(modv, float, (size_t)DEPTH_ * (B_ + 1) * 6 * D_);
  CARVE(xc, float, (size_t)NCTX_ * D_);
  CARVE(h, bf16_t, (size_t)NROWS_ * D_);
  CARVE(z, bf16_t, (size_t)NROWS_ * ZLD_);
  CARVE(y, bf16_t, (size_t)NROWS_ * D_);
  CARVE(qb, bf16_t, (size_t)NROWS_ * NH_ * QK_);
  CARVE(kb, bf16_t, (size_t)B_ * NH_ * LK_ * KLD_);
  CARVE(vb, bf16_t, (size_t)B_ * NH_ * LK_ * HD_);
  CARVE(sc_r, float, (size_t)NROWS_ * GWID_);
  CARVE(sc_v, float, (size_t)NROWS_ * GWID_);
  CARVE(sc_kk, float, (size_t)NROWS_ * GWID_);
  CARVE(sc_w, float, (size_t)2 * NROWS_ * GWID_);
  CARVE(sc_kka, float, (size_t)2 * NROWS_ * GWID_);
  CARVE(sc_kt, float, (size_t)2 * NROWS_ * GWID_);
  CARVE(sc_gate, float, (size_t)NROWS_ * GWID_);
  CARVE(sc_bonus, float, (size_t)2 * NROWS_ * NH_);
  CARVE(ys, float, (size_t)2 * NROWS_ * GWID_);
  CARVE(ob, float, (size_t)NROWS_ * GWID_);
  CARVE(rq, bf16_t, (size_t)NROWS_ * GWID_);
  CARVE(rk, bf16_t, (size_t)NROWS_ * GWID_);
  CARVE(rv, bf16_t, (size_t)NROWS_ * GWID_);
  CARVE(tab_mla, float, (size_t)L_ * ROPE_);
  CARVE(tab_ret, float, (size_t)L_ * HD_);
  CARVE(aff, float, (size_t)NROWS_ * NEXP_);
  CARVE(sel_idx, int, (size_t)XSLOTS_ + CSLOTS_);
  CARVE(sel_gate, float, (size_t)XSLOTS_ + CSLOTS_);
  CARVE(inv, int, (size_t)NROWS_ * NEXP_);
  CARVE(wb_in, bf16_t, (size_t)DEPTH_ * ZLD_ * D_);
  CARVE(wb_out, bf16_t, (size_t)DEPTH_ * D_ * D_);
  CARVE(kr2, float, (size_t)NROWS_);
  CARVE(bts, bf16_t, (size_t)DEPTH_ * ZS2W_ * AUXW_);
  CARVE(rg, bf16_t, (size_t)NROWS_ * GWID_);
  p.hid = (bf16_t*)p.z;
  p.ye = (bf16_t*)p.sc_w;
  p.zs2 = p.z;
  p.rd = (float*)p.h; p.rs = p.rd + (size_t)B_ * NH_ * NCH_ * 2 * HD_ * HD_;
  p.aux = (bf16_t*)p.ob;
  p.kbuf = (bf16_t*)p.ys; p.krp = p.kbuf + (size_t)NROWS_ * GWID_;
  p.wb_moe1 = (bf16_t*)p.ys;
  p.wb_moe2 = p.wb_moe1 + (size_t)NEXP_ * 2 * D_ * D_;
#undef CARVE
#ifndef CPU_EMU
  {
    static int grid = 0;
    if (!grid) {
      int dev = 0, cus = 0, per_cu = 0;
      hipGetDevice(&dev);
      hipDeviceGetAttribute(&cus, hipDeviceAttributeMultiprocessorCount, dev);
      hipFuncSetAttribute((const void*)mega, hipFuncAttributeMaxDynamicSharedMemorySize, LDS_BYTES_);
      hipOccupancyMaxActiveBlocksPerMultiprocessor(&per_cu, mega, NT, LDS_BYTES_);
      grid = cus * (per_cu < 1 ? per_cu : 1);
    }
    hipMemsetAsync(p.bar, 0, XCD_BAR_WORDS * sizeof(unsigned), stream);
    hipLaunchKernelGGL(mega, dim3(grid), dim3(NT), LDS_BYTES_, stream, p);
    return;
  }
#else
  const int grid = 256;
  LAUNCH(PH_MOD, grid, p, 0);
  for (int l = 0; l < DEPTH_; ++l) {
    LAUNCH(PH_NORM1, grid, p, l);
    LAUNCH(PH_GEMM_IN, grid, p, l);
    LAUNCH(PH_PREP, grid, p, l);
    LAUNCH(PH_RETD, grid, p, l);
    LAUNCH(PH_PREPC, grid, p, l);
    LAUNCH(PH_MIX, grid, p, l);
    LAUNCH(PH_POST, grid, p, l);
    LAUNCH(PH_GEMM_OUT, grid, p, l);
    LAUNCH(PH_NORM2, grid, p, l);
    LAUNCH(PH_TOPK, grid, p, l);
    LAUNCH(PH_MOE1, grid, p, l);
    LAUNCH(PH_MOE2, grid, p, l);
    if (l == DEPTH_ - 1) LAUNCH(PH_FINAL, grid, p, l);
  }
#endif
}
```

```cpp
#include <hip/hip_runtime.h>
#include <stdint.h>
#include <math.h>
#include <string.h>

#if defined(MED_CFG)
#define D_ 1024
#define B_ 1
#define L_ 128
#define DEPTH_ 2
#define LC_ 128
#define GRIDW_ 64
#define HD_ 64
#define KVR_ 128
#define DLORA_ 64
#define ALORA_ 64
#define GLORA_ 128
#define NEXP_ 2
#elif defined(SMALL_CFG)
#define D_ 256
#define B_ 2
#define L_ 256
#define DEPTH_ 2
#define LC_ 128
#define GRIDW_ 64
#define HD_ 32
#define KVR_ 32
#define DLORA_ 16
#define ALORA_ 16
#define GLORA_ 32
#define NEXP_ 4
#else
#define D_ 1024
#define B_ 8
#define L_ 4096
#define DEPTH_ 4
#define LC_ 256
#define GRIDW_ 64
#define HD_ 64
#define KVR_ 128
#define DLORA_ 64
#define ALORA_ 64
#define GLORA_ 128
#define NEXP_ 16
#endif
#define CAPF_ 2
#define AUXW_ 384
#define ZS2W_ 1792
#define GWID_ (D_ / 4)
#define NH_ (GWID_ / HD_)
#define ROPE_ (HD_ / 2)
#define QK_ (HD_ + ROPE_)
#define NTOK_ (B_ * L_)
#define NCTX_ (B_ * LC_)
#define NROWS_ (NTOK_ + NCTX_)
#define LK_ (LC_ + L_)
#define COLS_MLA_ (NH_ * QK_ + KVR_ + ROPE_)
#define COLS_RWKV_ (3 * GWID_ + DLORA_ + ALORA_ + GLORA_)
#define MLA0_ (3 * GWID_)
#define RW0_ (MLA0_ + COLS_MLA_)
#define RT0_ (RW0_ + COLS_RWKV_)
#define INCOLS_ (RT0_ + 4 * GWID_)
#define ZLD_ (((INCOLS_ + 255) / 256) * 256)
#define CAP_ (CAPF_ * L_ / NEXP_)
#define CAPC_ (CAPF_ * LC_ / NEXP_)
#define XSLOTS_ (B_ * NEXP_ * CAP_)
#define CSLOTS_ (B_ * NEXP_ * CAPC_)
#define RCH_ 128
#define NCC_ (LC_ / RCH_)
#define NCX_ (L_ / RCH_)
#define NCH_ (NCC_ + NCX_)
#define KLD_ (((QK_ + 63) / 64) * 64)
#define NT 512
#define NWAVE (NT / 64)

typedef unsigned short bf16_t;

__device__ __forceinline__ float bf2f(bf16_t v) { union { unsigned u; float f; } x; x.u = ((unsigned)v) << 16; return x.f; }
__device__ __forceinline__ bf16_t f2bf(float f) { union { unsigned u; float f; } x; x.f = f; unsigned u = x.u; u += 0x7FFFu + ((u >> 16) & 1u); return (bf16_t)(u >> 16); }
__device__ __forceinline__ float wave_sum(float v) { for (int m = 32; m >= 1; m >>= 1) v += __shfl_xor(v, m); return v; }
__device__ __forceinline__ float wave_max(float v) { for (int m = 32; m >= 1; m >>= 1) v = fmaxf(v, __shfl_xor(v, m)); return v; }
#ifdef CPU_EMU
__device__ __forceinline__ float sigmoidf_(float x) { return 1.0f / (1.0f + expf(-x)); }
__device__ __forceinline__ float siluf_(float x) { return x / (1.0f + expf(-x)); }
__device__ __forceinline__ float tanhf_(float x) { return tanhf(x); }
__device__ __forceinline__ float fexp_(float x) { return expf(x); }
__device__ __forceinline__ float softplus_neg_(float x) { return (-x > 20.f) ? -x : log1pf(expf(-x)); }
#else
__device__ __forceinline__ float fexp_(float x) { return __builtin_amdgcn_exp2f(x * 1.4426950408889634f); }
__device__ __forceinline__ float sigmoidf_(float x) { return __builtin_amdgcn_rcpf(1.0f + fexp_(-x)); }
__device__ __forceinline__ float siluf_(float x) { return x * __builtin_amdgcn_rcpf(1.0f + fexp_(-x)); }
__device__ __forceinline__ float tanhf_(float x) { const float e = fexp_(-2.0f * fabsf(x)); const float t = (1.0f - e) * __builtin_amdgcn_rcpf(1.0f + e); return x < 0.f ? -t : t; }
__device__ __forceinline__ float softplus_neg_(float x) { return (-x > 20.f) ? -x : __builtin_amdgcn_logf(1.0f + fexp_(-x)) * 0.6931471805599453f; }
#endif


#ifdef CPU_EMU
__device__ __forceinline__ int otid() { return threadIdx.x; }
__device__ __forceinline__ int obid() { return blockIdx.x; }
#else
__device__ __forceinline__ int otid() { int t = threadIdx.x; asm volatile("" : "+v"(t)); return t; }
__device__ __forceinline__ int obid() { int b = blockIdx.x; asm volatile("" : "+s"(b)); return b; }
#endif

#define LDS_BYTES_ (132 * 1024)
#define XBW_OFF_ (128 * 1024)
#ifdef CPU_EMU
#define SMEM_PTR() ((unsigned char*)emu_dynshm())
#else
extern __shared__ __attribute__((aligned(16))) unsigned char smem_dyn[];
#define SMEM_PTR() (smem_dyn)
#endif
struct Params {
  const float *x, *c, *ctx, *c_ctx, *w_ada, *b_ada, *g_norm1, *g_norm2, *w_in, *w_out, *conv_w, *g_out_conv, *g_kv_norm, *w_uk, *w_uv,
      *g_q_norm, *g_k_norm, *g_out_mla, *rwkv_mu, *rwkv_w0, *rwkv_w2, *rwkv_a0, *rwkv_a2, *rwkv_g2, *rwkv_k_k, *rwkv_k_a, *rwkv_r_k, *g_ln_x,
      *g_ret_norm, *w_router, *b_router, *w_gate, *w_up, *w_down;
  float* out;
  unsigned* bar;
  float* modv;
  float* xc;
  bf16_t* h;
  bf16_t* z;
  bf16_t* y;
  bf16_t* qb;
  bf16_t* kb;
  bf16_t* vb;
  float* ob;
  float* sc_r;
  float* sc_v;
  float* sc_kk;
  float* sc_w;
  float* sc_kka;
  float* sc_kt;
  float* sc_gate;
  float* sc_bonus;
  bf16_t* aux;
  bf16_t* kbuf;
  bf16_t* krp;
  float* kr2;
  bf16_t* bts;
  bf16_t* zs2;
  bf16_t* rg;
  float* ys;
  bf16_t* rq;
  bf16_t* rk;
  bf16_t* rv;
  float* rd;
  float* rs;
  float* tab_mla;
  float* tab_ret;
  float* aff;
  int* sel_idx;
  float* sel_gate;
  int* inv;
  bf16_t* hid;
  bf16_t* ye;
  bf16_t* wb_in;
  bf16_t* wb_out;
  bf16_t* wb_moe1;
  bf16_t* wb_moe2;
};

enum { PH_MOD = 0, PH_NORM1, PH_GEMM_IN, PH_PREP, PH_RETD, PH_PREPC, PH_MIX, PH_POST, PH_GEMM_OUT, PH_NORM2, PH_TOPK, PH_MOE1, PH_MOE2, PH_FINAL, PH_COUNT };

__device__ __forceinline__ int row_batch(int row) { return row < NTOK_ ? row / L_ : (row - NTOK_) / LC_; }
__device__ __forceinline__ int row_modidx(int row) { return row < NTOK_ ? row / L_ : B_; }
__device__ __forceinline__ int row_pos(int row) { return row < NTOK_ ? row % L_ : (row - NTOK_) % LC_; }
__device__ __forceinline__ int row_len(int row) { return row < NTOK_ ? L_ : LC_; }

__device__ __forceinline__ void phase_mod(const Params& p) {
  const int tid = otid();
#ifndef CPU_EMU
  {
    float* sv = (float*)SMEM_PTR();
    float* red = sv + (B_ + 1) * D_;
    for (int i = tid; i < (B_ + 1) * D_; i += NT) { const int r = i / D_, k = i % D_; sv[i] = siluf_(r < B_ ? p.c[r * D_ + k] : p.c_ctx[k]); }
    __syncthreads();
    const int kp = tid >> 7, c = tid & 127;
    for (int u = obid(); u < DEPTH_ * (6 * D_ / 128); u += gridDim.x) {
      const int l = u / (6 * D_ / 128), col = (u % (6 * D_ / 128)) * 128 + c;
      float acc[B_ + 1];
#pragma unroll
      for (int r = 0; r <= B_; ++r) acc[r] = 0.f;
      const float* w = p.w_ada + (size_t)l * D_ * 6 * D_ + (size_t)(kp * (D_ / 4)) * 6 * D_ + col;
#pragma unroll 8
      for (int k = 0; k < D_ / 4; ++k) {
        const float wv = w[(size_t)k * 6 * D_];
#pragma unroll
        for (int r = 0; r <= B_; ++r) acc[r] += sv[r * D_ + kp * (D_ / 4) + k] * wv;
      }
#pragma unroll
      for (int r = 0; r <= B_; ++r) red[(kp * (B_ + 1) + r) * 128 + c] = acc[r];
      __syncthreads();
      for (int i = tid; i < (B_ + 1) * 128; i += NT) { const int r = i >> 7, cc = i & 127, cl = (u % (6 * D_ / 128)) * 128 + cc;
        const float v = red[(0 * (B_ + 1) + r) * 128 + cc] + red[(1 * (B_ + 1) + r) * 128 + cc] + red[(2 * (B_ + 1) + r) * 128 + cc] + red[(3 * (B_ + 1) + r) * 128 + cc];
        p.modv[((size_t)l * (B_ + 1) + r) * 6 * D_ + cl] = v + p.b_ada[l * 6 * D_ + cl]; }
      __syncthreads();
    }
  }
#else
  for (int idx = obid() * NT + tid; idx < DEPTH_ * 6 * D_; idx += gridDim.x * NT) {
    const int l = idx / (6 * D_), col = idx % (6 * D_);
    float acc[B_ + 1];
#pragma unroll
    for (int r = 0; r <= B_; ++r) acc[r] = 0.f;
    const float* w = p.w_ada + (size_t)l * D_ * 6 * D_ + col;
    for (int k = 0; k < D_; ++k) {
      const float wv = w[(size_t)k * 6 * D_];
#pragma unroll
      for (int r = 0; r < B_; ++r) acc[r] += siluf_(p.c[r * D_ + k]) * wv;
      acc[B_] += siluf_(p.c_ctx[k]) * wv;
    }
    const float bb = p.b_ada[l * 6 * D_ + col];
#pragma unroll
    for (int r = 0; r <= B_; ++r) p.modv[((size_t)l * (B_ + 1) + r) * 6 * D_ + col] = acc[r] + bb;
  }
#endif
  const int NF = ROPE_ / 4;
  for (int idx = obid() * NT + tid; idx < L_ * NF; idx += gridDim.x * NT) {
    const int t = idx / NF, i = idx % NF;
    const float inv = powf(10000.0f, -(float)(2 * i) / (float)(ROPE_ / 2));
    const float ar = (float)(t / GRIDW_) * inv, ac = (float)(t % GRIDW_) * inv;
    float* o = p.tab_mla + (size_t)t * 4 * NF;
    o[0 * NF + i] = cosf(ar); o[1 * NF + i] = sinf(ar); o[2 * NF + i] = cosf(ac); o[3 * NF + i] = sinf(ac);
  }
  const int NR = HD_ / 2;
  for (int idx = obid() * NT + tid; idx < L_ * NR; idx += gridDim.x * NT) {
    const int t = idx / NR, i = idx % NR;
    const float theta = 1.0f / powf(10000.0f, (float)i / (float)(NR - 1));
    const float a = (float)t * theta;
    p.tab_ret[(size_t)t * 2 * NR + i] = cosf(a); p.tab_ret[(size_t)t * 2 * NR + NR + i] = sinf(a);
  }
}

struct F4_ { float x, y, z, w; };
struct U2n_ { unsigned x, y; };
#ifdef CPU_EMU
__device__ __forceinline__ int lane_bcast_i(int v, int src) { return __shfl(v, src); }
#else
__device__ __forceinline__ int lane_bcast_i(int v, int src) { return __builtin_amdgcn_readlane(v, src); }
#endif

#ifndef CPU_EMU
template <int CTRL> __device__ __forceinline__ float dpp_mov_f(float v) { return __builtin_bit_cast(float, __builtin_amdgcn_update_dpp(0, __builtin_bit_cast(int, v), CTRL, 0xF, 0xF, true)); }
__device__ __forceinline__ float reduce_scatter16(const float (&v)[16], int lane) {
  float w[8], u[4];
#pragma unroll
  for (int i = 0; i < 8; ++i) { auto r = __builtin_amdgcn_permlane32_swap(__float_as_uint(v[i]), __float_as_uint(v[i + 8]), false, false); w[i] = __uint_as_float(r[0]) + __uint_as_float(r[1]); }
#pragma unroll
  for (int i = 0; i < 4; ++i) { auto r = __builtin_amdgcn_permlane16_swap(__float_as_uint(w[i]), __float_as_uint(w[i + 4]), false, false); u[i] = __uint_as_float(r[0]) + __uint_as_float(r[1]); }
  const bool b3 = (lane & 8) != 0, b2 = (lane & 4) != 0;
  float t[2];
#pragma unroll
  for (int i = 0; i < 2; ++i) { const float keep = b3 ? u[i + 2] : u[i], send = b3 ? u[i] : u[i + 2]; t[i] = keep + dpp_mov_f<0x128>(send); }
  const float keep = b2 ? t[1] : t[0], send = b2 ? t[0] : t[1];
  float x = keep + dpp_mov_f<0x141>(send);
  x += dpp_mov_f<0xB1>(x); x += dpp_mov_f<0x4E>(x);
  return x;
}
#endif
template <int MODE> __device__ __forceinline__ void phase_norm(const Params& p, int l) {
  const int tid = otid(), wave = tid >> 6, lane = tid & 63;
  const bool last = (l == DEPTH_ - 1);
  constexpr int R = 2, NI = D_ / 256;
  const bool combine = (MODE == 0 && l > 0) || MODE == 2;
  const int lprev = (MODE == 2) ? l : l - 1;
  const int stride = gridDim.x * NWAVE;
#ifndef CPU_EMU
  float* wr_s = (float*)SMEM_PTR();
  if (MODE == 1) { const float* wsrc = p.w_router + (size_t)l * D_ * NEXP_; for (int i = tid; i < D_ * NEXP_ / 4; i += NT) { const F4_ w4 = ((const F4_*)wsrc)[i]; const int col = (i * 4) / NEXP_, e0 = (i * 4) % NEXP_;
      wr_s[(e0 + 0) * D_ + col] = w4.x; wr_s[(e0 + 1) * D_ + col] = w4.y; wr_s[(e0 + 2) * D_ + col] = w4.z; wr_s[(e0 + 3) * D_ + col] = w4.w; } __syncthreads(); }
#else
  const float* wr_s = p.w_router + (size_t)l * D_ * NEXP_;
#endif
  for (int rbase = obid() * NWAVE + wave; rbase < NROWS_; rbase += stride * R) {
    F4_ v[R][NI]; bool ok[R]; int rows[R]; float* xr[R]; int slotv[R];
#pragma unroll
    for (int k = 0; k < R; ++k) {
      const int row = rbase + k * stride; rows[k] = row;
      const bool isx = row < NTOK_;
      ok[k] = row < NROWS_ && !(MODE == 2 && !isx) && !(MODE == 1 && !isx && last);
      xr[k] = nullptr; slotv[k] = -1;
      if (ok[k]) {
        xr[k] = isx ? p.out + (size_t)row * D_ : p.xc + (size_t)(row - NTOK_) * D_;
        const float* src = xr[k];
        if (MODE == 0 && l == 0) src = isx ? p.x + (size_t)row * D_ : p.ctx + (size_t)(row - NTOK_) * D_;
#pragma unroll
        for (int i = 0; i < NI; ++i) v[k][i] = *(const F4_*)(src + (i * 64 + lane) * 4);
        if (combine) slotv[k] = p.inv[(size_t)row * NEXP_ + (lane % NEXP_)];
      }
    }
    if (combine) {
#ifndef CPU_EMU
      F4_ sacc[R][NI];
      unsigned long long hm[R];
#pragma unroll
      for (int k = 0; k < R; ++k) { hm[k] = ok[k] ? (__builtin_amdgcn_ballot_w64(slotv[k] >= 0) & 0xFFFFull) : 0ull;
#pragma unroll
        for (int i = 0; i < NI; ++i) { sacc[k][i].x = 0.f; sacc[k][i].y = 0.f; sacc[k][i].z = 0.f; sacc[k][i].w = 0.f; } }
      while ((hm[0] | hm[1]) != 0ull) {
        U2n_ t[R][3][NI];
#pragma unroll
        for (int k = 0; k < R; ++k)
#pragma unroll
          for (int j = 0; j < 3; ++j) {
            if (hm[k] != 0ull) {
              const int e = __builtin_ctzll(hm[k]); hm[k] &= hm[k] - 1ull;
              const int slot = __builtin_amdgcn_readlane(slotv[k], e);
              const bf16_t* yr = p.ye + (size_t)slot * D_ + lane * 4;
#pragma unroll
              for (int i = 0; i < NI; ++i) t[k][j][i] = *(const U2n_*)(yr + i * 256);
            } else {
#pragma unroll
              for (int i = 0; i < NI; ++i) { t[k][j][i].x = 0u; t[k][j][i].y = 0u; }
            }
          }
#pragma unroll
        for (int k = 0; k < R; ++k)
#pragma unroll
          for (int j = 0; j < 3; ++j)
#pragma unroll
            for (int i = 0; i < NI; ++i) { union { unsigned u; float f; } a, b2, c, d; a.u = t[k][j][i].x << 16; b2.u = t[k][j][i].x & 0xFFFF0000u; c.u = t[k][j][i].y << 16; d.u = t[k][j][i].y & 0xFFFF0000u;
              sacc[k][i].x += a.f; sacc[k][i].y += b2.f; sacc[k][i].z += c.f; sacc[k][i].w += d.f; }
      }
#pragma unroll
      for (int k = 0; k < R; ++k) if (ok[k]) {
        const int mi = row_modidx(rows[k]);
        const float* ga2 = p.modv + ((size_t)lprev * (B_ + 1) + mi) * 6 * D_ + 5 * D_;
#pragma unroll
        for (int i = 0; i < NI; ++i) { const F4_ g = *(const F4_*)(ga2 + (i * 64 + lane) * 4);
          v[k][i].x += g.x * sacc[k][i].x; v[k][i].y += g.y * sacc[k][i].y; v[k][i].z += g.z * sacc[k][i].z; v[k][i].w += g.w * sacc[k][i].w; }
      }
#else
#pragma unroll
      for (int k = 0; k < R; ++k) if (ok[k]) {
        F4_ s[NI];
#pragma unroll
        for (int i = 0; i < NI; ++i) { s[i].x = 0.f; s[i].y = 0.f; s[i].z = 0.f; s[i].w = 0.f; }
        for (int e = 0; e < NEXP_; ++e) {
          const int slot = lane_bcast_i(slotv[k], e);
          if (slot >= 0) {
            const bf16_t* yr = p.ye + (size_t)slot * D_ + lane * 4;
            U2n_ t[NI];
#pragma unroll
            for (int i = 0; i < NI; ++i) t[i] = *(const U2n_*)(yr + i * 256);
#pragma unroll
            for (int i = 0; i < NI; ++i) { union { unsigned u; float f; } a, b2, c, d; a.u = t[i].x << 16; b2.u = t[i].x & 0xFFFF0000u; c.u = t[i].y << 16; d.u = t[i].y & 0xFFFF0000u;
              s[i].x += a.f; s[i].y += b2.f; s[i].z += c.f; s[i].w += d.f; }
          }
        }
        const int mi = row_modidx(rows[k]);
        const float* ga2 = p.modv + ((size_t)lprev * (B_ + 1) + mi) * 6 * D_ + 5 * D_;
#pragma unroll
        for (int i = 0; i < NI; ++i) { const F4_ g = *(const F4_*)(ga2 + (i * 64 + lane) * 4);
          v[k][i].x += g.x * s[i].x; v[k][i].y += g.y * s[i].y; v[k][i].z += g.z * s[i].z; v[k][i].w += g.w * s[i].w; }
      }
#endif
    }
    if (combine || (MODE == 0 && l == 0)) {
#pragma unroll
      for (int k = 0; k < R; ++k) if (ok[k]) {
#pragma unroll
        for (int i = 0; i < NI; ++i) *(F4_*)(xr[k] + (i * 64 + lane) * 4) = v[k][i];
      }
    }
    if (MODE == 2) continue;
#pragma unroll
    for (int k = 0; k < R; ++k) {
      if (!ok[k]) continue;
      const int row = rows[k];
      float ss = 0.f;
#pragma unroll
      for (int i = 0; i < NI; ++i) ss += v[k][i].x * v[k][i].x + v[k][i].y * v[k][i].y + v[k][i].z * v[k][i].z + v[k][i].w * v[k][i].w;
      ss = wave_sum(ss);
      const float rstd = rsqrtf(ss / (float)D_ + 1e-6f);
      const int mi = row_modidx(row);
      const float* g = (MODE == 0 ? p.g_norm1 : p.g_norm2) + (size_t)l * D_;
      const float* mv = p.modv + ((size_t)l * (B_ + 1) + mi) * 6 * D_ + (MODE == 0 ? 0 : 3 * D_);
      float lg[NEXP_];
#pragma unroll
      for (int e = 0; e < NEXP_; ++e) lg[e] = 0.f;
#pragma unroll
      for (int i = 0; i < NI; ++i) {
        const int col = (i * 64 + lane) * 4;
        const F4_ gg = *(const F4_*)(g + col), sh = *(const F4_*)(mv + col), sc = *(const F4_*)(mv + D_ + col);
        float hv[4];
        hv[0] = v[k][i].x * rstd * gg.x * (1.0f + sc.x) + sh.x; hv[1] = v[k][i].y * rstd * gg.y * (1.0f + sc.y) + sh.y;
        hv[2] = v[k][i].z * rstd * gg.z * (1.0f + sc.z) + sh.z; hv[3] = v[k][i].w * rstd * gg.w * (1.0f + sc.w) + sh.w;
        U2n_ o; o.x = (unsigned)f2bf(hv[0]) | ((unsigned)f2bf(hv[1]) << 16); o.y = (unsigned)f2bf(hv[2]) | ((unsigned)f2bf(hv[3]) << 16);
        *(U2n_*)(p.h + (size_t)row * D_ + col) = o;
        if (MODE == 1) {
#ifndef CPU_EMU
#pragma unroll
          for (int e = 0; e < NEXP_; ++e) { const F4_ w4 = *(const F4_*)(wr_s + (size_t)e * D_ + col); lg[e] += (hv[0] * w4.x + hv[1] * w4.y) + (hv[2] * w4.z + hv[3] * w4.w); }
#else
#pragma unroll
          for (int j = 0; j < 4; ++j)
#pragma unroll
            for (int e = 0; e < NEXP_; ++e) lg[e] += hv[j] * wr_s[(size_t)(col + j) * NEXP_ + e];
#endif
        }
      }
      if (MODE == 1) {
#if !defined(CPU_EMU) && NEXP_ == 16
        const int eid = ((lane >> 5) & 1) * 8 + ((lane >> 4) & 1) * 4 + ((lane >> 3) & 1) * 2 + ((lane >> 2) & 1);
        const float lgt = reduce_scatter16(lg, lane) + p.b_router[l * NEXP_ + eid];
        float mx = lgt;
        { auto r = __builtin_amdgcn_permlane32_swap(__float_as_uint(mx), __float_as_uint(mx), false, false); mx = fmaxf(__uint_as_float(r[0]), __uint_as_float(r[1])); }
        { auto r = __builtin_amdgcn_permlane16_swap(__float_as_uint(mx), __float_as_uint(mx), false, false); mx = fmaxf(__uint_as_float(r[0]), __uint_as_float(r[1])); }
        mx = fmaxf(mx, dpp_mov_f<0x128>(mx)); mx = fmaxf(mx, dpp_mov_f<0x141>(mx));
        const float ex = fexp_(lgt - mx);
        float sm = ex;
        { auto r = __builtin_amdgcn_permlane32_swap(__float_as_uint(sm), __float_as_uint(sm), false, false); sm = __uint_as_float(r[0]) + __uint_as_float(r[1]); }
        { auto r = __builtin_amdgcn_permlane16_swap(__float_as_uint(sm), __float_as_uint(sm), false, false); sm = __uint_as_float(r[0]) + __uint_as_float(r[1]); }
        sm += dpp_mov_f<0x128>(sm); sm += dpp_mov_f<0x141>(sm);
        if ((lane & 3) == 0) p.aff[(size_t)row * NEXP_ + eid] = ex / sm;
#else
        float mx = -1e30f;
#pragma unroll
        for (int e = 0; e < NEXP_; ++e) { lg[e] = wave_sum(lg[e]) + p.b_router[l * NEXP_ + e]; mx = fmaxf(mx, lg[e]); }
        float sum = 0.f;
#pragma unroll
        for (int e = 0; e < NEXP_; ++e) { lg[e] = expf(lg[e] - mx); sum += lg[e]; }
        const float is = 1.0f / sum;
        if (lane == 0) {
#pragma unroll
          for (int e = 0; e < NEXP_; ++e) p.aff[(size_t)row * NEXP_ + e] = lg[e] * is;
        }
#endif
      }
    }
  }
#ifndef CPU_EMU
  if (MODE == 1) __syncthreads();
#endif
}


#if !defined(CPU_EMU) && NEXP_ == 16
struct RawN2 { F4_ x[4], sh[4], sc[4]; };
__device__ __forceinline__ void norm2_load(const Params& p, int l, int row, int lane, RawN2& r) {
  const float* src = row < NTOK_ ? p.out + (size_t)row * D_ : p.xc + (size_t)(row - NTOK_) * D_;
  const float* mv = p.modv + ((size_t)l * (B_ + 1) + row_modidx(row)) * 6 * D_ + 3 * D_;
#pragma unroll
  for (int i = 0; i < 4; ++i) { const int col = (i * 64 + lane) * 4; r.x[i] = *(const F4_*)(src + col); r.sh[i] = *(const F4_*)(mv + col); r.sc[i] = *(const F4_*)(mv + D_ + col); }
}
__device__ __forceinline__ void phase_norm2_pf(const Params& p, int l) {
  const int tid = otid(), wave = tid >> 6, lane = tid & 63;
  const bool last = (l == DEPTH_ - 1);
  const int stride = gridDim.x * NWAVE;
  float* wr_s = (float*)SMEM_PTR();
  { const float* wsrc = p.w_router + (size_t)l * D_ * NEXP_;
    for (int i = tid; i < D_ * NEXP_ / 4; i += NT) { const F4_ w4 = ((const F4_*)wsrc)[i]; const int col = (i * 4) / NEXP_, e0 = (i * 4) % NEXP_;
      wr_s[(e0 + 0) * D_ + col] = w4.x; wr_s[(e0 + 1) * D_ + col] = w4.y; wr_s[(e0 + 2) * D_ + col] = w4.z; wr_s[(e0 + 3) * D_ + col] = w4.w; }
    __syncthreads(); }
  const int nrows = last ? NTOK_ : NROWS_;
  int it = obid() * NWAVE + wave;
  if (it < nrows) {
    F4_ gg[4];
#pragma unroll
    for (int i = 0; i < 4; ++i) gg[i] = *(const F4_*)(p.g_norm2 + (size_t)l * D_ + (i * 64 + lane) * 4);
    const int eid = ((lane >> 5) & 1) * 8 + ((lane >> 4) & 1) * 4 + ((lane >> 3) & 1) * 2 + ((lane >> 2) & 1);
    const float brt = p.b_router[l * NEXP_ + eid];
    RawN2 cur; norm2_load(p, l, nrows - 1 - it, lane, cur);
    for (; it < nrows; it += stride) {
      const int row = nrows - 1 - it;
      RawN2 nxt; const bool has = it + stride < nrows;
      norm2_load(p, l, has ? row - stride : row, lane, nxt);
      float ss = 0.f;
#pragma unroll
      for (int i = 0; i < 4; ++i) ss += cur.x[i].x * cur.x[i].x + cur.x[i].y * cur.x[i].y + cur.x[i].z * cur.x[i].z + cur.x[i].w * cur.x[i].w;
      ss = wave_sum(ss);
      const float rstd = rsqrtf(ss / (float)D_ + 1e-6f);
      float lg[NEXP_];
#pragma unroll
      for (int e = 0; e < NEXP_; ++e) lg[e] = 0.f;
#pragma unroll
      for (int i = 0; i < 4; ++i) {
        const int col = (i * 64 + lane) * 4;
        float hv[4];
        hv[0] = cur.x[i].x * rstd * gg[i].x * (1.0f + cur.sc[i].x) + cur.sh[i].x; hv[1] = cur.x[i].y * rstd * gg[i].y * (1.0f + cur.sc[i].y) + cur.sh[i].y;
        hv[2] = cur.x[i].z * rstd * gg[i].z * (1.0f + cur.sc[i].z) + cur.sh[i].z; hv[3] = cur.x[i].w * rstd * gg[i].w * (1.0f + cur.sc[i].w) + cur.sh[i].w;
        U2n_ o; o.x = (unsigned)f2bf(hv[0]) | ((unsigned)f2bf(hv[1]) << 16); o.y = (unsigned)f2bf(hv[2]) | ((unsigned)f2bf(hv[3]) << 16);
        *(U2n_*)(p.h + (size_t)row * D_ + col) = o;
#pragma unroll
        for (int eg = 0; eg < NEXP_; eg += 4) {
          const F4_ w0 = *(const F4_*)(wr_s + (size_t)(eg + 0) * D_ + col), w1 = *(const F4_*)(wr_s + (size_t)(eg + 1) * D_ + col), w2 = *(const F4_*)(wr_s + (size_t)(eg + 2) * D_ + col), w3 = *(const F4_*)(wr_s + (size_t)(eg + 3) * D_ + col);
          lg[eg + 0] += (hv[0] * w0.x + hv[1] * w0.y) + (hv[2] * w0.z + hv[3] * w0.w); lg[eg + 1] += (hv[0] * w1.x + hv[1] * w1.y) + (hv[2] * w1.z + hv[3] * w1.w);
          lg[eg + 2] += (hv[0] * w2.x + hv[1] * w2.y) + (hv[2] * w2.z + hv[3] * w2.w); lg[eg + 3] += (hv[0] * w3.x + hv[1] * w3.y) + (hv[2] * w3.z + hv[3] * w3.w);
          __builtin_amdgcn_sched_barrier(0);
        }
      }
      const float lgt = reduce_scatter16(lg, lane) + brt;
      float mx = lgt;
      { auto r = __builtin_amdgcn_permlane32_swap(__float_as_uint(mx), __float_as_uint(mx), false, false); mx = fmaxf(__uint_as_float(r[0]), __uint_as_float(r[1])); }
      { auto r = __builtin_amdgcn_permlane16_swap(__float_as_uint(mx), __float_as_uint(mx), false, false); mx = fmaxf(__uint_as_float(r[0]), __uint_as_float(r[1])); }
      mx = fmaxf(mx, dpp_mov_f<0x128>(mx)); mx = fmaxf(mx, dpp_mov_f<0x141>(mx));
      const float ex = fexp_(lgt - mx);
      float sm = ex;
      { auto r = __builtin_amdgcn_permlane32_swap(__float_as_uint(sm), __float_as_uint(sm), false, false); sm = __uint_as_float(r[0]) + __uint_as_float(r[1]); }
      { auto r = __builtin_amdgcn_permlane16_swap(__float_as_uint(sm), __float_as_uint(sm), false, false); sm = __uint_as_float(r[0]) + __uint_as_float(r[1]); }
      sm += dpp_mov_f<0x128>(sm); sm += dpp_mov_f<0x141>(sm);
      if ((lane & 3) == 0) p.aff[(size_t)row * NEXP_ + eid] = ex / sm;
      cur = nxt;
    }
  }
  __syncthreads();
}
#endif

struct GemmDesc { const bf16_t* A; int lda; const int* amap; const float* W; const float* W2; int ldw; int M, N, K; };
template <bool DUAL, class Epi> __device__ __forceinline__ void gemm_tile_f32(const GemmDesc& g, int tm, int tn, const Epi& epi) {
  float (*As)[132] = (float (*)[132])SMEM_PTR();
  float (*Bs)[64] = (float (*)[64])(SMEM_PTR() + 16 * 132 * 4);
  float (*Bs2)[64] = (float (*)[64])(SMEM_PTR() + 16 * 132 * 4 + 16 * 64 * 4);
  const int tid = otid(), ty = tid >> 4, tx = tid & 15;
  float acc[4][4], acc2[4][4];
#pragma unroll
  for (int i = 0; i < 4; ++i)
#pragma unroll
    for (int j = 0; j < 4; ++j) { acc[i][j] = 0.f; acc2[i][j] = 0.f; }
  const int ar = tid >> 2, ak = (tid & 3) * 4;
  int arow = tm * 128 + ar; if (arow >= g.M) arow = g.M - 1;
  const size_t asrc = (size_t)(g.amap ? g.amap[arow] : arow) * g.lda;
  const int bk = tid >> 5, bn = (tid & 31) * 2;
  for (int k0 = 0; k0 < g.K; k0 += 16) {
    __syncthreads();
#pragma unroll
    for (int j = 0; j < 4; ++j) As[ak + j][ar] = bf2f(g.A[asrc + k0 + ak + j]);
#pragma unroll
    for (int j = 0; j < 2; ++j) {
      const int n = tn * 64 + bn + j;
      Bs[bk][bn + j] = n < g.N ? g.W[(size_t)(k0 + bk) * g.ldw + n] : 0.f;
      if (DUAL) Bs2[bk][bn + j] = n < g.N ? g.W2[(size_t)(k0 + bk) * g.ldw + n] : 0.f;
    }
    __syncthreads();
#pragma unroll
    for (int kk = 0; kk < 16; ++kk) {
      float a[4], b[4], b2[4];
#pragma unroll
      for (int i = 0; i < 4; ++i) a[i] = As[kk][ty * 4 + i];
#pragma unroll
      for (int j = 0; j < 4; ++j) { b[j] = Bs[kk][tx * 4 + j]; if (DUAL) b2[j] = Bs2[kk][tx * 4 + j]; }
#pragma unroll
      for (int i = 0; i < 4; ++i)
#pragma unroll
        for (int j = 0; j < 4; ++j) { acc[i][j] += a[i] * b[j]; if (DUAL) acc2[i][j] += a[i] * b2[j]; }
    }
  }
#pragma unroll
  for (int i = 0; i < 4; ++i) {
    const int m = tm * 128 + ty * 4 + i;
    if (m >= g.M) continue;
#pragma unroll
    for (int j = 0; j < 4; ++j) { const int n = tn * 64 + tx * 4 + j; if (n < g.N) epi(m, n, acc[i][j], acc2[i][j]); }
  }
}

struct EpiZ { bf16_t* z; __device__ void operator()(int m, int n, float a, float) const { z[(size_t)m * ZLD_ + n] = f2bf(a); } };
struct EpiOut { const float* modv; float* out; float* xc; int l; __device__ void operator()(int m, int n, float a, float) const {
    const int mi = row_modidx(m); const float ga1 = modv[((size_t)l * (B_ + 1) + mi) * 6 * D_ + 2 * D_ + n];
    float* xr = m < NTOK_ ? out + (size_t)m * D_ : xc + (size_t)(m - NTOK_) * D_; xr[n] += ga1 * a; } };
struct EpiHid { bf16_t* hid; int row0; __device__ void operator()(int m, int n, float a, float b) const { hid[(size_t)(row0 + m) * D_ + n] = f2bf(siluf_(a) * b); } };
struct EpiYe { bf16_t* ye; const float* gate; int row0; __device__ void operator()(int m, int n, float a, float) const { ye[(size_t)(row0 + m) * D_ + n] = f2bf(a * gate[row0 + m]); } };

__device__ __forceinline__ void phase_gemm_in(const Params& p, int l) {
  GemmDesc g; g.A = p.h; g.lda = D_; g.amap = nullptr; g.W = p.w_in + (size_t)l * D_ * INCOLS_; g.W2 = nullptr; g.ldw = INCOLS_; g.M = NROWS_; g.N = INCOLS_; g.K = D_;
  EpiZ epi{p.z};
  const int ntm = (NROWS_ + 127) / 128, ntn = (INCOLS_ + 63) / 64;
  for (int u = obid(); u < ntm * ntn; u += gridDim.x) gemm_tile_f32<false>(g, u / ntn, u % ntn, epi);
}
__device__ __forceinline__ void phase_gemm_out(const Params& p, int l) {
  const bool last = (l == DEPTH_ - 1);
  GemmDesc g; g.A = p.y; g.lda = D_; g.amap = nullptr; g.W = p.w_out + (size_t)l * D_ * D_; g.W2 = nullptr; g.ldw = D_; g.M = last ? NTOK_ : NROWS_; g.N = D_; g.K = D_;
  EpiOut epi{p.modv, p.out, p.xc, l};
  const int ntm = (g.M + 127) / 128, ntn = D_ / 64;
  for (int u = obid(); u < ntm * ntn; u += gridDim.x) gemm_tile_f32<false>(g, u / ntn, u % ntn, epi);
}
__device__ __forceinline__ int slot_expert(int slotrow) { return slotrow < XSLOTS_ ? slotrow / (B_ * CAP_) : (slotrow - XSLOTS_) / (B_ * CAPC_); }
__device__ __forceinline__ void phase_moe1(const Params& p, int l) {
  const bool last = (l == DEPTH_ - 1);
  const int M = last ? XSLOTS_ : XSLOTS_ + CSLOTS_;
  const int ntm = M / 128, ntn = D_ / 64;
  for (int u = obid(); u < ntm * ntn; u += gridDim.x) {
    const int tm = u / ntn, tn = u % ntn, e = slot_expert(tm * 128);
    GemmDesc g; g.A = p.h; g.lda = D_; g.amap = p.sel_idx + tm * 128; g.W = p.w_gate + ((size_t)l * NEXP_ + e) * D_ * D_; g.W2 = p.w_up + ((size_t)l * NEXP_ + e) * D_ * D_;
    g.ldw = D_; g.M = 128; g.N = D_; g.K = D_;
    EpiHid epi{p.hid, tm * 128};
    gemm_tile_f32<true>(g, 0, tn, epi);
  }
}
__device__ __forceinline__ void phase_moe2(const Params& p, int l) {
  const bool last = (l == DEPTH_ - 1);
  const int M = last ? XSLOTS_ : XSLOTS_ + CSLOTS_;
  const int ntm = M / 128, ntn = D_ / 64;
  for (int u = obid(); u < ntm * ntn; u += gridDim.x) {
    const int tm = u / ntn, tn = u % ntn, e = slot_expert(tm * 128);
    GemmDesc g; g.A = p.hid + (size_t)tm * 128 * D_; g.lda = D_; g.amap = nullptr; g.W = p.w_down + ((size_t)l * NEXP_ + e) * D_ * D_; g.W2 = nullptr;
    g.ldw = D_; g.M = 128; g.N = D_; g.K = D_;
    EpiYe epi{p.ye, p.sel_gate, tm * 128};
    gemm_tile_f32<false>(g, 0, tn, epi);
  }
}


#ifndef CPU_EMU
#define LAS __attribute__((address_space(3)))
namespace pg8 {
typedef short bf16x8 __attribute__((ext_vector_type(8)));
typedef float f32x4 __attribute__((ext_vector_type(4)));
typedef unsigned u32x4 __attribute__((ext_vector_type(4)));
constexpr int BM = 256, BK = 64, HALF = 128, HTB = HALF * BK * 2, STAGE_BYTES = 8 * HTB, NXCD = 8, WGM = 8;
__device__ __forceinline__ int lds_byte(int r, int c) { const int st = (r >> 4) * 2 + (c >> 5), rr = r & 15, cc = c & 31, ob = rr * 64 + cc * 2; return st * 1024 + (ob ^ (((ob >> 9) & 1) << 5)); }
__device__ __forceinline__ void stage_rc(int b, int& R, int& C) { const int st = b / 1024, sb = b % 1024, swz = sb ^ (((sb >> 9) & 1) << 5); R = (st >> 1) * 16 + swz / 64; C = (st & 1) * 32 + (swz % 64) / 2; }
__device__ __forceinline__ int perm32(int rho) { const int n = rho >> 4, i = rho & 15; return 8 * (i >> 2) + 4 * n + (i & 3); }
struct Unit { int pm, pn; };
__device__ __forceinline__ bool static_order(int i, int nM, int nN, int G, int c, Unit& u) {
    const int nwg = nM * nN; const long L = (long)i * G + c; if (L >= nwg) return false;
    int wgid = (int)L; { const int q = nwg / NXCD, r = nwg % NXCD, xcd = wgid % NXCD, off = wgid / NXCD; wgid = (xcd < r ? xcd * (q + 1) : r * (q + 1) + (xcd - r) * q) + off; }
    const int nig = WGM * nN, gid = wgid / nig, fm = gid * WGM, gsz = (nM - fm) < WGM ? (nM - fm) : WGM;
    u.pm = fm + ((wgid % nig) % gsz); u.pn = (wgid % nig) / gsz; return true;
}
__device__ __forceinline__ unsigned cvt_pk_bf16(float lo, float hi) { unsigned r; asm volatile("v_cvt_pk_bf16_f32 %0, %1, %2" : "=v"(r) : "v"(lo), "v"(hi)); return r; }

template <class P> __device__ __forceinline__ void gemm_phase(LAS unsigned char* lds, const P& prob) {
    const int tid = otid(), wid = __builtin_amdgcn_readfirstlane(tid >> 6), lane = tid & 63, wr = wid >> 2, wc = wid & 3, fr = lane & 15, fq = lane >> 4;
    constexpr int K = P::KDIM, nt = K / BK;
    unsigned voffB[2]; int sR[2], sC[2];
#pragma unroll
    for (int i = 0; i < 2; ++i) { int R, C; stage_rc(tid * 16 + i * 8192, R, C); sR[i] = R; sC[i] = C; const int Rb = P::PERM ? ((R & ~31) + perm32(R & 31)) : R; voffB[i] = (unsigned)(Rb * K + C) * 2u; }
    constexpr size_t kstep = (size_t)(BK * 2);
    constexpr size_t hstep = (size_t)HALF * K * 2;
    const unsigned ldsw = (unsigned)wid * 1024u;
    const int aoff = lds_byte(wr * 64 + fr, fq * 8), boff = lds_byte(wc * 32 + fr, fq * 8);
#define PG8_SA(b, h) (((b) * 2 + (h)) * HTB)
#define PG8_SB(b, h) ((4 + (b) * 2 + (h)) * HTB)
#define PG8_STAGE(bufoff, gbase, voff) do { _Pragma("unroll") for (int _i = 0; _i < 2; ++_i) \
        __builtin_amdgcn_global_load_lds((const unsigned*)((const char*)(gbase) + (voff)[_i]), (LAS unsigned*)(lds + (bufoff) + ldsw + _i * 8192), 16, 0, 0); } while (0)
#define PG8_LDA(dst, b, h) do { _Pragma("unroll") for (int m = 0; m < 4; ++m) _Pragma("unroll") for (int k = 0; k < 2; ++k) dst[m][k] = *(const LAS bf16x8*)(lds + PG8_SA(b, h) + aoff + m * 2048 + k * 1024); } while (0)
#define PG8_LDB(dst, b, h) do { _Pragma("unroll") for (int n = 0; n < 2; ++n) _Pragma("unroll") for (int k = 0; k < 2; ++k) dst[n][k] = *(const LAS bf16x8*)(lds + PG8_SB(b, h) + boff + n * 2048 + k * 1024); } while (0)
#define PG8_MMA(ai, bj, At, Bt) do { __builtin_amdgcn_s_setprio(1); _Pragma("unroll") for (int m = 0; m < 4; ++m) _Pragma("unroll") for (int n = 0; n < 2; ++n) _Pragma("unroll") for (int k = 0; k < 2; ++k) \
        acc[ai][bj][m][n] = __builtin_amdgcn_mfma_f32_16x16x32_bf16(Bt[n][k], At[m][k], acc[ai][bj][m][n], 0, 0, 0); __builtin_amdgcn_s_setprio(0); } while (0)
#define PG8_WAIT_V(n) asm volatile("s_waitcnt vmcnt(" #n ")" ::: "memory")
#define PG8_WAIT_L(n) asm volatile("s_waitcnt lgkmcnt(" #n ")" ::: "memory")
#define PG8_BAR __builtin_amdgcn_s_barrier()
#define PG8_SCHED __builtin_amdgcn_sched_barrier(0)
    Unit cur, nxt; int ui = 0;
    if (!prob.unit(0, cur)) return;
    f32x4 acc[2][2][4][2];
#pragma unroll
    for (int a = 0; a < 2; ++a)
#pragma unroll
        for (int b = 0; b < 2; ++b)
#pragma unroll
            for (int m = 0; m < 4; ++m)
#pragma unroll
                for (int n = 0; n < 2; ++n) acc[a][b][m][n] = (f32x4){0.f, 0.f, 0.f, 0.f};
    bf16x8 At[4][2], B0[2][2], B1[2][2];
    unsigned vc[2][2], vn[2][2];
#pragma unroll
    for (int h = 0; h < 2; ++h)
#pragma unroll
        for (int i = 0; i < 2; ++i) vc[h][i] = prob.a_voff(cur, h * HALF + sR[i], sC[i]);
    const char* Ab = prob.a_base();
    const char* cB = prob.b_base(cur);
    PG8_STAGE(PG8_SB(0, 0), cB, voffB); PG8_STAGE(PG8_SA(0, 0), Ab, vc[0]); PG8_STAGE(PG8_SB(0, 1), cB + hstep, voffB); PG8_STAGE(PG8_SA(0, 1), Ab, vc[1]);
    if (wr == 1) PG8_BAR;
    PG8_WAIT_V(4); PG8_BAR;
    PG8_STAGE(PG8_SB(1, 0), cB + kstep, voffB); PG8_STAGE(PG8_SA(1, 0), Ab + kstep, vc[0]); PG8_STAGE(PG8_SB(1, 1), cB + hstep + kstep, voffB);
    PG8_WAIT_V(6); PG8_BAR;
    for (;;) {
        const bool has_next = prob.unit(ui + 1, nxt);
        const char* nB = has_next ? prob.b_base(nxt) : cB;
#pragma unroll
        for (int h = 0; h < 2; ++h)
#pragma unroll
            for (int i = 0; i < 2; ++i) vn[h][i] = has_next ? prob.a_voff(nxt, h * HALF + sR[i], sC[i]) : vc[h][i];
        for (int t = 0; t < nt; t += 2) {
            const bool last = (t == nt - 2);
            const char* a1 = Ab + (size_t)(t + 1) * kstep;
            const char* a2 = last ? Ab : Ab + (size_t)(t + 2) * kstep; const char* b2 = last ? nB : cB + (size_t)(t + 2) * kstep;
            const char* a3 = a2 + kstep; const char* b3 = b2 + kstep;
            unsigned v2[2][2];
#pragma unroll
            for (int h = 0; h < 2; ++h)
#pragma unroll
                for (int i = 0; i < 2; ++i) v2[h][i] = last ? vn[h][i] : vc[h][i];
            PG8_LDB(B0, 0, 0); PG8_SCHED; PG8_LDA(At, 0, 0); PG8_STAGE(PG8_SA(1, 1), a1, vc[1]);
            PG8_WAIT_L(8); PG8_BAR; PG8_WAIT_L(0); PG8_MMA(0, 0, At, B0); PG8_BAR; PG8_SCHED;
            PG8_LDB(B1, 0, 1); PG8_STAGE(PG8_SB(0, 0), b2, voffB);
            PG8_BAR; PG8_WAIT_L(0); PG8_MMA(0, 1, At, B1); PG8_BAR;
            PG8_LDA(At, 0, 1); PG8_STAGE(PG8_SA(0, 0), a2, v2[0]);
            PG8_BAR; PG8_WAIT_L(0); PG8_MMA(1, 0, At, B0); PG8_BAR; PG8_SCHED;
            PG8_STAGE(PG8_SB(0, 1), b2 + hstep, voffB);
            PG8_WAIT_V(6); PG8_BAR; PG8_MMA(1, 1, At, B1); PG8_BAR;
            PG8_LDB(B0, 1, 0); PG8_SCHED; PG8_LDA(At, 1, 0); PG8_STAGE(PG8_SA(0, 1), a2, v2[1]);
            PG8_WAIT_L(8); PG8_BAR; PG8_WAIT_L(0); PG8_MMA(0, 0, At, B0); PG8_BAR; PG8_SCHED;
            PG8_LDB(B1, 1, 1); PG8_STAGE(PG8_SB(1, 0), b3, voffB);
            PG8_BAR; PG8_WAIT_L(0); PG8_MMA(0, 1, At, B1); PG8_BAR;
            PG8_LDA(At, 1, 1); PG8_STAGE(PG8_SA(1, 0), a3, v2[0]);
            PG8_BAR; PG8_WAIT_L(0); PG8_MMA(1, 0, At, B0); PG8_BAR; PG8_SCHED;
            PG8_STAGE(PG8_SB(1, 1), b3 + hstep, voffB);
            PG8_WAIT_V(6); PG8_BAR; PG8_MMA(1, 1, At, B1); PG8_BAR;
        }
        prob.epi(acc, cur, wr, wc, fr, fq);
        if (!has_next) break;
#pragma unroll
        for (int a = 0; a < 2; ++a)
#pragma unroll
            for (int b = 0; b < 2; ++b)
#pragma unroll
                for (int m = 0; m < 4; ++m)
#pragma unroll
                    for (int n = 0; n < 2; ++n) acc[a][b][m][n] = (f32x4){0.f, 0.f, 0.f, 0.f};
        cur = nxt; cB = nB; ++ui;
#pragma unroll
        for (int h = 0; h < 2; ++h)
#pragma unroll
            for (int i = 0; i < 2; ++i) vc[h][i] = vn[h][i];
    }
    PG8_WAIT_V(0);
    if (wr == 0) PG8_BAR;
    PG8_BAR;
#undef PG8_SA
#undef PG8_SB
#undef PG8_STAGE
#undef PG8_LDA
#undef PG8_LDB
#undef PG8_MMA
#undef PG8_WAIT_V
#undef PG8_WAIT_L
#undef PG8_BAR
#undef PG8_SCHED
}
typedef f32x4 Acc[2][2][4][2];

template <int KD, int LDC, int NTN> struct ProbBf16 {
    static constexpr int KDIM = KD;
    static constexpr bool PERM = true;
    const bf16_t* A; const bf16_t* Bt; bf16_t* z; int G, c;
    __device__ __forceinline__ bool unit(int i, Unit& u) const { return static_order(i, NROWS_ / BM, NTN, G, c, u); }
    __device__ __forceinline__ const char* a_base() const { return (const char*)A; }
    __device__ __forceinline__ unsigned a_voff(const Unit& u, int r, int cc) const { return (unsigned)((u.pm * BM + r) * KD + cc) * 2u; }
    __device__ __forceinline__ const char* b_base(const Unit& u) const { return (const char*)Bt + (size_t)u.pn * BM * KD * 2; }
    __device__ __forceinline__ void epi(const Acc& acc, const Unit& u, int wr, int wc, int fr, int fq) const {
        const int row0 = u.pm * BM + wr * 64 + fr, col0 = u.pn * BM + wc * 32 + 8 * fq;
#pragma unroll
        for (int ai = 0; ai < 2; ++ai)
#pragma unroll
            for (int m = 0; m < 4; ++m) { bf16_t* rowp = z + (size_t)(row0 + ai * HALF + m * 16) * LDC + col0;
#pragma unroll
                for (int bj = 0; bj < 2; ++bj) { const f32x4 v0 = acc[ai][bj][m][0], v1 = acc[ai][bj][m][1];
                    u32x4 w; w.x = cvt_pk_bf16(v0[0], v0[1]); w.y = cvt_pk_bf16(v0[2], v0[3]); w.z = cvt_pk_bf16(v1[0], v1[1]); w.w = cvt_pk_bf16(v1[2], v1[3]);
                    *(u32x4*)(rowp + bj * HALF) = w; } }
    }
};
typedef ProbBf16<D_, ZLD_, ZLD_ / BM> ProbIn;
struct ProbOut {
    static constexpr int KDIM = D_;
    static constexpr bool PERM = false;
    const bf16_t* A; const bf16_t* Bt; float* out; float* xc; const float* modv_l; int nM, G, c;
    __device__ __forceinline__ bool unit(int i, Unit& u) const { return static_order(i, nM, D_ / BM, G, c, u); }
    __device__ __forceinline__ const char* a_base() const { return (const char*)A; }
    __device__ __forceinline__ unsigned a_voff(const Unit& u, int r, int cc) const { return (unsigned)((u.pm * BM + r) * D_ + cc) * 2u; }
    __device__ __forceinline__ const char* b_base(const Unit& u) const { return (const char*)Bt + (size_t)u.pn * BM * D_ * 2; }
    __device__ __forceinline__ void epi(const Acc& acc, const Unit& u, int wr, int wc, int fr, int fq) const {
        const int rt = u.pm * BM; const bool isx = rt < NTOK_;
        const int mi = isx ? rt / L_ : B_;
        float* xb = isx ? out + (size_t)rt * D_ : xc + (size_t)(rt - NTOK_) * D_;
        const int rl = wr * 64 + fr, col0 = u.pn * BM + wc * 32 + 4 * fq;
        const float* gp = modv_l + (size_t)mi * 6 * D_ + 2 * D_ + col0;
        f32x4 ga[2][2];
#pragma unroll
        for (int bj = 0; bj < 2; ++bj)
#pragma unroll
            for (int n = 0; n < 2; ++n) ga[bj][n] = *(const f32x4*)(gp + bj * HALF + n * 16);
#pragma unroll
        for (int ai = 0; ai < 2; ++ai)
#pragma unroll
          for (int mh = 0; mh < 2; ++mh) {
            f32x4 xv[2][2][2];
#pragma unroll
            for (int mm = 0; mm < 2; ++mm) { const float* rowp = xb + (size_t)(rl + ai * HALF + (mh * 2 + mm) * 16) * D_ + col0;
#pragma unroll
                for (int bj = 0; bj < 2; ++bj)
#pragma unroll
                    for (int n = 0; n < 2; ++n) xv[mm][bj][n] = *(const f32x4*)(rowp + bj * HALF + n * 16); }
#pragma unroll
            for (int mm = 0; mm < 2; ++mm) { float* rowp = xb + (size_t)(rl + ai * HALF + (mh * 2 + mm) * 16) * D_ + col0;
#pragma unroll
                for (int bj = 0; bj < 2; ++bj)
#pragma unroll
                    for (int n = 0; n < 2; ++n) *(f32x4*)(rowp + bj * HALF + n * 16) = xv[mm][bj][n] + ga[bj][n] * acc[ai][bj][mh * 2 + mm][n]; }
          }
    }
};
struct ProbMoe1 {
    static constexpr int KDIM = D_;
    static constexpr bool PERM = true;
    const bf16_t* A; const bf16_t* Bt; const int* sel; bf16_t* hid; int nM, G, c;
    __device__ __forceinline__ bool unit(int i, Unit& u) const { return static_order(i, nM, 2 * D_ / BM, G, c, u); }
    __device__ __forceinline__ const char* a_base() const { return (const char*)A; }
    __device__ __forceinline__ unsigned a_voff(const Unit& u, int r, int cc) const { return (unsigned)(sel[u.pm * BM + r] * D_ + cc) * 2u; }
    __device__ __forceinline__ const char* b_base(const Unit& u) const { const int rt = u.pm * BM; const int e = rt < XSLOTS_ ? rt / (B_ * CAP_) : (rt - XSLOTS_) / (B_ * CAPC_);
        return (const char*)Bt + ((size_t)e * 2 * D_ + (size_t)u.pn * BM) * D_ * 2; }
    __device__ __forceinline__ void epi(const Acc& acc, const Unit& u, int wr, int wc, int fr, int fq) const {
        const int row0 = u.pm * BM + wr * 64 + fr, col0 = u.pn * HALF + wc * 32 + 8 * fq;
#pragma unroll
        for (int ai = 0; ai < 2; ++ai)
#pragma unroll
            for (int m = 0; m < 4; ++m) { bf16_t* rowp = hid + (size_t)(row0 + ai * HALF + m * 16) * D_ + col0;
                float r[8];
#pragma unroll
                for (int n = 0; n < 2; ++n)
#pragma unroll
                    for (int j = 0; j < 4; ++j) { const float g = acc[ai][0][m][n][j], uu = acc[ai][1][m][n][j]; r[n * 4 + j] = g * __builtin_amdgcn_rcpf(1.0f + __expf(-g)) * uu; }
                u32x4 w; w.x = cvt_pk_bf16(r[0], r[1]); w.y = cvt_pk_bf16(r[2], r[3]); w.z = cvt_pk_bf16(r[4], r[5]); w.w = cvt_pk_bf16(r[6], r[7]);
                *(u32x4*)rowp = w; }
    }
};
struct ProbMoe2 {
    static constexpr int KDIM = D_;
    static constexpr bool PERM = true;
    const bf16_t* A; const bf16_t* Bt; const float* gate; bf16_t* ye; int nM, G, c;
    __device__ __forceinline__ bool unit(int i, Unit& u) const { return static_order(i, nM, D_ / BM, G, c, u); }
    __device__ __forceinline__ const char* a_base() const { return (const char*)A; }
    __device__ __forceinline__ unsigned a_voff(const Unit& u, int r, int cc) const { return (unsigned)((u.pm * BM + r) * D_ + cc) * 2u; }
    __device__ __forceinline__ const char* b_base(const Unit& u) const { const int rt = u.pm * BM; const int e = rt < XSLOTS_ ? rt / (B_ * CAP_) : (rt - XSLOTS_) / (B_ * CAPC_);
        return (const char*)Bt + ((size_t)e * D_ + (size_t)u.pn * BM) * D_ * 2; }
    __device__ __forceinline__ void epi(const Acc& acc, const Unit& u, int wr, int wc, int fr, int fq) const {
        const int row0 = u.pm * BM + wr * 64 + fr, col0 = u.pn * BM + wc * 32 + 8 * fq;
        float gts[2][4];
#pragma unroll
        for (int ai = 0; ai < 2; ++ai)
#pragma unroll
            for (int m = 0; m < 4; ++m) gts[ai][m] = gate[row0 + ai * HALF + m * 16];
        __builtin_amdgcn_sched_barrier(0);
#pragma unroll
        for (int ai = 0; ai < 2; ++ai)
#pragma unroll
            for (int m = 0; m < 4; ++m) { const int row = row0 + ai * HALF + m * 16; const float gt = gts[ai][m]; bf16_t* rowp = ye + (size_t)row * D_ + col0;
#pragma unroll
                for (int bj = 0; bj < 2; ++bj) { const f32x4 v0 = acc[ai][bj][m][0] * gt, v1 = acc[ai][bj][m][1] * gt;
                    u32x4 w; w.x = cvt_pk_bf16(v0[0], v0[1]); w.y = cvt_pk_bf16(v0[2], v0[3]); w.z = cvt_pk_bf16(v1[0], v1[1]); w.w = cvt_pk_bf16(v1[2], v1[3]);
                    *(u32x4*)(rowp + bj * HALF) = w; } }
    }
};
}

__device__ __forceinline__ void cvt_wave_tile(const float* src, int ld, int nvalid, int k0, int n0, bf16_t* dst, int dld, int dst_row0, int lane) {
  typedef float f32x4 __attribute__((ext_vector_type(4)));
  typedef unsigned u32x4 __attribute__((ext_vector_type(4)));
  const int n4 = lane >> 3, kq = lane & 7, n = n0 + 4 * n4;
  f32x4 r[8];
  const bool ok = n < nvalid;
#pragma unroll
  for (int j = 0; j < 8; ++j) r[j] = ok ? __builtin_nontemporal_load((const f32x4*)(src + (size_t)(k0 + 8 * kq + j) * ld + n)) : (f32x4){0.f, 0.f, 0.f, 0.f};
#pragma unroll
  for (int i = 0; i < 4; ++i) {
    u32x4 w; w.x = pg8::cvt_pk_bf16(r[0][i], r[1][i]); w.y = pg8::cvt_pk_bf16(r[2][i], r[3][i]); w.z = pg8::cvt_pk_bf16(r[4][i], r[5][i]); w.w = pg8::cvt_pk_bf16(r[6][i], r[7][i]);
    *(u32x4*)(dst + (size_t)(dst_row0 + 4 * n4 + i) * dld + k0 + 8 * kq) = w;
  }
}
__device__ __forceinline__ void phase_cvt_static(const Params& p) {
  const int tid = otid(), wave = tid >> 6, lane = tid & 63;
  constexpr int KT = D_ / 64, NTI = ZLD_ / 32, NTO = D_ / 32;
  const int nin = DEPTH_ * KT * NTI, nout = DEPTH_ * KT * NTO;
  for (int u = obid() * NWAVE + wave; u < nin + nout; u += gridDim.x * NWAVE) {
    if (u < nin) { const int l = u / (KT * NTI), r = u % (KT * NTI), kt = r / NTI, ntl = r % NTI;
      cvt_wave_tile(p.w_in + (size_t)l * D_ * INCOLS_, INCOLS_, INCOLS_, kt * 64, ntl * 32, p.wb_in + (size_t)l * ZLD_ * D_, D_, ntl * 32, lane); }
    else { const int v = u - nin; const int l = v / (KT * NTO), r = v % (KT * NTO), kt = r / NTO, ntl = r % NTO;
      cvt_wave_tile(p.w_out + (size_t)l * D_ * D_, D_, D_, kt * 64, ntl * 32, p.wb_out + (size_t)l * D_ * D_, D_, ntl * 32, lane); }
  }
}
__device__ __forceinline__ void cvt_moe_tile(const Params& p, int l, int u, int lane) {
  constexpr int KT = D_ / 64, NTL = D_ / 32, per = KT * NTL;
  const int mat = u / (NEXP_ * per), e = (u / per) % NEXP_, r = u % per, kt = r / NTL, ntl = r % NTL;
  const size_t so = ((size_t)l * NEXP_ + e) * D_ * D_;
  const int n0 = ntl * 32;
  if (mat == 0) cvt_wave_tile(p.w_gate + so, D_, D_, kt * 64, n0, p.wb_moe1 + (size_t)e * 2 * D_ * D_, D_, (n0 / 128) * 256 + (n0 % 128), lane);
  else if (mat == 1) cvt_wave_tile(p.w_up + so, D_, D_, kt * 64, n0, p.wb_moe1 + (size_t)e * 2 * D_ * D_, D_, (n0 / 128) * 256 + 128 + (n0 % 128), lane);
  else cvt_wave_tile(p.w_down + so, D_, D_, kt * 64, n0, p.wb_moe2 + (size_t)e * D_ * D_, D_, n0, lane);
}
typedef float cvt_f32x4 __attribute__((ext_vector_type(4)));
__device__ __forceinline__ void cvt_moe_tile_load(const Params& p, int l, int u, int lane, cvt_f32x4 (&r)[8]) {
  constexpr int KT = D_ / 64, NTL = D_ / 32, per = KT * NTL;
  const int mat = u / (NEXP_ * per), e = (u / per) % NEXP_, rr = u % per, kt = rr / NTL, ntl = rr % NTL;
  const float* src = (mat == 0 ? p.w_gate : mat == 1 ? p.w_up : p.w_down) + ((size_t)l * NEXP_ + e) * D_ * D_;
  const int n4 = lane >> 3, kq = lane & 7, n = ntl * 32 + 4 * n4;
#pragma unroll
  for (int j = 0; j < 8; ++j) r[j] = __builtin_nontemporal_load((const cvt_f32x4*)(src + (size_t)(kt * 64 + 8 * kq + j) * D_ + n));
}
__device__ __forceinline__ void cvt_moe_tile_store(const Params& p, int u, int lane, const cvt_f32x4 (&r)[8]) {
  typedef unsigned u32x4 __attribute__((ext_vector_type(4)));
  constexpr int KT = D_ / 64, NTL = D_ / 32, per = KT * NTL;
  const int mat = u / (NEXP_ * per), e = (u / per) % NEXP_, rr = u % per, kt = rr / NTL, ntl = rr % NTL;
  const int n0 = ntl * 32, n4 = lane >> 3, kq = lane & 7;
  bf16_t* dst; int row0;
  if (mat == 0) { dst = p.wb_moe1 + (size_t)e * 2 * D_ * D_; row0 = (n0 / 128) * 256 + (n0 % 128); }
  else if (mat == 1) { dst = p.wb_moe1 + (size_t)e * 2 * D_ * D_; row0 = (n0 / 128) * 256 + 128 + (n0 % 128); }
  else { dst = p.wb_moe2 + (size_t)e * D_ * D_; row0 = n0; }
#pragma unroll
  for (int i = 0; i < 4; ++i) {
    u32x4 w; w.x = pg8::cvt_pk_bf16(r[0][i], r[1][i]); w.y = pg8::cvt_pk_bf16(r[2][i], r[3][i]); w.z = pg8::cvt_pk_bf16(r[4][i], r[5][i]); w.w = pg8::cvt_pk_bf16(r[6][i], r[7][i]);
    *(u32x4*)(dst + (size_t)(row0 + 4 * n4 + i) * D_ + kt * 64 + 8 * kq) = w;
  }
}
__device__ __forceinline__ void phase_cvt_moe_steal(const Params& p, int l, LAS unsigned char* lds) {
  const int tid = otid(), wave = tid >> 6, lane = tid & 63;
  constexpr int total = 3 * NEXP_ * (D_ / 64) * (D_ / 32);
  unsigned* ctr = p.bar + 3584 + 64 * l;
  volatile LAS int* slot = (volatile LAS int*)(lds + 64);
  for (;;) {
    __syncthreads();
    if (tid == 0) *slot = (int)__hip_atomic_fetch_add(ctr, (unsigned)(2 * NWAVE), __ATOMIC_RELAXED, __HIP_MEMORY_SCOPE_AGENT);
    __syncthreads();
    const int t0 = *slot;
    if (t0 >= total) break;
#pragma unroll
    for (int j = 0; j < 2; ++j) { const int u = t0 + j * NWAVE + wave; if (u < total) cvt_moe_tile(p, l, u, lane); }
  }
}
__device__ __forceinline__ void phase_cvt_small(const Params& p) {
  const int tid = otid(), wave = tid >> 6, lane = tid & 63;
  typedef unsigned u32x4 __attribute__((ext_vector_type(4)));
  const int nchunk = DEPTH_ * ZS2W_ * (AUXW_ / 8);
  for (int idx = obid() * NT + tid; idx < nchunk; idx += gridDim.x * NT) {
    const int k8 = (idx % (AUXW_ / 8)) * 8, n = (idx / (AUXW_ / 8)) % ZS2W_, pn = n >> 8;
    const int lo = pn <= 1 ? 0 : pn <= 3 ? 128 : pn <= 5 ? 192 : 256, hi = pn <= 1 ? 128 : pn <= 3 ? 192 : pn <= 5 ? 256 : 384;
    if (k8 < lo || k8 >= hi) *(u32x4*)(p.bts + (size_t)idx * 8) = (u32x4){0u, 0u, 0u, 0u};
  }
  for (int u = obid() * NWAVE + wave; u < DEPTH_ * 80; u += gridDim.x * NWAVE) {
    const int l = u / 80; int r = u % 80; int pn, kt, ntl;
    if (r < 32) { pn = r / 16; r %= 16; kt = r / 8; ntl = r % 8; }
    else if (r < 64) { pn = 2 + (r - 32) / 8; kt = 0; ntl = (r - 32) % 8; }
    else { pn = 6; r -= 64; kt = r / 8; ntl = r % 8; }
    const float* src; int koff;
    if (pn == 0) { src = p.w_uk + (size_t)l * KVR_ * GWID_; koff = 0; }
    else if (pn == 1) { src = p.w_uv + (size_t)l * KVR_ * GWID_; koff = 0; }
    else if (pn <= 3) { src = p.rwkv_w2 + ((size_t)l * 2 + (pn - 2)) * DLORA_ * GWID_; koff = 128; }
    else if (pn <= 5) { src = p.rwkv_a2 + ((size_t)l * 2 + (pn - 4)) * ALORA_ * GWID_; koff = 192; }
    else { src = p.rwkv_g2 + (size_t)l * GLORA_ * GWID_; koff = 256; }
    cvt_wave_tile(src, GWID_, GWID_, kt * 64, ntl * 32, p.bts + (size_t)l * ZS2W_ * AUXW_ + koff, AUXW_, pn * 256 + ntl * 32, lane);
  }
}
__device__ __forceinline__ void phase_gemm_small_mfma(const Params& p, int l, LAS unsigned char* lds) {
  pg8::ProbBf16<AUXW_, ZS2W_, ZS2W_ / 256> pr; pr.A = p.aux; pr.Bt = p.bts + (size_t)l * ZS2W_ * AUXW_; pr.z = p.zs2; pr.G = gridDim.x; pr.c = obid();
  pg8::gemm_phase(lds, pr);
}
__device__ __forceinline__ void phase_gemm_in_mfma(const Params& p, int l, LAS unsigned char* lds) {
  pg8::ProbIn pr; pr.A = p.h; pr.Bt = p.wb_in + (size_t)l * ZLD_ * D_; pr.z = p.z; pr.G = gridDim.x; pr.c = obid();
  pg8::gemm_phase(lds, pr);
}
__device__ __forceinline__ void phase_gemm_out_mfma(const Params& p, int l, LAS unsigned char* lds) {
  pg8::ProbOut pr; pr.A = p.y; pr.Bt = p.wb_out + (size_t)l * D_ * D_; pr.out = p.out; pr.xc = p.xc; pr.modv_l = p.modv + (size_t)l * (B_ + 1) * 6 * D_;
  pr.nM = (l == DEPTH_ - 1 ? NTOK_ : NROWS_) / 256; pr.G = gridDim.x; pr.c = obid();
  pg8::gemm_phase(lds, pr);
}
__device__ __forceinline__ void phase_moe1_mfma(const Params& p, int l, LAS unsigned char* lds) {
  pg8::ProbMoe1 pr; pr.A = p.h; pr.Bt = p.wb_moe1; pr.sel = p.sel_idx; pr.hid = p.hid; pr.nM = (l == DEPTH_ - 1 ? XSLOTS_ : XSLOTS_ + CSLOTS_) / 256; pr.G = gridDim.x; pr.c = obid();
  pg8::gemm_phase(lds, pr);
}
__device__ __forceinline__ void phase_moe2_mfma(const Params& p, int l, LAS unsigned char* lds) {
  pg8::ProbMoe2 pr; pr.A = p.hid; pr.Bt = p.wb_moe2; pr.gate = p.sel_gate; pr.ye = p.ye; pr.nM = (l == DEPTH_ - 1 ? XSLOTS_ : XSLOTS_ + CSLOTS_) / 256; pr.G = gridDim.x; pr.c = obid();
  pg8::gemm_phase(lds, pr);
}
#endif


#if D_ == 1024 && HD_ == 64 && KVR_ == 128 && DLORA_ == 64 && ALORA_ == 64 && GLORA_ == 128
#define HAVE_PREPA 1
struct U2_ { unsigned x, y; };
struct U4_ { unsigned x, y, z, w; };
__device__ __forceinline__ float bflo(unsigned u) { union { unsigned u; float f; } x; x.u = u << 16; return x.f; }
__device__ __forceinline__ float bfhi(unsigned u) { union { unsigned u; float f; } x; x.u = u & 0xFFFF0000u; return x.f; }
__device__ __forceinline__ unsigned pk2(float a, float b) { return (unsigned)f2bf(a) | ((unsigned)f2bf(b) << 16); }
__device__ __forceinline__ void ld2(const bf16_t* p, float* o) { const unsigned u = *(const unsigned*)p; o[0] = bflo(u); o[1] = bfhi(u); }
__device__ __forceinline__ void ld4(const bf16_t* p, float* o) { const U2_ u = *(const U2_*)p; o[0] = bflo(u.x); o[1] = bfhi(u.x); o[2] = bflo(u.y); o[3] = bfhi(u.y); }
__device__ __forceinline__ void ld8(const bf16_t* p, float* o) { const U4_ u = *(const U4_*)p; o[0] = bflo(u.x); o[1] = bfhi(u.x); o[2] = bflo(u.y); o[3] = bfhi(u.y); o[4] = bflo(u.z); o[5] = bfhi(u.z); o[6] = bflo(u.w); o[7] = bfhi(u.w); }
__device__ __forceinline__ void st2(bf16_t* p, const float* v) { *(unsigned*)p = pk2(v[0], v[1]); }
__device__ __forceinline__ void st4(bf16_t* p, const float* v) { U2_ u; u.x = pk2(v[0], v[1]); u.y = pk2(v[2], v[3]); *(U2_*)p = u; }
__device__ __forceinline__ void st8(bf16_t* p, const float* v) { U4_ u; u.x = pk2(v[0], v[1]); u.y = pk2(v[2], v[3]); u.z = pk2(v[4], v[5]); u.w = pk2(v[6], v[7]); *(U4_*)p = u; }
__device__ __forceinline__ void unp2(unsigned u, float* o) { o[0] = bflo(u); o[1] = bfhi(u); }
__device__ __forceinline__ void unp4(U2_ u, float* o) { o[0] = bflo(u.x); o[1] = bfhi(u.x); o[2] = bflo(u.y); o[3] = bfhi(u.y); }
__device__ __forceinline__ void unp8(U4_ u, float* o) { o[0] = bflo(u.x); o[1] = bfhi(u.x); o[2] = bflo(u.y); o[3] = bfhi(u.y); o[4] = bflo(u.z); o[5] = bfhi(u.z); o[6] = bflo(u.w); o[7] = bfhi(u.w); }
struct RawA { U2_ bb, cg, hh, cgp, hp, cgn, hn, qn; unsigned qr, c2, kr; U4_ a, ap, an, b, bp, bn; U2_ q, k, v, g; float tc0, ts0, tc1, ts1; F4_ rc4, rs4; };
struct ParA { F4_ w0, w1, w2, go, gq4, ma0, ma1, mb0, mb1, kk0, kk1; float gq_r0, gq_r1, gkv0, gkv1, gk0, gk1; };
__device__ __forceinline__ void prepA_params(const Params& p, int l, int lane, ParA& P) {
  const int c4 = 4 * lane, sub = lane & 15;
  const float* cw = p.conv_w + (size_t)l * 3 * GWID_ + c4;
  P.w0 = *(const F4_*)cw; P.w1 = *(const F4_*)(cw + GWID_); P.w2 = *(const F4_*)(cw + 2 * GWID_); P.go = *(const F4_*)(p.g_out_conv + l * GWID_ + c4);
  const float* gq = p.g_q_norm + (size_t)l * QK_;
  P.gq4 = *(const F4_*)(gq + 4 * sub); P.gq_r0 = gq[HD_ + 2 * sub]; P.gq_r1 = gq[HD_ + 2 * sub + 1];
  P.gkv0 = p.g_kv_norm[l * KVR_ + 2 * lane]; P.gkv1 = p.g_kv_norm[l * KVR_ + 2 * lane + 1];
  const float* gk = p.g_k_norm + (size_t)l * QK_ + HD_; P.gk0 = gk[2 * sub]; P.gk1 = gk[2 * sub + 1];
  const float* mu = p.rwkv_mu + (size_t)l * COLS_RWKV_;
  P.ma0 = *(const F4_*)(mu + 8 * lane); P.ma1 = *(const F4_*)(mu + 8 * lane + 4); P.mb0 = *(const F4_*)(mu + 512 + 8 * lane); P.mb1 = *(const F4_*)(mu + 512 + 8 * lane + 4);
  const int kch = 8 * (lane & 31);
  P.kk0 = *(const F4_*)(p.rwkv_k_k + l * GWID_ + kch); P.kk1 = *(const F4_*)(p.rwkv_k_k + l * GWID_ + kch + 4);
}
__device__ __forceinline__ void prepA_load(const Params& p, int row, int lane, RawA& r) {
  const int c4 = 4 * lane, head = lane >> 4, sub = lane & 15;
  const int pos = row_pos(row), len = row_len(row);
  const bf16_t* zr = p.z + (size_t)row * ZLD_;
  const bool hasp = pos > 0, hasn = pos < len - 1;
  const bf16_t* zp = hasp ? zr - ZLD_ : zr; const bf16_t* zn = hasn ? zr + ZLD_ : zr;
  const bf16_t* zm = zr + MLA0_;
  const bf16_t* zw = zr + RW0_; const bf16_t* zwp = zp + RW0_; const bf16_t* zwn = zn + RW0_;
  const bf16_t* zt = zr + RT0_;
  r.bb = *(const U2_*)(zr + c4); r.cg = *(const U2_*)(zr + GWID_ + c4); r.hh = *(const U2_*)(zr + 2 * GWID_ + c4);
  r.cgp = *(const U2_*)(zp + GWID_ + c4); r.hp = *(const U2_*)(zp + 2 * GWID_ + c4); r.cgn = *(const U2_*)(zn + GWID_ + c4); r.hn = *(const U2_*)(zn + 2 * GWID_ + c4);
  r.qn = *(const U2_*)(zm + head * HD_ + 4 * sub);
  r.qr = *(const unsigned*)(zm + NH_ * HD_ + head * ROPE_ + 2 * sub); r.c2 = *(const unsigned*)(zm + NH_ * QK_ + 2 * lane); r.kr = *(const unsigned*)(zm + NH_ * QK_ + KVR_ + 2 * sub);
  r.a = *(const U4_*)(zw + 8 * lane); r.ap = *(const U4_*)(zwp + 8 * lane); r.an = *(const U4_*)(zwn + 8 * lane);
  r.b = *(const U4_*)(zw + 512 + 8 * lane); r.bp = *(const U4_*)(zwp + 512 + 8 * lane); r.bn = *(const U4_*)(zwn + 512 + 8 * lane);
  r.q = *(const U2_*)(zt + c4); r.k = *(const U2_*)(zt + GWID_ + c4); r.v = *(const U2_*)(zt + 2 * GWID_ + c4); r.g = *(const U2_*)(zt + 3 * GWID_ + c4);
  { const float* tab = p.tab_mla + (size_t)pos * 32; const int ax = sub >> 3, f0 = (2 * sub) & 7;
    r.tc0 = tab[(ax * 2) * 8 + f0]; r.ts0 = tab[(ax * 2 + 1) * 8 + f0]; r.tc1 = tab[(ax * 2) * 8 + f0 + 1]; r.ts1 = tab[(ax * 2 + 1) * 8 + f0 + 1];
    const float* tr = p.tab_ret + (size_t)pos * HD_; const int fr0 = 4 * (lane & 7); r.rc4 = *(const F4_*)(tr + fr0); r.rs4 = *(const F4_*)(tr + HD_ / 2 + fr0); }
}
__device__ __forceinline__ void prepA_compute(const Params& p, int l, int row, int lane, const RawA& R, const ParA& P) {
  const bool last = (l == DEPTH_ - 1);
  const int c4 = 4 * lane, head = lane >> 4, sub = lane & 15;
  const bool isx = row < NTOK_;
  const int pos = row_pos(row), len = row_len(row);
  const bool hasp = pos > 0, hasn = pos < len - 1;
  const float fp = hasp ? 1.f : 0.f, fn = hasn ? 1.f : 0.f;
  const bool need_out = isx || !last;
  const U2_ r_bb = R.bb, r_cg = R.cg, r_hh = R.hh, r_cgp = R.cgp, r_hp = R.hp, r_cgn = R.cgn, r_hn = R.hn, r_qn = R.qn;
  const unsigned r_qr = R.qr, r_c2 = R.c2, r_kr = R.kr;
  const U4_ r_a = R.a, r_ap = R.ap, r_an = R.an, r_b = R.b, r_bp = R.bp, r_bn = R.bn;
  const U2_ r_q = R.q, r_k = R.k, r_v = R.v, r_g = R.g;
  {
    if (need_out) {
      float bb[4], cg[4], hh[4], cgp[4], hp[4], cgn[4], hn[4], t[4];
      unp4(r_bb, bb); unp4(r_cg, cg); unp4(r_hh, hh); unp4(r_cgp, cgp); unp4(r_hp, hp); unp4(r_cgn, cgn); unp4(r_hn, hn);
      const F4_ w0 = P.w0, w1 = P.w1, w2 = P.w2, go = P.go;
      const float w0a[4] = {w0.x, w0.y, w0.z, w0.w}, w1a[4] = {w1.x, w1.y, w1.z, w1.w}, w2a[4] = {w2.x, w2.y, w2.z, w2.w}, goa[4] = {go.x, go.y, go.z, go.w};
      float ss = 0.f;
#pragma unroll
      for (int j = 0; j < 4; ++j) { const float yv = w0a[j] * (fp * cgp[j] * hp[j]) + w1a[j] * (cg[j] * hh[j]) + w2a[j] * (fn * cgn[j] * hn[j]); t[j] = bb[j] * yv; ss += t[j] * t[j]; }
      ss = wave_sum(ss);
      const float rstd = rsqrtf(ss / (float)GWID_ + 1e-6f);
#pragma unroll
      for (int j = 0; j < 4; ++j) t[j] = t[j] * rstd * goa[j];
      st4(p.y + (size_t)row * D_ + c4, t);
    }
    {
      float qn[4], qr[2];
      unp4(r_qn, qn); unp2(r_qr, qr);
      float ss = qn[0] * qn[0] + qn[1] * qn[1] + qn[2] * qn[2] + qn[3] * qn[3] + qr[0] * qr[0] + qr[1] * qr[1];
      ss += __shfl_xor(ss, 1); ss += __shfl_xor(ss, 2); ss += __shfl_xor(ss, 4); ss += __shfl_xor(ss, 8);
      const float rs = rsqrtf(ss / (float)QK_ + 1e-6f) * 0.10206207261596575f;
      const F4_ gq4 = P.gq4;
      qn[0] *= rs * gq4.x; qn[1] *= rs * gq4.y; qn[2] *= rs * gq4.z; qn[3] *= rs * gq4.w;
      float v0 = qr[0] * rs * P.gq_r0, v1 = qr[1] * rs * P.gq_r1;
      const float p0 = __shfl_xor(v0, 4), p1 = __shfl_xor(v1, 4);
      if (isx) {
        const int half = (sub >> 2) & 1;
        const float c0 = R.tc0, s0 = R.ts0, c1 = R.tc1, s1 = R.ts1;
        v0 = half == 0 ? v0 * c0 - p0 * s0 : p0 * s0 + v0 * c0;
        v1 = half == 0 ? v1 * c1 - p1 * s1 : p1 * s1 + v1 * c1;
      }
      if (need_out) { bf16_t* qd = p.qb + ((size_t)row * NH_ + head) * QK_; st4(qd + 4 * sub, qn); float o2[2] = {v0, v1}; st2(qd + HD_ + 2 * sub, o2); }
    }
    {
      float c2[2]; unp2(r_c2, c2);
      const float ss = wave_sum(c2[0] * c2[0] + c2[1] * c2[1]);
      const float rstd = rsqrtf(ss / (float)KVR_ + 1e-6f);
      float o2[2] = {c2[0] * rstd * P.gkv0, c2[1] * rstd * P.gkv1};
      st2(p.aux + (size_t)row * AUXW_ + 2 * lane, o2);
      float kr[2]; unp2(r_kr, kr);
      float s2 = kr[0] * kr[0] + kr[1] * kr[1];
      s2 += __shfl_xor(s2, 1); s2 += __shfl_xor(s2, 2); s2 += __shfl_xor(s2, 4); s2 += __shfl_xor(s2, 8);
      float v0 = kr[0] * P.gk0, v1 = kr[1] * P.gk1;
      const float p0 = __shfl_xor(v0, 4), p1 = __shfl_xor(v1, 4);
      if (isx) {
        const int half = (sub >> 2) & 1;
        const float c0 = R.tc0, s0 = R.ts0, c1 = R.tc1, s1 = R.ts1;
        v0 = half == 0 ? v0 * c0 - p0 * s0 : p0 * s0 + v0 * c0;
        v1 = half == 0 ? v1 * c1 - p1 * s1 : p1 * s1 + v1 * c1;
      }
      if (lane < 16) { float o[2] = {v0, v1}; st2(p.krp + (size_t)row * ROPE_ + 2 * sub, o); if (lane == 0) p.kr2[row] = s2; }
    }
    {
      float a[8], ap[8], an[8], bq[8], bp[8], bn[8];
      unp8(r_a, a); unp8(r_ap, ap); unp8(r_an, an); unp8(r_b, bq); unp8(r_bp, bp); unp8(r_bn, bn);
      const F4_ ma0 = P.ma0, ma1 = P.ma1, mb0 = P.mb0, mb1 = P.mb1;
      const float mua[8] = {ma0.x, ma0.y, ma0.z, ma0.w, ma1.x, ma1.y, ma1.z, ma1.w}, mub[8] = {mb0.x, mb0.y, mb0.z, mb0.w, mb1.x, mb1.y, mb1.z, mb1.w};
#pragma unroll
      for (int j = 0; j < 8; ++j) { a[j] = a[j] + mua[j] * (0.5f * (fp * ap[j] + fn * an[j]) - a[j]); bq[j] = bq[j] + mub[j] * (0.5f * (fp * bp[j] + fn * bn[j]) - bq[j]); }
      {
        const int kch = 8 * (lane & 31);
        const F4_ kk0 = P.kk0, kk1 = P.kk1;
        const float kkw[8] = {kk0.x, kk0.y, kk0.z, kk0.w, kk1.x, kk1.y, kk1.z, kk1.w};
        float kkr[8]; float s2 = 0.f;
#pragma unroll
        for (int j = 0; j < 8; ++j) { kkr[j] = a[j] * kkw[j]; s2 += kkr[j] * kkr[j]; }
        s2 += __shfl_xor(s2, 1); s2 += __shfl_xor(s2, 2); s2 += __shfl_xor(s2, 4);
        const float inv = rsqrtf(s2 + 1e-12f);
        if (lane < 32) { F4_* d = (F4_*)(p.sc_r + (size_t)row * GWID_ + kch); F4_ o0 = {a[0], a[1], a[2], a[3]}, o1 = {a[4], a[5], a[6], a[7]}; d[0] = o0; d[1] = o1; }
        else { st8(p.kbuf + (size_t)row * GWID_ + kch, a); F4_* d = (F4_*)(p.sc_kk + (size_t)row * GWID_ + kch);
          F4_ o0 = {kkr[0] * inv, kkr[1] * inv, kkr[2] * inv, kkr[3] * inv}, o1 = {kkr[4] * inv, kkr[5] * inv, kkr[6] * inv, kkr[7] * inv}; d[0] = o0; d[1] = o1; }
      }
      if (lane < 32) { F4_* d = (F4_*)(p.sc_v + (size_t)row * GWID_ + 8 * lane); F4_ o0 = {bq[0], bq[1], bq[2], bq[3]}, o1 = {bq[4], bq[5], bq[6], bq[7]}; d[0] = o0; d[1] = o1; }
      else {
        float o[8];
        if (lane < 40) {
#pragma unroll
          for (int j = 0; j < 8; ++j) o[j] = tanhf_(bq[j]); }
        else if (lane < 48) {
#pragma unroll
          for (int j = 0; j < 8; ++j) o[j] = bq[j]; }
        else {
#pragma unroll
          for (int j = 0; j < 8; ++j) o[j] = sigmoidf_(bq[j]); }
        st8(p.aux + (size_t)row * AUXW_ + KVR_ + 8 * (lane - 32), o);
      }
    }
    {
      float q[4], k[4];
      unp4(r_q, q); unp4(r_k, k);
#pragma unroll
      for (int j = 0; j < 4; ++j) q[j] *= 0.125f;
      float pq[4], pk[4];
#pragma unroll
      for (int j = 0; j < 4; ++j) { pq[j] = __shfl_xor(q[j], 8); pk[j] = __shfl_xor(k[j], 8); }
      if (isx) {
        const int half = (lane >> 3) & 1, f0 = 4 * (lane & 7);
        const F4_ c4v = R.rc4, s4v = R.rs4;
        const float csa[4] = {c4v.x, c4v.y, c4v.z, c4v.w}, sna[4] = {s4v.x, s4v.y, s4v.z, s4v.w};
#pragma unroll
        for (int j = 0; j < 4; ++j) { const float cs = csa[j], sn = sna[j];
          q[j] = half == 0 ? q[j] * cs - pq[j] * sn : pq[j] * sn + q[j] * cs;
          k[j] = half == 0 ? k[j] * cs - pk[j] * sn : pk[j] * sn + k[j] * cs; }
      }
      st4(p.rq + (size_t)row * GWID_ + c4, q); st4(p.rk + (size_t)row * GWID_ + c4, k);
      *(U2_*)(p.rv + (size_t)row * GWID_ + c4) = r_v;
      float g4[4]; unp4(r_g, g4);
#pragma unroll
      for (int j = 0; j < 4; ++j) g4[j] = siluf_(g4[j]);
      st4(p.rg + (size_t)row * GWID_ + c4, g4);
    }
  }
}
__device__ __forceinline__ void phase_prepA(const Params& p, int l) {
  const int tid = otid(), wave = tid >> 6, lane = tid & 63;
  const int stride = gridDim.x * NWAVE;
  int row = obid() * NWAVE + wave;
  if (row >= NROWS_) return;
  ParA P; prepA_params(p, l, lane, P);
  RawA cur; prepA_load(p, row, lane, cur);
  for (; row < NROWS_; row += stride) {
    RawA nxt; const bool has = row + stride < NROWS_;
    prepA_load(p, has ? row + stride : row, lane, nxt);
    prepA_compute(p, l, row, lane, cur, P);
    cur = nxt;
  }
}
__device__ __forceinline__ void phase_prepB_naive(const Params& p, int l) {
  const int tid = otid(), wave = tid >> 6, lane = tid & 63;
  for (int row = obid() * NWAVE + wave; row < NROWS_; row += gridDim.x * NWAVE) {
    const bf16_t* ax = p.aux + (size_t)row * AUXW_;
    for (int n = lane; n < ZS2W_; n += 64) {
      const int pn = n >> 8, ch = n & 255; float acc = 0.f;
      if (pn == 0) for (int k = 0; k < 128; ++k) acc += bf2f(ax[k]) * p.w_uk[((size_t)l * KVR_ + k) * GWID_ + ch];
      else if (pn == 1) for (int k = 0; k < 128; ++k) acc += bf2f(ax[k]) * p.w_uv[((size_t)l * KVR_ + k) * GWID_ + ch];
      else if (pn <= 3) for (int k = 0; k < 64; ++k) acc += bf2f(ax[128 + k]) * p.rwkv_w2[(((size_t)l * 2 + (pn - 2)) * DLORA_ + k) * GWID_ + ch];
      else if (pn <= 5) for (int k = 0; k < 64; ++k) acc += bf2f(ax[192 + k]) * p.rwkv_a2[(((size_t)l * 2 + (pn - 4)) * ALORA_ + k) * GWID_ + ch];
      else for (int k = 0; k < 128; ++k) acc += bf2f(ax[256 + k]) * p.rwkv_g2[((size_t)l * GLORA_ + k) * GWID_ + ch];
      p.zs2[(size_t)row * ZS2W_ + n] = f2bf(acc);
    }
  }
}
struct RawC { U2_ kn, v, lw0, lw1, la0, la1, k0; F4_ kk, rr; unsigned kr; float kr2; };
__device__ __forceinline__ void prepC_load(const Params& p, int row, int lane, RawC& r) {
  const int head = lane >> 4, sub = lane & 15, ch = 64 * head + 4 * sub;
  const bf16_t* zs = p.zs2 + (size_t)row * ZS2W_;
  r.kn = *(const U2_*)(zs + ch); r.v = *(const U2_*)(zs + 256 + ch); r.lw0 = *(const U2_*)(zs + 512 + ch); r.lw1 = *(const U2_*)(zs + 768 + ch);
  r.la0 = *(const U2_*)(zs + 1024 + ch); r.la1 = *(const U2_*)(zs + 1280 + ch);
  r.kk = *(const F4_*)(p.sc_kk + (size_t)row * GWID_ + ch); r.rr = *(const F4_*)(p.sc_r + (size_t)row * GWID_ + ch);
  r.k0 = *(const U2_*)(p.kbuf + (size_t)row * GWID_ + ch);
  r.kr = *(const unsigned*)(p.krp + (size_t)row * ROPE_ + 2 * sub);
  r.kr2 = p.kr2[row];
}
__device__ __forceinline__ void phase_prepC(const Params& p, int l) {
  const int tid = otid(), wave = tid >> 6, lane = tid & 63;
  const int head = lane >> 4, sub = lane & 15, ch = 64 * head + 4 * sub;
  const int stride = gridDim.x * NWAVE;
  int it = obid() * NWAVE + wave;
  if (it >= NROWS_) return;
  const F4_ gk4 = *(const F4_*)(p.g_k_norm + (size_t)l * QK_ + 4 * sub);
  const F4_ w00 = *(const F4_*)(p.rwkv_w0 + (l * 2 + 0) * GWID_ + ch), w01 = *(const F4_*)(p.rwkv_w0 + (l * 2 + 1) * GWID_ + ch);
  const F4_ a00 = *(const F4_*)(p.rwkv_a0 + (l * 2 + 0) * GWID_ + ch), a01 = *(const F4_*)(p.rwkv_a0 + (l * 2 + 1) * GWID_ + ch);
  const F4_ ka4 = *(const F4_*)(p.rwkv_k_a + l * GWID_ + ch), rk4 = *(const F4_*)(p.rwkv_r_k + l * GWID_ + ch);
  RawC cur; prepC_load(p, NROWS_ - 1 - it, lane, cur);
  for (; it < NROWS_; it += stride) {
    const int row = NROWS_ - 1 - it;
    RawC nxt; const bool has = it + stride < NROWS_;
    prepC_load(p, has ? row - stride : row, lane, nxt);
    const bool isx = row < NTOK_; const int pos = row_pos(row), b = row_batch(row);
    const int kpos = isx ? LC_ + pos : pos;
    const U2_ r_kn = cur.kn, r_v = cur.v, r_lw0 = cur.lw0, r_lw1 = cur.lw1, r_la0 = cur.la0, r_la1 = cur.la1, r_k0 = cur.k0;
    const F4_ r_kk = cur.kk, r_rr = cur.rr; const unsigned r_kr = cur.kr; const float kr2 = cur.kr2;
    {
      float kn[4]; unp4(r_kn, kn);
      float ss = kn[0] * kn[0] + kn[1] * kn[1] + kn[2] * kn[2] + kn[3] * kn[3];
      ss += __shfl_xor(ss, 1); ss += __shfl_xor(ss, 2); ss += __shfl_xor(ss, 4); ss += __shfl_xor(ss, 8);
      const float rstd = rsqrtf((ss + kr2) / (float)QK_ + 1e-6f);
      bf16_t* kd = p.kb + (((size_t)b * NH_ + head) * LK_ + kpos) * KLD_;
      kn[0] *= rstd * gk4.x; kn[1] *= rstd * gk4.y; kn[2] *= rstd * gk4.z; kn[3] *= rstd * gk4.w;
      st4(kd + 4 * sub, kn);
      float kr[2]; unp2(r_kr, kr); kr[0] *= rstd; kr[1] *= rstd;
      st2(kd + HD_ + 2 * sub, kr);
      *(unsigned*)(kd + QK_ + 2 * sub) = 0u;
      *(U2_*)(p.vb + (((size_t)b * NH_ + head) * LK_ + kpos) * HD_ + 4 * sub) = r_v;
    }
    {
      const float kk[4] = {r_kk.x, r_kk.y, r_kk.z, r_kk.w}, rr[4] = {r_rr.x, r_rr.y, r_rr.z, r_rr.w};
      const float kaa[4] = {ka4.x, ka4.y, ka4.z, ka4.w}, rka[4] = {rk4.x, rk4.y, rk4.z, rk4.w};
      float k0[4]; unp4(r_k0, k0);
      float bsum = 0.f;
#pragma unroll
      for (int d = 0; d < 2; ++d) {
        float lw[4], la[4];
        unp4(d == 0 ? r_lw0 : r_lw1, lw); unp4(d == 0 ? r_la0 : r_la1, la);
        const F4_ w0v = d == 0 ? w00 : w01, a0v = d == 0 ? a00 : a01;
        const float w0a[4] = {w0v.x, w0v.y, w0v.z, w0v.w}, a0a[4] = {a0v.x, a0v.y, a0v.z, a0v.w};
        float ow[4], oka[4], okt[4];
#pragma unroll
        for (int j = 0; j < 4; ++j) {
          const float x = lw[j] + w0a[j];
          const float sp = softplus_neg_(x);
          ow[j] = fexp_(-fexp_(-sp - 0.5f));
          const float a = sigmoidf_(la[j] + a0a[j]);
          const float kt = k0[j] * (1.0f + (a - 1.0f) * kaa[j]);
          oka[j] = kk[j] * a; okt[j] = kt; bsum += rr[j] * kt * rka[j];
        }
        const size_t o = ((size_t)d * NROWS_ + row) * GWID_ + ch;
        { F4_ t = {ow[0], ow[1], ow[2], ow[3]}; *(F4_*)(p.sc_w + o) = t; }
        { F4_ t = {oka[0], oka[1], oka[2], oka[3]}; *(F4_*)(p.sc_kka + o) = t; }
        { F4_ t = {okt[0], okt[1], okt[2], okt[3]}; *(F4_*)(p.sc_kt + o) = t; }
      }
      bsum += __shfl_xor(bsum, 1); bsum += __shfl_xor(bsum, 2); bsum += __shfl_xor(bsum, 4); bsum += __shfl_xor(bsum, 8);
      if (sub == 0) { p.sc_bonus[(size_t)row * NH_ + head] = bsum; p.sc_bonus[(size_t)(NROWS_ + row) * NH_ + head] = 0.f; }
    }
    cur = nxt;
  }
}
struct RawP { F4_ ob, y0, y1, v; U2_ gt; float bon; };
__device__ __forceinline__ void post_load(const Params& p, int row, int lane, RawP& r) {
  const int ch = 4 * lane, head = lane >> 4; const size_t o = (size_t)row * GWID_ + ch;
  r.ob = *(const F4_*)(p.ob + o); r.y0 = *(const F4_*)(p.ys + o); r.y1 = *(const F4_*)(p.ys + (size_t)NROWS_ * GWID_ + o);
  r.v = *(const F4_*)(p.sc_v + o); r.gt = *(const U2_*)(p.zs2 + (size_t)row * ZS2W_ + 1536 + ch);
  r.bon = p.sc_bonus[(size_t)row * NH_ + head];
}
__device__ __forceinline__ void phase_post_fast(const Params& p, int l) {
  const int tid = otid(), wave = tid >> 6, lane = tid & 63;
  const bool last = (l == DEPTH_ - 1);
  const int nrow = last ? NTOK_ : NROWS_;
  const int ch = 4 * lane;
  const int stride = gridDim.x * NWAVE;
  int it = obid() * NWAVE + wave;
  if (it >= nrow) return;
  const F4_ gm = *(const F4_*)(p.g_out_mla + l * GWID_ + ch), gl = *(const F4_*)(p.g_ln_x + l * GWID_ + ch);
  RawP cur; post_load(p, nrow - 1 - it, lane, cur);
  for (; it < nrow; it += stride) {
    const int row = nrow - 1 - it;
    RawP nxt; const bool has = it + stride < nrow;
    post_load(p, has ? row - stride : row, lane, nxt);
    const F4_ r_ob = cur.ob, r_y0 = cur.y0, r_y1 = cur.y1, r_v = cur.v; const U2_ r_gt = cur.gt; const float bon = cur.bon;
    {
      const float ss = wave_sum(r_ob.x * r_ob.x + r_ob.y * r_ob.y + r_ob.z * r_ob.z + r_ob.w * r_ob.w);
      const float rstd = rsqrtf(ss / (float)GWID_ + 1e-6f);
      float t[4] = {r_ob.x * rstd * gm.x, r_ob.y * rstd * gm.y, r_ob.z * rstd * gm.z, r_ob.w * rstd * gm.w};
      st4(p.y + (size_t)row * D_ + GWID_ + ch, t);
    }
    {
      float yv[4] = {r_y0.x + r_y1.x, r_y0.y + r_y1.y, r_y0.z + r_y1.z, r_y0.w + r_y1.w};
      float s1 = yv[0] + yv[1] + yv[2] + yv[3];
      s1 += __shfl_xor(s1, 1); s1 += __shfl_xor(s1, 2); s1 += __shfl_xor(s1, 4); s1 += __shfl_xor(s1, 8);
      const float mean = s1 / (float)HD_;
      float s2 = 0.f;
#pragma unroll
      for (int j = 0; j < 4; ++j) { yv[j] -= mean; s2 += yv[j] * yv[j]; }
      s2 += __shfl_xor(s2, 1); s2 += __shfl_xor(s2, 2); s2 += __shfl_xor(s2, 4); s2 += __shfl_xor(s2, 8);
      const float rstd = rsqrtf(s2 / (float)HD_ + 64e-5f);
      const float gla[4] = {gl.x, gl.y, gl.z, gl.w}, va[4] = {r_v.x, r_v.y, r_v.z, r_v.w};
      float ga[4]; unp4(r_gt, ga);
      float t[4];
#pragma unroll
      for (int j = 0; j < 4; ++j) t[j] = (yv[j] * rstd * gla[j] + bon * va[j]) * ga[j];
      st4(p.y + (size_t)row * D_ + 2 * GWID_ + ch, t);
    }
    cur = nxt;
  }
}
#endif

__device__ __forceinline__ void phase_prep(const Params& p, int l) {
  float (*sm)[COLS_RWKV_ + 64] = (float (*)[COLS_RWKV_ + 64])SMEM_PTR();
  const int tid = otid(), wave = tid >> 6, lane = tid & 63;
  float* ws = sm[wave];
  const bool last = (l == DEPTH_ - 1);
  for (int row = obid() * NWAVE + wave; row < NROWS_; row += gridDim.x * NWAVE) {
    const bool isx = row < NTOK_;
    const int pos = row_pos(row), len = row_len(row), b = row_batch(row);
    const bf16_t* zr = p.z + (size_t)row * ZLD_;
    const bool hasp = pos > 0, hasn = pos < len - 1;
    const bf16_t* zp = zr - ZLD_; const bf16_t* zn = zr + ZLD_;
    const bool need_out = isx || !last;
    if (need_out) {
      const float* cw = p.conv_w + (size_t)l * 3 * GWID_;
      float t[GWID_ / 64]; float ss = 0.f;
#pragma unroll
      for (int i = 0; i < GWID_ / 64; ++i) {
        const int ch = i * 64 + lane;
        const float bv = bf2f(zr[ch]);
        const float u0 = bf2f(zr[GWID_ + ch]) * bf2f(zr[2 * GWID_ + ch]);
        const float up = hasp ? bf2f(zp[GWID_ + ch]) * bf2f(zp[2 * GWID_ + ch]) : 0.f;
        const float un = hasn ? bf2f(zn[GWID_ + ch]) * bf2f(zn[2 * GWID_ + ch]) : 0.f;
        const float yv = cw[ch] * up + cw[GWID_ + ch] * u0 + cw[2 * GWID_ + ch] * un;
        t[i] = bv * yv; ss += t[i] * t[i];
      }
      ss = wave_sum(ss);
      const float rstd = rsqrtf(ss / (float)GWID_ + 1e-6f);
#pragma unroll
      for (int i = 0; i < GWID_ / 64; ++i) { const int ch = i * 64 + lane; p.y[(size_t)row * D_ + ch] = f2bf(t[i] * rstd * p.g_out_conv[l * GWID_ + ch]); }
    }
    {
      const bf16_t* zm = zr + MLA0_;
      const int NF = ROPE_ / 4;
      const float* tab = p.tab_mla + (size_t)pos * 4 * NF;
      if (need_out) {
        for (int hh = 0; hh < NH_; ++hh) {
          float q0 = 0.f, q1 = 0.f;
          { const int e = lane; if (e < QK_) q0 = bf2f(e < HD_ ? zm[hh * HD_ + e] : zm[NH_ * HD_ + hh * ROPE_ + (e - HD_)]); }
          { const int e = lane + 64; if (e < QK_) q1 = bf2f(e < HD_ ? zm[hh * HD_ + e] : zm[NH_ * HD_ + hh * ROPE_ + (e - HD_)]); }
          const float ss = wave_sum(q0 * q0 + q1 * q1);
          const float rstd = rsqrtf(ss / (float)QK_ + 1e-6f);
          if (lane < QK_) ws[lane] = q0 * rstd * p.g_q_norm[l * QK_ + lane];
          if (lane + 64 < QK_) ws[lane + 64] = q1 * rstd * p.g_q_norm[l * QK_ + lane + 64];
          __builtin_amdgcn_wave_barrier();
          const float scale = 1.0f / sqrtf((float)QK_);
          for (int e = lane; e < QK_; e += 64) {
            float v = ws[e];
            if (isx && e >= HD_) {
              const int r = e - HD_; const int ax = r / (ROPE_ / 2), ri = r % (ROPE_ / 2); const int half = ri / NF, fi = ri % NF;
              const float cs = tab[(ax * 2 + 0) * NF + fi], sn = tab[(ax * 2 + 1) * NF + fi];
              const int base = HD_ + ax * (ROPE_ / 2);
              const float t1 = ws[base + fi], t2 = ws[base + NF + fi];
              v = half == 0 ? t1 * cs - t2 * sn : t1 * sn + t2 * cs;
            }
            p.qb[((size_t)row * NH_ + hh) * QK_ + e] = f2bf(v * scale);
          }
          __builtin_amdgcn_wave_barrier();
        }
      }
      float cs2 = 0.f;
      for (int e = lane; e < KVR_; e += 64) { const float v = bf2f(zm[NH_ * QK_ + e]); cs2 += v * v; }
      cs2 = wave_sum(cs2);
      const float crstd = rsqrtf(cs2 / (float)KVR_ + 1e-6f);
      for (int e = lane; e < KVR_; e += 64) ws[e] = bf2f(zm[NH_ * QK_ + e]) * crstd * p.g_kv_norm[l * KVR_ + e];
      __builtin_amdgcn_wave_barrier();
      float kn[GWID_ / 64], vv[GWID_ / 64];
#pragma unroll
      for (int i = 0; i < GWID_ / 64; ++i) { kn[i] = 0.f; vv[i] = 0.f; }
      const float* wuk = p.w_uk + (size_t)l * KVR_ * GWID_; const float* wuv = p.w_uv + (size_t)l * KVR_ * GWID_;
#pragma unroll 4
      for (int k = 0; k < KVR_; ++k) {
        const float cv = ws[k];
#pragma unroll
        for (int i = 0; i < GWID_ / 64; ++i) { kn[i] += cv * wuk[k * GWID_ + i * 64 + lane]; vv[i] += cv * wuv[k * GWID_ + i * 64 + lane]; }
      }
      __builtin_amdgcn_wave_barrier();
      const int kpos = isx ? LC_ + pos : pos;
#pragma unroll
      for (int i = 0; i < GWID_ / 64; ++i) {
        const int cidx = i * 64 + lane, hh = cidx / HD_, e = cidx % HD_;
        p.vb[(((size_t)b * NH_ + hh) * LK_ + kpos) * HD_ + e] = f2bf(vv[i]);
        ws[64 + cidx] = kn[i];
      }
      for (int e = lane; e < ROPE_; e += 64) ws[64 + GWID_ + e] = bf2f(zm[NH_ * QK_ + KVR_ + e]);
      __builtin_amdgcn_wave_barrier();
      float kr2 = 0.f;
      for (int e = lane; e < ROPE_; e += 64) { const float v = ws[64 + GWID_ + e]; kr2 += v * v; }
      kr2 = wave_sum(kr2);
      for (int hh = 0; hh < NH_; ++hh) {
        float s2 = 0.f;
        for (int e = lane; e < HD_; e += 64) { const float v = ws[64 + hh * HD_ + e]; s2 += v * v; }
        s2 = wave_sum(s2) + kr2;
        const float rstd = rsqrtf(s2 / (float)QK_ + 1e-6f);
        for (int e = lane; e < QK_; e += 64) {
          float v;
          if (e < HD_) v = ws[64 + hh * HD_ + e] * rstd * p.g_k_norm[l * QK_ + e];
          else {
            const int r = e - HD_;
            if (!isx) v = ws[64 + GWID_ + r] * rstd * p.g_k_norm[l * QK_ + e];
            else {
              const int ax = r / (ROPE_ / 2), ri = r % (ROPE_ / 2); const int half = ri / NF, fi = ri % NF;
              const float cs = tab[(ax * 2 + 0) * NF + fi], sn = tab[(ax * 2 + 1) * NF + fi];
              const int i1 = ax * (ROPE_ / 2) + fi, i2 = i1 + NF;
              const float t1 = ws[64 + GWID_ + i1] * rstd * p.g_k_norm[l * QK_ + HD_ + i1], t2 = ws[64 + GWID_ + i2] * rstd * p.g_k_norm[l * QK_ + HD_ + i2];
              v = half == 0 ? t1 * cs - t2 * sn : t1 * sn + t2 * cs;
            }
          }
          p.kb[(((size_t)b * NH_ + hh) * LK_ + kpos) * KLD_ + e] = f2bf(v);
        }
        for (int e = QK_ + lane; e < KLD_; e += 64) p.kb[(((size_t)b * NH_ + hh) * LK_ + kpos) * KLD_ + e] = 0;
      }
      __builtin_amdgcn_wave_barrier();
    }
    {
      const bf16_t* zw = zr + RW0_; const bf16_t* zwp = zp + RW0_; const bf16_t* zwn = zn + RW0_;
      const float* mu = p.rwkv_mu + (size_t)l * COLS_RWKV_;
      for (int e = lane; e < COLS_RWKV_; e += 64) {
        const float zc = bf2f(zw[e]); const float pv = hasp ? bf2f(zwp[e]) : 0.f; const float nv = hasn ? bf2f(zwn[e]) : 0.f;
        ws[e] = zc + mu[e] * (0.5f * (pv + nv) - zc);
      }
      __builtin_amdgcn_wave_barrier();
      for (int j = lane; j < DLORA_; j += 64) ws[3 * GWID_ + j] = tanhf(ws[3 * GWID_ + j]);
      for (int j = lane; j < GLORA_; j += 64) ws[3 * GWID_ + DLORA_ + ALORA_ + j] = sigmoidf_(ws[3 * GWID_ + DLORA_ + ALORA_ + j]);
      __builtin_amdgcn_wave_barrier();
      const float* zs = ws;
      const float* w2 = p.rwkv_w2 + (size_t)l * 2 * DLORA_ * GWID_; const float* a2 = p.rwkv_a2 + (size_t)l * 2 * ALORA_ * GWID_; const float* g2 = p.rwkv_g2 + (size_t)l * GLORA_ * GWID_;
      float bon[GWID_ / 64];
#pragma unroll
      for (int i = 0; i < GWID_ / 64; ++i) {
        const int ch = i * 64 + lane;
        const float rr = zs[ch], kk0 = zs[GWID_ + ch], vvv = zs[2 * GWID_ + ch];
        const float kkr = kk0 * p.rwkv_k_k[l * GWID_ + ch];
        float s2 = kkr * kkr;
        for (int m = 1; m < HD_ && m < 64; m <<= 1) s2 += __shfl_xor(s2, m);
        const float kkn = kkr * rsqrtf(s2 + 1e-12f);
        float gacc = 0.f;
#pragma unroll 4
        for (int j = 0; j < GLORA_; ++j) gacc += zs[3 * GWID_ + DLORA_ + ALORA_ + j] * g2[j * GWID_ + ch];
        float ksum = 0.f;
#pragma unroll 1
        for (int d = 0; d < 2; ++d) {
          float lw = p.rwkv_w0[(l * 2 + d) * GWID_ + ch], la = p.rwkv_a0[(l * 2 + d) * GWID_ + ch];
#pragma unroll 4
          for (int j = 0; j < DLORA_; ++j) lw += zs[3 * GWID_ + j] * w2[(d * DLORA_ + j) * GWID_ + ch];
#pragma unroll 4
          for (int j = 0; j < ALORA_; ++j) la += zs[3 * GWID_ + DLORA_ + j] * a2[(d * ALORA_ + j) * GWID_ + ch];
          const float sp = (-lw > 20.f) ? -lw : log1pf(expf(-lw));
          const float wdec = expf(-expf(-sp - 0.5f));
          const float a = sigmoidf_(la);
          const float kt = kk0 * (1.0f + (a - 1.0f) * p.rwkv_k_a[l * GWID_ + ch]);
          const size_t o = ((size_t)d * NROWS_ + row) * GWID_ + ch;
          p.sc_w[o] = wdec; p.sc_kka[o] = kkn * a; p.sc_kt[o] = kt; ksum += kt;
        }
        const size_t o = (size_t)row * GWID_ + ch;
        p.sc_r[o] = rr; p.sc_v[o] = vvv; p.sc_kk[o] = kkn; p.sc_gate[o] = gacc;
        float bs = rr * ksum * p.rwkv_r_k[l * GWID_ + ch];
        for (int m = 1; m < HD_ && m < 64; m <<= 1) bs += __shfl_xor(bs, m);
        bon[i] = bs;
      }
#pragma unroll
      for (int i = 0; i < GWID_ / 64; ++i) {
        const int ch = i * 64 + lane;
        if ((ch % HD_) == 0) { p.sc_bonus[(size_t)row * NH_ + ch / HD_] = bon[i]; p.sc_bonus[(size_t)(NROWS_ + row) * NH_ + ch / HD_] = 0.f; }
      }
      __builtin_amdgcn_wave_barrier();
    }
    {
      const bf16_t* zt = zr + RT0_;
      const int NR = HD_ / 2;
      const float* tab = p.tab_ret + (size_t)pos * 2 * NR;
      const float qs = 1.0f / sqrtf((float)HD_);
#pragma unroll
      for (int i = 0; i < GWID_ / 64; ++i) {
        const int ch = i * 64 + lane, hh = ch / HD_, e = ch % HD_;
        float q = bf2f(zt[ch]) * qs, k = bf2f(zt[GWID_ + ch]);
        if (isx) {
          const int fi = e % NR; const int half = e / NR;
          const int c1 = hh * HD_ + fi, c2 = c1 + NR;
          const float q1 = bf2f(zt[c1]) * qs, q2 = bf2f(zt[c2]) * qs, k1 = bf2f(zt[GWID_ + c1]), k2 = bf2f(zt[GWID_ + c2]);
          const float cs = tab[fi], sn = tab[NR + fi];
          q = half == 0 ? q1 * cs - q2 * sn : q1 * sn + q2 * cs;
          k = half == 0 ? k1 * cs - k2 * sn : k1 * sn + k2 * cs;
        }
        p.rq[(size_t)row * GWID_ + ch] = f2bf(q); p.rk[(size_t)row * GWID_ + ch] = f2bf(k); p.rv[(size_t)row * GWID_ + ch] = zt[2 * GWID_ + ch];
      }
    }
  }
}

__device__ __forceinline__ int chunk_row0(int b, int n) { return n < NCC_ ? NTOK_ + b * LC_ + n * RCH_ : b * L_ + (n - NCC_) * RCH_; }
__device__ __forceinline__ float ret_lg(int hh) { return log1pf(-exp2f(-5.0f - (float)hh)); }

__device__ __forceinline__ void phase_retd(const Params& p, int l) {
  const int tid = otid();
  const int nunits = B_ * NH_ * NCH_ * 2;
  for (int u = obid(); u < nunits; u += gridDim.x) {
    const int d = u & 1, n = (u >> 1) % NCH_, hh = ((u >> 1) / NCH_) % NH_, b = (u >> 1) / (NCH_ * NH_);
    const int r0 = chunk_row0(b, n);
    const float lg = ret_lg(hh);
    float* o = p.rd + ((((size_t)b * NH_ + hh) * NCH_ + n) * 2 + d) * HD_ * HD_;
    for (int e = tid; e < HD_ * HD_; e += NT) {
      const int kc = e / HD_, vc = e % HD_;
      float acc = 0.f;
      for (int c = 0; c < RCH_; ++c) {
        const float zeta = expf((d == 0 ? (float)(RCH_ - 1 - c) : (float)c) * lg);
        acc += zeta * bf2f(p.rk[(size_t)(r0 + c) * GWID_ + hh * HD_ + kc]) * bf2f(p.rv[(size_t)(r0 + c) * GWID_ + hh * HD_ + vc]);
      }
      o[e] = acc;
    }
  }
}

template <bool WITH_ATTN, bool WITH_SCAN, bool RS_BF16 = false> __device__ __forceinline__ void phase_mix(const Params& p, int l) {
  const int tid = otid(), wave = tid >> 6, lane = tid & 63;
  const bool last = (l == DEPTH_ - 1);
  for (int u = obid(); u < B_ * NH_ * 2; u += gridDim.x) {
    const int d = u & 1, hh = (u >> 1) % NH_, b = (u >> 1) / NH_;
    const float dec = expf((float)RCH_ * ret_lg(hh));
    for (int e = tid; e < HD_ * HD_; e += NT) {
      float st = 0.f;
      for (int i = 0; i < NCH_; ++i) {
        int n;
        if (d == 0) n = i; else n = i < NCC_ ? (NCC_ - 1 - i) : (NCC_ + (NCH_ - 1 - i));
        const size_t o = ((((size_t)b * NH_ + hh) * NCH_ + n) * 2 + d) * HD_ * HD_ + e;
        if (RS_BF16) ((bf16_t*)p.rs)[o] = f2bf(st); else p.rs[o] = st;
        st = st * dec + p.rd[o];
      }
    }
  }
  if (WITH_SCAN) for (int u = obid() * NWAVE + wave; u < B_ * NH_ * 2; u += gridDim.x * NWAVE) {
    const int d = u & 1, hh = (u >> 1) % NH_, b = (u >> 1) / NH_;
    float s[HD_];
#pragma unroll
    for (int k = 0; k < HD_; ++k) s[k] = 0.f;
    const int vr = lane % HD_;
    for (int i = 0; i < LK_; ++i) {
      int row;
      if (d == 0) row = i < LC_ ? NTOK_ + b * LC_ + i : b * L_ + (i - LC_);
      else row = i < LC_ ? NTOK_ + b * LC_ + (LC_ - 1 - i) : b * L_ + (L_ - 1 - (i - LC_));
      const size_t o1 = (size_t)row * GWID_ + hh * HD_, o2 = ((size_t)d * NROWS_ + row) * GWID_ + hh * HD_;
      const float vt = p.sc_v[o1 + vr];
      float sa = 0.f;
#pragma unroll
      for (int k = 0; k < HD_; ++k) sa += s[k] * p.sc_kk[o1 + k];
      float yv = 0.f;
#pragma unroll
      for (int k = 0; k < HD_; ++k) { s[k] = s[k] * p.sc_w[o2 + k] - sa * p.sc_kka[o2 + k] + vt * p.sc_kt[o2 + k]; yv += s[k] * p.sc_r[o1 + k]; }
      if (lane < HD_) p.ys[o2 + vr] = yv;
    }
  }
  if (WITH_ATTN) {
    const int nq = last ? NTOK_ : NROWS_;
    for (int idx = obid() * NT + tid; idx < ((nq + NT - 1) / NT) * NT * NH_; idx += gridDim.x * NT) {
      const int blk = idx / (NT * NH_), rem = idx % (NT * NH_), hh = rem / NT, row = blk * NT + rem % NT;
      if (row >= nq) continue;
      const bool isx = row < NTOK_; const int b = row_batch(row);
      const int nk = isx ? LK_ : LC_;
      unsigned q[QK_ / 2]; float o[HD_];
      { const unsigned* qp = (const unsigned*)(p.qb + ((size_t)row * NH_ + hh) * QK_);
#pragma unroll
        for (int e = 0; e < QK_ / 2; ++e) q[e] = qp[e]; }
#pragma unroll
      for (int e = 0; e < HD_; ++e) o[e] = 0.f;
      float m = -1e30f, lsum = 0.f;
      const bf16_t* kbase = p.kb + ((size_t)b * NH_ + hh) * LK_ * KLD_; const bf16_t* vbase = p.vb + ((size_t)b * NH_ + hh) * LK_ * HD_;
      for (int j = 0; j < nk; ++j) {
        float sdot = 0.f;
        const unsigned* kp = (const unsigned*)(kbase + (size_t)j * KLD_);
#pragma unroll
        for (int e = 0; e < QK_ / 2; ++e) { const unsigned kq = kp[e], qq = q[e];
          union { unsigned u; float f; } a0, a1, b0, b1; a0.u = qq << 16; a1.u = qq & 0xFFFF0000u; b0.u = kq << 16; b1.u = kq & 0xFFFF0000u;
          sdot += a0.f * b0.f + a1.f * b1.f; }
        if (sdot > m) { const float corr = expf(m - sdot); lsum *= corr;
#pragma unroll
          for (int e = 0; e < HD_; ++e) o[e] *= corr;
          m = sdot; }
        const float pj = expf(sdot - m); lsum += pj;
#pragma unroll
        for (int e = 0; e < HD_; ++e) o[e] += pj * bf2f(vbase[(size_t)j * HD_ + e]);
      }
      const float il = 1.0f / lsum;
#pragma unroll
      for (int e = 0; e < HD_; ++e) p.ob[(size_t)row * GWID_ + hh * HD_ + e] = o[e] * il;
    }
  }
}


#ifndef CPU_EMU
namespace fa {
using bf16x8 = __attribute__((ext_vector_type(8))) short;
using s16x4  = __attribute__((ext_vector_type(4))) short;
using f32x16 = __attribute__((ext_vector_type(16))) float;
using u32x4  = __attribute__((ext_vector_type(4))) unsigned;
constexpr int NW = 8, QBLK = 32, KVBLK = 64, ND0 = QK_ / 16, NDV = HD_ / 32;
constexpr float THR = 8.f;
constexpr int LDQ = NH_ * QK_, LDKK = KLD_, LDV = HD_, LDO = GWID_;
constexpr size_t SHM_V = KVBLK * HD_ * 2, SHM_K = KVBLK * KLD_ * 2, SHM_ATTN = 2 * SHM_V + 2 * SHM_K + NW * 64 * 4;
#define KSWZ(row, colB) ((row) * 256 + ((colB) ^ (((row) & 7) << 4)))
#define SBAR() __builtin_amdgcn_sched_barrier(0)
__device__ __forceinline__ int crow(int r, int hi) { return (r & 3) + 8 * (r >> 2) + 4 * hi; }
__device__ __forceinline__ unsigned cvtpk(float lo, float hi) { unsigned r; asm volatile("v_cvt_pk_bf16_f32 %0, %1, %2" : "=v"(r) : "v"(lo), "v"(hi)); return r; }
__device__ __forceinline__ void partialSM(f32x16& p0, f32x16& p1, float& m_reg, float& mn, float& alpha) {
  constexpr float C = 1.4426950408889634f;
  float pmax = p0[0];
#pragma unroll
  for (int r = 1; r < 16; ++r) pmax = fmaxf(pmax, p0[r]);
#pragma unroll
  for (int r = 0; r < 16; ++r) pmax = fmaxf(pmax, p1[r]);
  { auto rr = __builtin_amdgcn_permlane32_swap(__float_as_uint(pmax), __float_as_uint(pmax), false, false);
    pmax = fmaxf(__uint_as_float(rr[0]), __uint_as_float(rr[1])); }
  if (__builtin_expect(__all(pmax - m_reg <= THR), 1)) { mn = m_reg; alpha = 1.f; }
  else { mn = fmaxf(m_reg, pmax); alpha = __builtin_amdgcn_exp2f((m_reg - mn) * C); m_reg = mn; }
  const float mnC = -mn * C;
#pragma unroll
  for (int r = 0; r < 16; ++r) p0[r] = fmaf(p0[r], C, mnC);
#pragma unroll
  for (int r = 0; r < 16; ++r) p1[r] = fmaf(p1[r], C, mnC);
#pragma unroll
  for (int r = 0; r < 16; ++r) p0[r] = __builtin_amdgcn_exp2f(p0[r]);
}
__device__ __forceinline__ void finishSM(f32x16& p0, f32x16& p1, float alpha, float& l_reg, bf16x8& pa0, bf16x8& pa1, bf16x8& pa2, bf16x8& pa3) {
#pragma unroll
  for (int r = 0; r < 16; ++r) p1[r] = __builtin_amdgcn_exp2f(p1[r]);
  float ps = 0;
#pragma unroll
  for (int r = 0; r < 16; ++r) ps += p0[r];
#pragma unroll
  for (int r = 0; r < 16; ++r) ps += p1[r];
  { auto rr = __builtin_amdgcn_permlane32_swap(__float_as_uint(ps), __float_as_uint(ps), false, false);
    ps = __uint_as_float(rr[0]) + __uint_as_float(rr[1]); }
  l_reg = l_reg * alpha + ps;
#define PK4(P, BASE, OUT) do { unsigned a0 = cvtpk(P[BASE + 0], P[BASE + 1]), a1 = cvtpk(P[BASE + 2], P[BASE + 3]);   \
    unsigned b0 = cvtpk(P[BASE + 4], P[BASE + 5]), b1 = cvtpk(P[BASE + 6], P[BASE + 7]);                              \
    auto r0 = __builtin_amdgcn_permlane32_swap(a0, b0, false, false); auto r1 = __builtin_amdgcn_permlane32_swap(a1, b1, false, false); \
    u32x4 w = {r0[0], r1[0], r0[1], r1[1]}; OUT = *reinterpret_cast<bf16x8*>(&w); } while (0)
  PK4(p0, 0, pa0); PK4(p0, 8, pa1); PK4(p1, 0, pa2); PK4(p1, 8, pa3);
#undef PK4
}
__device__ __forceinline__ void qkt(f32x16& p0, f32x16& p1, const char* Ks, const bf16x8* qr, int r32, int hi) {
  p0 = f32x16{}; p1 = f32x16{};
#pragma unroll
  for (int d0 = 0; d0 < ND0; ++d0) { const int cb = (d0 * 16 + hi * 8) * 2;
    bf16x8 b0 = *reinterpret_cast<const bf16x8*>(Ks + KSWZ(r32, cb));
    bf16x8 b1 = *reinterpret_cast<const bf16x8*>(Ks + KSWZ(32 + r32, cb));
    p0 = __builtin_amdgcn_mfma_f32_32x32x16_bf16(b0, qr[d0], p0, 0, 0, 0);
    p1 = __builtin_amdgcn_mfma_f32_32x32x16_bf16(b1, qr[d0], p1, 0, 0, 0); }
}
__device__ __forceinline__ int v_st(int k, int c) { const int kk = (k & ~0xC) | ((k & 4) << 1) | ((k & 8) >> 1); return ((kk >> 3) * NDV + (c >> 5)) * 512 + ((kk & 7) * 32 + (c & 31)) * 2; }
__device__ __forceinline__ int v_rd_base(int lane) { return ((lane & 3) << 3) | (((lane >> 2) & 3) << 6) | (((lane >> 4) & 1) << 5) | (((lane >> 5) & 1) << 8); }
constexpr int v_rd_off(int d0, int ks, int half) { return d0 * 512 + ks * (2 * NDV * 512) + half * (NDV * 512); }
template <int OFF> __device__ __forceinline__ s16x4 tr_read(int vb) { s16x4 r; asm volatile("ds_read_b64_tr_b16 %0, %1 offset:%2" : "=&v"(r) : "v"(vb), "i"(OFF) : "memory"); return r; }
template <int D0> __device__ __forceinline__ void pv_one(f32x16& od, int vb, bf16x8 pa0, bf16x8 pa1, bf16x8 pa2, bf16x8 pa3) {
  const s16x4 l0 = tr_read<v_rd_off(D0, 0, 0)>(vb), h0 = tr_read<v_rd_off(D0, 0, 1)>(vb), l1 = tr_read<v_rd_off(D0, 1, 0)>(vb), h1 = tr_read<v_rd_off(D0, 1, 1)>(vb);
  const s16x4 l2 = tr_read<v_rd_off(D0, 2, 0)>(vb), h2 = tr_read<v_rd_off(D0, 2, 1)>(vb), l3 = tr_read<v_rd_off(D0, 3, 0)>(vb), h3 = tr_read<v_rd_off(D0, 3, 1)>(vb);
  asm volatile("s_waitcnt lgkmcnt(0)" ::: "memory"); SBAR();
#define PK(L, H) (bf16x8){L[0], L[1], L[2], L[3], H[0], H[1], H[2], H[3]}
  od = __builtin_amdgcn_mfma_f32_32x32x16_bf16(pa0, PK(l0, h0), od, 0, 0, 0);
  od = __builtin_amdgcn_mfma_f32_32x32x16_bf16(pa1, PK(l1, h1), od, 0, 0, 0);
  od = __builtin_amdgcn_mfma_f32_32x32x16_bf16(pa2, PK(l2, h2), od, 0, 0, 0);
  od = __builtin_amdgcn_mfma_f32_32x32x16_bf16(pa3, PK(l3, h3), od, 0, 0, 0);
#undef PK
}
__device__ __forceinline__ void pv_d0(f32x16* o, int vb, bf16x8 pa0, bf16x8 pa1, bf16x8 pa2, bf16x8 pa3) {
  pv_one<0>(o[0], vb, pa0, pa1, pa2, pa3); pv_one<1>(o[1], vb, pa0, pa1, pa2, pa3);
}
__device__ __forceinline__ void attn_body(const bf16_t* __restrict__ Qb, const bf16_t* __restrict__ Kh, const bf16_t* __restrict__ Vh, float* __restrict__ Ob, int seq, char* lds) {
  const int tid = otid(), wid = tid >> 6, lane = tid & 63, r32 = lane & 31, hi = lane >> 5;
  char* V_lds = lds; char* K_lds = lds + 2 * SHM_V;
  float* ws = (float*)(lds + 2 * SHM_V + 2 * SHM_K) + wid * 64; float* li_l = ws; float* al_l = ws + 32;
  float m_reg = -1e30f, l_reg = 0; f32x16 o[NDV] = {}; bf16x8 qr[ND0];
  const bf16_t* Qw = Qb + (long)(wid * QBLK + r32) * LDQ + hi * 8;
#pragma unroll
  for (int d0 = 0; d0 < ND0; ++d0) qr[d0] = *reinterpret_cast<const bf16x8*>(Qw + d0 * 16);
  const int sr = tid >> 4, sc = (tid & 15) * 8;
  const int vr = tid >> 3, vc = (tid & 7) * 8, vst0 = v_st(vr, vc);
  const int vb0 = (int)(uintptr_t)V_lds + v_rd_base(lane);
  struct { bf16x8 vs0, ks0, ks1; } sr_[2];
#define SLOAD(i, k0) do { sr_[i].vs0 = *reinterpret_cast<const bf16x8*>(&Vh[(long)((k0) + vr) * LDV + vc]); \
    sr_[i].ks0 = *reinterpret_cast<const bf16x8*>(&Kh[(long)((k0) + sr) * LDKK + sc]); sr_[i].ks1 = *reinterpret_cast<const bf16x8*>(&Kh[(long)((k0) + 32 + sr) * LDKK + sc]); } while (0)
#define SWRITE(b, i) do { *(bf16x8*)(V_lds + (b) * SHM_V + vst0) = sr_[i].vs0; const int kc = sc * 2;               \
    *(bf16x8*)(K_lds + (b) * SHM_K + KSWZ(sr, kc)) = sr_[i].ks0;                       \
    *(bf16x8*)(K_lds + (b) * SHM_K + KSWZ(32 + sr, kc)) = sr_[i].ks1; } while (0)
#define SWAIT() asm volatile("s_waitcnt vmcnt(3)" ::: "memory")
#define RESC(a) do { if (__any((a) < 1.f)) { if (hi == 0) al_l[r32] = (a); asm volatile("s_waitcnt lgkmcnt(0)" ::: "memory"); \
    _Pragma("unroll") for (int d = 0; d < NDV; ++d) _Pragma("unroll") for (int r = 0; r < 16; ++r) o[d][r] *= al_l[crow(r, hi)]; } } while (0)
  f32x16 pA0, pA1, pB0, pB1; float mnA, mnB, alA, alB; bf16x8 pa0, pa1, pa2, pa3; const int NTL = seq / KVBLK;
  constexpr int SE = 0, SO = 1;
  SLOAD(SE, 0); asm volatile("s_waitcnt vmcnt(0)" ::: "memory"); SWRITE(0, SE); __syncthreads();
  qkt(pA0, pA1, K_lds, qr, r32, hi); partialSM(pA0, pA1, m_reg, mnA, alA);
  SLOAD(SO, KVBLK); if (2 < NTL) SLOAD(SE, 2 * KVBLK);
  SWAIT(); SWRITE(1, SO); __syncthreads();
  for (int j = 1; j + 1 < NTL; j += 2) {
    SBAR(); qkt(pB0, pB1, K_lds + SHM_K, qr, r32, hi);
    finishSM(pA0, pA1, alA, l_reg, pa0, pa1, pa2, pa3); SBAR();
    SLOAD(SO, (j + 2) * KVBLK); SBAR();
    pv_d0(o, vb0, pa0, pa1, pa2, pa3); partialSM(pB0, pB1, m_reg, mnB, alB);
    __syncthreads(); SWAIT(); SWRITE(0, SE);
    RESC(alB); __syncthreads();
    SBAR(); qkt(pA0, pA1, K_lds, qr, r32, hi);
    finishSM(pB0, pB1, alB, l_reg, pa0, pa1, pa2, pa3); SBAR();
    if (j + 3 < NTL) SLOAD(SE, (j + 3) * KVBLK); SBAR();
    pv_d0(o, vb0 + (int)SHM_V, pa0, pa1, pa2, pa3); partialSM(pA0, pA1, m_reg, mnA, alA);
    __syncthreads(); SWAIT(); SWRITE(1, SO);
    RESC(alA); __syncthreads();
  }
  SBAR(); qkt(pB0, pB1, K_lds + SHM_K, qr, r32, hi);
  finishSM(pA0, pA1, alA, l_reg, pa0, pa1, pa2, pa3); SBAR();
  pv_d0(o, vb0, pa0, pa1, pa2, pa3); partialSM(pB0, pB1, m_reg, mnB, alB);
  __syncthreads(); RESC(alB);
  finishSM(pB0, pB1, alB, l_reg, pa0, pa1, pa2, pa3); SBAR();
  pv_d0(o, vb0 + (int)SHM_V, pa0, pa1, pa2, pa3);
  if (hi == 0) li_l[r32] = l_reg; asm volatile("s_waitcnt lgkmcnt(0)" ::: "memory");
  float rli[16];
#pragma unroll
  for (int r = 0; r < 16; ++r) rli[r] = __builtin_amdgcn_rcpf(li_l[crow(r, hi)]);
  float* Ow = Ob + (long)(wid * QBLK) * LDO;
#pragma unroll
  for (int r = 0; r < 16; ++r) { const int orow = crow(r, hi);
#pragma unroll
    for (int d0 = 0; d0 < NDV; ++d0) Ow[(long)orow * LDO + d0 * 32 + r32] = o[d0][r] * rli[r]; }
#undef SLOAD
#undef SWRITE
#undef SWAIT
#undef RESC
}
}

__device__ __forceinline__ void phase_attn(const Params& p, int l) {
  const bool last = (l == DEPTH_ - 1);
  const int c = obid(), G = gridDim.x;
  const int nx = B_ * NH_ * (L_ / 256), nc = last ? 0 : B_ * NH_ * (LC_ / 256);
  char* lds = (char*)SMEM_PTR();
  for (int i = 0; i * G + c < nx + nc; ++i) {
    const int u = i * G + c;
    int b, hh, r0, seq;
    if (u < nx) {
      int pair, qb;
      if (G == 256) { pair = i * 16 + 2 * (c & 7) + ((c >> 3) >> 4); qb = (c >> 3) & 15; } else { pair = u / (L_ / 256); qb = u % (L_ / 256); }
      b = pair / NH_; hh = pair % NH_; r0 = b * L_ + qb * 256; seq = LK_;
    } else { const int v = u - nx; hh = v % NH_; b = v / NH_; r0 = NTOK_ + b * LC_; seq = LC_; }
    __syncthreads();
    fa::attn_body(p.qb + ((size_t)r0 * NH_ + hh) * QK_, p.kb + ((size_t)b * NH_ + hh) * LK_ * KLD_, p.vb + ((size_t)b * NH_ + hh) * LK_ * HD_, p.ob + (size_t)r0 * GWID_ + hh * HD_, seq, lds);
  }
  __syncthreads();
}
#endif


#ifndef CPU_EMU
namespace sc {
typedef float f2 __attribute__((ext_vector_type(2)));
typedef float f4 __attribute__((ext_vector_type(4)));
constexpr int CH = 32, NCHK = LK_ / CH, VECB = CH * HD_ * 4, VOFF = 5 * VECB, BUFB = VOFF + CH * 16 * 4;
static_assert(3 * BUFB <= XBW_OFF_, "scan ring fits LDS");
template <int CTRL> __device__ __forceinline__ float dpp_add(float v) {
  return v + __builtin_bit_cast(float, __builtin_amdgcn_update_dpp(0, __builtin_bit_cast(int, v), CTRL, 0xF, 0xF, true));
}
__device__ __forceinline__ float allreduce16(float v) { v = dpp_add<0xB1>(v); v = dpp_add<0x4E>(v); v = dpp_add<0x141>(v); v = dpp_add<0x140>(v); return v; }
__device__ __forceinline__ int step_row(int s, int b, int d) {
  if (d == 0) return s < LC_ ? NTOK_ + b * LC_ + s : b * L_ + (s - LC_);
  return s < LC_ ? NTOK_ + b * LC_ + (LC_ - 1 - s) : b * L_ + (L_ - 1 - (s - LC_));
}
struct In { f4 kk, kka, w, kt, r; float v; };
}
__device__ __forceinline__ void phase_scan(const Params& p, int l, LAS unsigned char* lds) {
  using namespace sc;
  const int tid = otid(), wid = __builtin_amdgcn_readfirstlane(tid >> 6), lane = tid & 63;
  const int G = gridDim.x;
  for (int u = obid(); u < B_ * NH_ * 2 * 4; u += G) {
    const int rg = (u >> 3) & 3, pi = (u & 7) + 8 * (u >> 5), d = pi & 1, hh = (pi >> 1) % NH_, b = pi / (2 * NH_);
    __syncthreads();
    if (wid >= 4) {
      const int lw = wid - 4;
      const size_t doff = (size_t)d * NROWS_ * GWID_;
      const float* b0 = p.sc_kk + hh * HD_ + (lane & 15) * 4;
      const float* b1 = p.sc_kka + doff + hh * HD_ + (lane & 15) * 4;
      const float* b2 = p.sc_w + doff + hh * HD_ + (lane & 15) * 4;
      const float* b3 = p.sc_kt + doff + hh * HD_ + (lane & 15) * 4;
      const float* b4 = p.sc_r + hh * HD_ + (lane & 15) * 4;
      const float* bv = p.sc_v + hh * HD_ + rg * 16 + (lane & 3) * 4;
#define SC_ISSUE(chunk) do { const int _ck = (chunk); LAS unsigned char* _buf = lds + (_ck % 3) * BUFB; \
        _Pragma("unroll") for (int k = 0; k < 10; ++k) { const int tg = (k & 1) * 4 + lw; const int srow = step_row(_ck * CH + tg * 4 + (lane >> 4), b, d); \
          const float* bp = (k >> 1) == 0 ? b0 : (k >> 1) == 1 ? b1 : (k >> 1) == 2 ? b2 : (k >> 1) == 3 ? b3 : b4; \
          __builtin_amdgcn_global_load_lds((const unsigned*)(bp + (size_t)srow * GWID_), (LAS unsigned*)(_buf + (k >> 1) * VECB + tg * 1024), 16, 0, 0); } \
        if (lw < 2) { const int srow = step_row(_ck * CH + lw * 16 + (lane >> 2), b, d); \
          __builtin_amdgcn_global_load_lds((const unsigned*)(bv + (size_t)srow * GWID_), (LAS unsigned*)(_buf + VOFF + lw * 1024), 16, 0, 0); } } while (0)
#define SC_WAITK() do { if (lw < 2) asm volatile("s_waitcnt vmcnt(11)" ::: "memory"); else asm volatile("s_waitcnt vmcnt(10)" ::: "memory"); } while (0)
      SC_ISSUE(0); SC_ISSUE(1);
      SC_WAITK();
      __builtin_amdgcn_s_barrier();
      constexpr int CVT_TOTAL = 3 * NEXP_ * (D_ / 64) * (D_ / 32);
      const int need = (u == obid()) ? (CVT_TOTAL + 4 * G - 1) / (4 * G) : 0;
      cvt_f32x4 rcur[8], rnew[8];
#pragma unroll
      for (int j = 0; j < 8; ++j) { rcur[j] = (cvt_f32x4){0.f, 0.f, 0.f, 0.f}; rnew[j] = rcur[j]; }
      for (int ck = 0; ck < NCHK; ++ck) {
        const bool dma = ck + 2 < NCHK;
        const int tnew = (ck * 4 + lw) * G + obid(), tcur = ((ck - 1) * 4 + lw) * G + obid();
        const bool ldn = ck < need && tnew < CVT_TOTAL, stc = ck >= 1 && ck <= need && tcur < CVT_TOTAL;
        if (dma) SC_ISSUE(ck + 2);
        if (ldn) cvt_moe_tile_load(p, l, tnew, lane, rnew);
        if (dma && ldn) { if (lw < 2) asm volatile("s_waitcnt vmcnt(19)" ::: "memory"); else asm volatile("s_waitcnt vmcnt(18)" ::: "memory"); }
        else if (dma) SC_WAITK();
        else asm volatile("s_waitcnt vmcnt(0)" ::: "memory");
        if (stc) cvt_moe_tile_store(p, tcur, lane, rcur);
#pragma unroll
        for (int j = 0; j < 8; ++j) rcur[j] = rnew[j];
        __builtin_amdgcn_s_barrier();
      }
#undef SC_ISSUE
#undef SC_WAITK
    } else {
      const int seg = lane & 15, rowl = wid * 4 + (lane >> 4);
      f2 s01 = {0.f, 0.f}, s23 = {0.f, 0.f};
      float* yb = p.ys + (size_t)d * NROWS_ * GWID_ + hh * HD_ + rg * 16 + rowl;
      __builtin_amdgcn_s_barrier();
      for (int ck = 0; ck < NCHK; ++ck) {
        const LAS unsigned char* buf = lds + (ck % 3) * BUFB;
        const LAS unsigned char* vb = buf + seg * 16;
        const LAS unsigned char* vv = buf + VOFF + rowl * 4;
        const int row0 = step_row(ck * CH, b, d);
        const long rstep = d == 0 ? (long)GWID_ : -(long)GWID_;
        float* yp = yb + (size_t)row0 * GWID_;
        In in[3]; float ykeep = 0.f, ypend = 0.f;
#define SC_LOAD(dst, t) do { dst.kk = *(const LAS f4*)(vb + 0 * VECB + (t) * 256); dst.kka = *(const LAS f4*)(vb + 1 * VECB + (t) * 256); dst.w = *(const LAS f4*)(vb + 2 * VECB + (t) * 256); \
          dst.kt = *(const LAS f4*)(vb + 3 * VECB + (t) * 256); dst.r = *(const LAS f4*)(vb + 4 * VECB + (t) * 256); dst.v = *(const LAS float*)(vv + (t) * 64); } while (0)
#define SC_YDONE(tt) do { const float _yy = allreduce16(ypend); ykeep = (seg == ((tt) & 15)) ? _yy : ykeep; \
          if (((tt) & 15) == 15) yp[(long)(((tt) & ~15) + seg) * rstep] = ykeep; } while (0)
        SC_LOAD(in[0], 0); SC_LOAD(in[1], 1);
#pragma unroll
        for (int t = 0; t < CH; ++t) {
          if (t + 2 < CH) SC_LOAD(in[(t + 2) % 3], t + 2);
          __builtin_amdgcn_sched_barrier(0);
          const In& x = in[t % 3];
          f2 p2 = s01 * (f2){x.kk[0], x.kk[1]}; p2 = s23 * (f2){x.kk[2], x.kk[3]} + p2;
          const float sa = allreduce16(p2[0] + p2[1]);
          if (t > 0) SC_YDONE(t - 1);
          const f2 vv2 = {x.v, x.v};
          s01 = s01 * (f2){x.w[0], x.w[1]} + vv2 * (f2){x.kt[0], x.kt[1]};
          s23 = s23 * (f2){x.w[2], x.w[3]} + vv2 * (f2){x.kt[2], x.kt[3]};
          const f2 nsa = {-sa, -sa};
          s01 = nsa * (f2){x.kka[0], x.kka[1]} + s01;
          s23 = nsa * (f2){x.kka[2], x.kka[3]} + s23;
          f2 y2 = s01 * (f2){x.r[0], x.r[1]}; y2 = s23 * (f2){x.r[2], x.r[3]} + y2;
          ypend = y2[0] + y2[1];
          __builtin_amdgcn_sched_barrier(0);
        }
        SC_YDONE(CH - 1);
#undef SC_YDONE
#undef SC_LOAD
        __builtin_amdgcn_s_barrier();
      }
    }
  }
  __syncthreads();
}
#endif


#ifndef CPU_EMU
namespace rt {
typedef short bf16x8 __attribute__((ext_vector_type(8)));
typedef float f32x4 __attribute__((ext_vector_type(4)));
typedef unsigned u32x4 __attribute__((ext_vector_type(4)));
typedef unsigned u32x2 __attribute__((ext_vector_type(2)));
constexpr int QS = 72, TS = 136;
__device__ __forceinline__ f32x4 mm(bf16x8 a, bf16x8 b, f32x4 c) { return __builtin_amdgcn_mfma_f32_16x16x32_bf16(a, b, c, 0, 0, 0); }
__device__ __forceinline__ float lg2_gamma(int hh) { return __builtin_amdgcn_logf(1.0f - __builtin_amdgcn_exp2f(-5.0f - (float)hh)); }
__device__ __forceinline__ unsigned pkbf(float a, float b) { unsigned r; asm volatile("v_cvt_pk_bf16_f32 %0, %1, %2" : "=v"(r) : "v"(a), "v"(b)); return r; }
}
__device__ __forceinline__ void phase_retA_mfma(const Params& p, LAS unsigned char* lds) {
  using namespace rt;
  const int tid = otid(), wid = tid >> 6, lane = tid & 63, fr = lane & 15, fq = lane >> 4;
  LAS bf16_t* Kf = (LAS bf16_t*)lds; LAS bf16_t* Kb = Kf + 64 * TS; LAS bf16_t* Vt = Kb + 64 * TS;
  for (int u = obid(); u < B_ * NH_ * NCH_; u += gridDim.x) {
    const int n = u % NCH_, hh = (u / NCH_) % NH_, b = u / (NCH_ * NH_);
    const int r0 = chunk_row0(b, n);
    const float lg2 = lg2_gamma(hh);
    __syncthreads();
    {
      const int tok = tid >> 2, part = tid & 3;
      const bf16_t* kp = p.rk + (size_t)(r0 + tok) * GWID_ + hh * HD_ + 16 * part; const bf16_t* vp = p.rv + (size_t)(r0 + tok) * GWID_ + hh * HD_ + 16 * part;
      const u32x4 k0 = *(const u32x4*)kp, k1 = *(const u32x4*)(kp + 8), v0 = *(const u32x4*)vp, v1 = *(const u32x4*)(vp + 8);
      const unsigned kw[8] = {k0.x, k0.y, k0.z, k0.w, k1.x, k1.y, k1.z, k1.w}, vw[8] = {v0.x, v0.y, v0.z, v0.w, v1.x, v1.y, v1.z, v1.w};
      const float zf = __builtin_amdgcn_exp2f((float)(RCH_ - 1 - tok) * lg2), zb = __builtin_amdgcn_exp2f((float)tok * lg2);
#pragma unroll
      for (int j = 0; j < 8; ++j) {
        const float ka = __uint_as_float(kw[j] << 16), kc = __uint_as_float(kw[j] & 0xFFFF0000u);
        const unsigned f = pkbf(ka * zf, kc * zf), g = pkbf(ka * zb, kc * zb);
        const int dd = 16 * part + 2 * j;
        Kf[dd * TS + tok] = (bf16_t)(f & 0xFFFFu); Kf[(dd + 1) * TS + tok] = (bf16_t)(f >> 16);
        Kb[dd * TS + tok] = (bf16_t)(g & 0xFFFFu); Kb[(dd + 1) * TS + tok] = (bf16_t)(g >> 16);
        Vt[dd * TS + tok] = (bf16_t)(vw[j] & 0xFFFFu); Vt[(dd + 1) * TS + tok] = (bf16_t)(vw[j] >> 16);
      }
    }
    __syncthreads();
    {
      const int d = wid >> 2, kt = wid & 3;
      const LAS bf16_t* Kd = d == 0 ? Kf : Kb;
      f32x4 acc[4];
#pragma unroll
      for (int vt = 0; vt < 4; ++vt) acc[vt] = (f32x4){0.f, 0.f, 0.f, 0.f};
#pragma unroll
      for (int ts = 0; ts < 4; ++ts) {
        const bf16x8 kfr = *(const LAS bf16x8*)(Kd + (16 * kt + fr) * TS + 32 * ts + 8 * fq);
#pragma unroll
        for (int vt = 0; vt < 4; ++vt) { const bf16x8 vfr = *(const LAS bf16x8*)(Vt + (16 * vt + fr) * TS + 32 * ts + 8 * fq); acc[vt] = mm(kfr, vfr, acc[vt]); }
      }
      float* o = p.rd + ((((size_t)b * NH_ + hh) * NCH_ + n) * 2 + d) * HD_ * HD_;
#pragma unroll
      for (int vt = 0; vt < 4; ++vt) *(f32x4*)(o + (16 * vt + fr) * HD_ + 16 * kt + 4 * fq) = acc[vt];
    }
  }
  __syncthreads();
}
__device__ __forceinline__ void phase_retB_mfma(const Params& p, int l, LAS unsigned char* lds) {
  using namespace rt;
  const int tid = otid(), wid = tid >> 6, lane = tid & 63, fr = lane & 15, fq = lane >> 4;
  const bool last = (l == DEPTH_ - 1);
  LAS bf16_t* Qs = (LAS bf16_t*)lds; LAS bf16_t* Ks = Qs + 128 * QS; LAS bf16_t* Vt = Ks + 128 * QS; LAS bf16_t* Rt = Vt + 64 * TS; LAS bf16_t* Ss = Rt + 2 * 64 * QS + wid * 16 * TS;
  const bf16_t* rs16 = (const bf16_t*)p.rs;
  for (int u = obid(); u < B_ * NH_ * NCH_; u += gridDim.x) {
    const int n = u % NCH_, hh = (u / NCH_) % NH_, b = u / (NCH_ * NH_);
    if (last && n < NCC_) continue;
    const int r0 = chunk_row0(b, n);
    const float lg2 = lg2_gamma(hh);
    __syncthreads();
    {
      const int tok = tid >> 2, part = tid & 3;
      const size_t go = (size_t)(r0 + tok) * GWID_ + hh * HD_ + 16 * part;
      const u32x4 q0 = *(const u32x4*)(p.rq + go), q1 = *(const u32x4*)(p.rq + go + 8), k0 = *(const u32x4*)(p.rk + go), k1 = *(const u32x4*)(p.rk + go + 8);
      const u32x4 v0 = *(const u32x4*)(p.rv + go), v1 = *(const u32x4*)(p.rv + go + 8);
      *(LAS u32x4*)(Qs + tok * QS + 16 * part) = q0; *(LAS u32x4*)(Qs + tok * QS + 16 * part + 8) = q1;
      *(LAS u32x4*)(Ks + tok * QS + 16 * part) = k0; *(LAS u32x4*)(Ks + tok * QS + 16 * part + 8) = k1;
      const unsigned vw[8] = {v0.x, v0.y, v0.z, v0.w, v1.x, v1.y, v1.z, v1.w};
#pragma unroll
      for (int j = 0; j < 8; ++j) { const int dd = 16 * part + 2 * j; Vt[dd * TS + tok] = (bf16_t)(vw[j] & 0xFFFFu); Vt[(dd + 1) * TS + tok] = (bf16_t)(vw[j] >> 16); }
      const int vi = tid >> 3, k0i = (tid & 7) * 8;
#pragma unroll
      for (int d = 0; d < 2; ++d) {
        const u32x4 rr = *(const u32x4*)(rs16 + ((((size_t)b * NH_ + hh) * NCH_ + n) * 2 + d) * HD_ * HD_ + vi * HD_ + k0i);
        *(LAS u32x4*)(Rt + d * 64 * QS + vi * QS + k0i) = rr;
      }
    }
    __syncthreads();
    const int i0 = 16 * wid, qpos = i0 + fr;
    bf16x8 qf[2];
#pragma unroll
    for (int kc = 0; kc < 2; ++kc) qf[kc] = *(const LAS bf16x8*)(Qs + (i0 + fr) * QS + 32 * kc + 8 * fq);
#pragma unroll
    for (int nt = 0; nt < 8; ++nt) {
      f32x4 sacc = (f32x4){0.f, 0.f, 0.f, 0.f};
#pragma unroll
      for (int kc = 0; kc < 2; ++kc) { const bf16x8 kf = *(const LAS bf16x8*)(Ks + (16 * nt + fr) * QS + 32 * kc + 8 * fq); sacc = mm(kf, qf[kc], sacc); }
      float sv[4];
#pragma unroll
      for (int t = 0; t < 4; ++t) { const int key = 16 * nt + 4 * fq + t; const int dist = qpos > key ? qpos - key : key - qpos; sv[t] = sacc[t] * __builtin_amdgcn_exp2f((float)dist * lg2); }
      u32x2 w; w.x = pkbf(sv[0], sv[1]); w.y = pkbf(sv[2], sv[3]);
      *(LAS u32x2*)(Ss + fr * TS + 16 * nt + 4 * fq) = w;
    }
    f32x4 yv[4], tf[4], tb[4];
#pragma unroll
    for (int vt = 0; vt < 4; ++vt) { yv[vt] = (f32x4){0.f, 0.f, 0.f, 0.f}; tf[vt] = yv[vt]; tb[vt] = yv[vt]; }
#pragma unroll
    for (int ks = 0; ks < 4; ++ks) {
      const bf16x8 sf = *(const LAS bf16x8*)(Ss + fr * TS + 32 * ks + 8 * fq);
#pragma unroll
      for (int vt = 0; vt < 4; ++vt) { const bf16x8 vf = *(const LAS bf16x8*)(Vt + (16 * vt + fr) * TS + 32 * ks + 8 * fq); yv[vt] = mm(vf, sf, yv[vt]); }
    }
#pragma unroll
    for (int kc = 0; kc < 2; ++kc)
#pragma unroll
      for (int vt = 0; vt < 4; ++vt) {
        const bf16x8 rf = *(const LAS bf16x8*)(Rt + (16 * vt + fr) * QS + 32 * kc + 8 * fq), rb = *(const LAS bf16x8*)(Rt + 64 * QS + (16 * vt + fr) * QS + 32 * kc + 8 * fq);
        tf[vt] = mm(rf, qf[kc], tf[vt]); tb[vt] = mm(rb, qf[kc], tb[vt]);
      }
    const float xf = __builtin_amdgcn_exp2f((float)(qpos + 1) * lg2), xb = __builtin_amdgcn_exp2f((float)(RCH_ - qpos) * lg2);
    float ss = 0.f;
#pragma unroll
    for (int vt = 0; vt < 4; ++vt)
#pragma unroll
      for (int t = 0; t < 4; ++t) { const float v = yv[vt][t] + xf * tf[vt][t] + xb * tb[vt][t]; yv[vt][t] = v; ss += v * v; }
    ss += __shfl_xor(ss, 16); ss += __shfl_xor(ss, 32);
    const float rstd = rsqrtf(ss * (1.0f / (float)HD_) + 1e-6f);
    const int row = r0 + qpos;
    f32x4 gv[4]; u32x2 rgv[4];
#pragma unroll
    for (int vt = 0; vt < 4; ++vt) { const int ch = hh * HD_ + 16 * vt + 4 * fq; gv[vt] = *(const f32x4*)(p.g_ret_norm + (size_t)l * GWID_ + ch); rgv[vt] = *(const u32x2*)(p.rg + (size_t)row * GWID_ + ch); }
#pragma unroll
    for (int vt = 0; vt < 4; ++vt) {
      const int ch = hh * HD_ + 16 * vt + 4 * fq;
      const f32x4 g = gv[vt]; const u32x2 rgw = rgv[vt];
      const float o0 = yv[vt][0] * rstd * g[0] * __uint_as_float(rgw.x << 16), o1 = yv[vt][1] * rstd * g[1] * __uint_as_float(rgw.x & 0xFFFF0000u);
      const float o2 = yv[vt][2] * rstd * g[2] * __uint_as_float(rgw.y << 16), o3 = yv[vt][3] * rstd * g[3] * __uint_as_float(rgw.y & 0xFFFF0000u);
      u32x2 w; w.x = pkbf(o0, o1); w.y = pkbf(o2, o3);
      *(u32x2*)(p.y + (size_t)row * D_ + 3 * GWID_ + ch) = w;
    }
  }
  __syncthreads();
}
#endif

template <bool WITH_RET> __device__ __forceinline__ void phase_post(const Params& p, int l) {
  float (*sm)[RCH_ + 2 * HD_] = (float (*)[RCH_ + 2 * HD_])SMEM_PTR();
  const int tid = otid(), wave = tid >> 6, lane = tid & 63;
  float* ws = sm[wave];
  const bool last = (l == DEPTH_ - 1);
  const int nrow = last ? NTOK_ : NROWS_;
  for (int row = obid() * NWAVE + wave; row < nrow; row += gridDim.x * NWAVE) {
    const int pos = row_pos(row), b = row_batch(row); const bool isx = row < NTOK_;
    {
      float t[GWID_ / 64]; float ss = 0.f;
#pragma unroll
      for (int i = 0; i < GWID_ / 64; ++i) { t[i] = p.ob[(size_t)row * GWID_ + i * 64 + lane]; ss += t[i] * t[i]; }
      ss = wave_sum(ss); const float rstd = rsqrtf(ss / (float)GWID_ + 1e-6f);
#pragma unroll
      for (int i = 0; i < GWID_ / 64; ++i) p.y[(size_t)row * D_ + GWID_ + i * 64 + lane] = f2bf(t[i] * rstd * p.g_out_mla[l * GWID_ + i * 64 + lane]);
    }
    {
#pragma unroll
      for (int i = 0; i < GWID_ / 64; ++i) {
        const int ch = i * 64 + lane; const size_t o = (size_t)row * GWID_ + ch;
        const float yv = p.ys[o] + p.ys[(size_t)NROWS_ * GWID_ + o];
        float s1 = yv;
        for (int m = 1; m < HD_ && m < 64; m <<= 1) s1 += __shfl_xor(s1, m);
        const float mean = s1 / (float)HD_;
        const float dv = yv - mean; float s2 = dv * dv;
        for (int m = 1; m < HD_ && m < 64; m <<= 1) s2 += __shfl_xor(s2, m);
        const float var = s2 / (float)HD_;
        float r = dv * rsqrtf(var + 64e-5f) * p.g_ln_x[l * GWID_ + ch];
        r += (p.sc_bonus[(size_t)row * NH_ + ch / HD_] + p.sc_bonus[(size_t)(NROWS_ + row) * NH_ + ch / HD_]) * p.sc_v[o];
        p.y[(size_t)row * D_ + 2 * GWID_ + ch] = f2bf(r * p.sc_gate[o]);
      }
    }
    if (WITH_RET) {
      const int n = isx ? NCC_ + pos / RCH_ : pos / RCH_, c = pos % RCH_;
      const int r0 = chunk_row0(b, n);
      for (int hh = 0; hh < NH_; ++hh) {
        const float lg = ret_lg(hh);
        for (int j = lane; j < RCH_; j += 64) {
          float sdot = 0.f;
          for (int e = 0; e < HD_; ++e) sdot += bf2f(p.rq[(size_t)row * GWID_ + hh * HD_ + e]) * bf2f(p.rk[(size_t)(r0 + j) * GWID_ + hh * HD_ + e]);
          const int dist = c > j ? c - j : j - c;
          ws[j] = sdot * expf((float)dist * lg);
        }
        for (int e = lane; e < HD_; e += 64) ws[RCH_ + e] = bf2f(p.rq[(size_t)row * GWID_ + hh * HD_ + e]);
        __builtin_amdgcn_wave_barrier();
        float yv = 0.f;
        const int vc = lane % HD_;
        for (int j = 0; j < RCH_; ++j) yv += ws[j] * bf2f(p.rv[(size_t)(r0 + j) * GWID_ + hh * HD_ + vc]);
        const float xf = expf((float)(c + 1) * lg), xb = expf((float)(RCH_ - c) * lg);
        const float* sf = p.rs + ((((size_t)b * NH_ + hh) * NCH_ + n) * 2 + 0) * HD_ * HD_;
        const float* sb = sf + HD_ * HD_;
        float cf = 0.f, cb = 0.f;
        for (int k = 0; k < HD_; ++k) { const float qk = ws[RCH_ + k]; cf += qk * sf[k * HD_ + vc]; cb += qk * sb[k * HD_ + vc]; }
        yv += xf * cf + xb * cb;
        float s2 = yv * yv;
        for (int m = 1; m < HD_ && m < 64; m <<= 1) s2 += __shfl_xor(s2, m);
        const float rstd = rsqrtf(s2 / (float)HD_ + 1e-6f);
        const int ch = hh * HD_ + vc;
#ifdef HAVE_PREPA
        const float sg = bf2f(p.rg[(size_t)row * GWID_ + ch]);
#else
        const float sg = siluf_(bf2f(p.z[(size_t)row * ZLD_ + RT0_ + 3 * GWID_ + ch]));
#endif
        if (lane < HD_) p.y[(size_t)row * D_ + 3 * GWID_ + ch] = f2bf(sg * yv * rstd * p.g_ret_norm[l * GWID_ + ch]);
        __builtin_amdgcn_wave_barrier();
      }
    }
  }
}

__device__ __forceinline__ void phase_topk(const Params& p, int l) {
  unsigned* vals = (unsigned*)SMEM_PTR();
  int* hist = (int*)(vals + (L_ > LC_ ? L_ : LC_));
  int* scan_gt = hist + 256; int* scan_eq = scan_gt + NT + 1;
  unsigned& s_prefix = *(unsigned*)(scan_eq + NT + 1); int& s_need = *(scan_eq + NT + 2);
  const int tid = otid();
  const bool last = (l == DEPTH_ - 1);
  const int nunits = (last ? B_ : 2 * B_) * NEXP_;
  for (int u = obid(); u < nunits; u += gridDim.x) {
    const int e = u % NEXP_, set = u / NEXP_; const bool isx = set < B_; const int b = isx ? set : set - B_;
    const int N = isx ? L_ : LC_, cap = isx ? CAP_ : CAPC_;
    const int row0 = isx ? b * L_ : NTOK_ + b * LC_;
    __syncthreads();
    for (int i = tid; i < N; i += NT) { union { float f; unsigned u; } x; x.f = p.aff[(size_t)(row0 + i) * NEXP_ + e]; vals[i] = x.u; }
    if (tid == 0) { s_prefix = 0u; s_need = cap; }
    __syncthreads();
    for (int pass = 0; pass < 4; ++pass) {
      const int shift = 24 - 8 * pass;
      for (int i = tid; i < 256; i += NT) hist[i] = 0;
      __syncthreads();
      const unsigned prefix = s_prefix; const unsigned himask = pass == 0 ? 0u : (0xFFFFFFFFu << (shift + 8));
      for (int i = tid; i < N; i += NT) { const unsigned v = vals[i]; if ((v & himask) == prefix) atomicAdd(&hist[(v >> shift) & 255], 1); }
      __syncthreads();
      if (tid < 64) {
        const int h0 = hist[4 * tid], h1 = hist[4 * tid + 1], h2 = hist[4 * tid + 2], h3 = hist[4 * tid + 3];
        const int c = h0 + h1 + h2 + h3;
        int suf = c;
        for (int d = 1; d < 64; d <<= 1) { const int o = __shfl_down(suf, d); if (tid + d < 64) suf += o; }
        const int above = suf - c;
        const int need0 = s_need;
        int need = need0 - above;
        const bool mine = (need > 0 && need <= c) || (tid == 0 && need > c);
        if (mine) {
          int bin;
          if (h3 >= need) bin = 3; else { need -= h3; if (h2 >= need) bin = 2; else { need -= h2; if (h1 >= need) bin = 1; else { need -= h1; bin = 0; } } }
          s_prefix = prefix | ((unsigned)(4 * tid + bin) << shift); s_need = need;
        }
      }
      __syncthreads();
    }
    const unsigned T = s_prefix; const int need_eq = s_need;
    const int per = (N + NT - 1) / NT;
    int cg = 0, ce = 0;
    for (int j = 0; j < per; ++j) { const int i = tid * per + j; if (i < N) { const unsigned v = vals[i]; cg += v > T; ce += v == T; } }
    int ig = cg, ie = ce;
    { const int ln = tid & 63;
      for (int d = 1; d < 64; d <<= 1) { const int og = __shfl_up(ig, d), oe = __shfl_up(ie, d); if (ln >= d) { ig += og; ie += oe; } }
      if (ln == 63) { scan_gt[tid >> 6] = ig; scan_eq[tid >> 6] = ie; } }
    __syncthreads();
    int rg = ig - cg, re = ie - ce;
    for (int w = 0; w < (tid >> 6); ++w) { rg += scan_gt[w]; re += scan_eq[w]; }
    const int slot0 = isx ? (e * B_ + b) * CAP_ : XSLOTS_ + (e * B_ + b) * CAPC_;
    for (int j = 0; j < per; ++j) {
      const int i = tid * per + j; if (i >= N) break;
      const unsigned v = vals[i];
      int slot = -1;
      if (v > T) { slot = rg + (re < need_eq ? re : need_eq); ++rg; }
      else if (v == T) { if (re < need_eq) slot = rg + re; ++re; }
      if (slot >= 0) { union { float f; unsigned u; } x; x.u = v; p.sel_idx[slot0 + slot] = row0 + i; p.sel_gate[slot0 + slot] = x.f; }
      p.inv[(size_t)(row0 + i) * NEXP_ + e] = slot >= 0 ? slot0 + slot : -1;
    }
  }
}

#ifndef CPU_EMU
#define XB_SPIN_CAP (1u << 24)
#endif
__device__ __forceinline__ void grid_sync(const Params& p) { (void)p; }

template <int PH> __device__ __forceinline__ void run_phase(const Params& p, int l) {
  if (PH == PH_MOD) phase_mod(p);
  if (PH == PH_NORM1) phase_norm<0>(p, l);
  if (PH == PH_GEMM_IN) phase_gemm_in(p, l);
#ifdef HAVE_PREPA
  if (PH == PH_PREP) phase_prepA(p, l);
  if (PH == PH_RETD) phase_prepB_naive(p, l);
  if (PH == PH_PREPC) phase_prepC(p, l);
#else
  if (PH == PH_PREP) phase_prep(p, l);
#endif
  if (PH == PH_RETD) phase_retd(p, l);
  if (PH == PH_MIX) phase_mix<true, true>(p, l);
#ifdef HAVE_PREPA
  if (PH == PH_POST) { phase_post<true>(p, l); phase_post_fast(p, l); }
#else
  if (PH == PH_POST) phase_post<true>(p, l);
#endif
  if (PH == PH_GEMM_OUT) phase_gemm_out(p, l);
  if (PH == PH_NORM2) phase_norm<1>(p, l);
  if (PH == PH_TOPK) phase_topk(p, l);
  if (PH == PH_MOE1) phase_moe1(p, l);
  if (PH == PH_MOE2) phase_moe2(p, l);
  if (PH == PH_FINAL) phase_norm<2>(p, l);
}
template <int PH> __global__ void __launch_bounds__(NT) k_phase(Params p, int l) { run_phase<PH>(p, l); }

#ifndef CPU_EMU
#define XB_TMO      128
#define XB_XCNT(j)  (256  + 64 * (j))
#define XB_XSUB(j)  (1280 + 64 * (j))
#define XB_XGEN(j)  (2304 + 64 * (j))
#define XB_TOP      3328
#define XB_TOPGEN   3392
#define XCD_BAR_WORDS 3456
#define XB_SPIN_CAP (1u << 23)
__device__ __forceinline__ unsigned xb_ld(unsigned* p)              { return __hip_atomic_load(p, __ATOMIC_RELAXED, __HIP_MEMORY_SCOPE_AGENT); }
__device__ __forceinline__ unsigned xb_add(unsigned* p, unsigned v) { return __hip_atomic_fetch_add(p, v, __ATOMIC_RELAXED, __HIP_MEMORY_SCOPE_AGENT); }
__device__ __forceinline__ unsigned xb_xcc_id() { return (unsigned)__builtin_amdgcn_s_getreg((3 << 11) | 20) & 0xFu; }
#define XB_SPIN(cond, bar) do { unsigned _sp = 0; while (cond) { __builtin_amdgcn_s_sleep(1); \
    if ((++_sp & 255u) == 0u) { if (xb_ld(&(bar)[XB_TMO])) break; if (_sp > XB_SPIN_CAP) { atomicAdd(&(bar)[XB_TMO], 1u); break; } } } } while (0)
struct XcdBarrier { unsigned* bar; unsigned x; volatile LAS unsigned* st; };
__device__ __forceinline__ XcdBarrier xcd_barrier_post(unsigned* bar, volatile LAS unsigned* st) {
    XcdBarrier b; b.bar = bar; b.x = xb_xcc_id(); b.st = st;
    if (threadIdx.x == 0) (void)xb_add(&bar[XB_XCNT(b.x)], 1u);
    return b;
}
__device__ __forceinline__ void xcd_barrier_complete(unsigned* bar, unsigned x, unsigned& nloc, unsigned& nx) {
    const unsigned G = gridDim.x * gridDim.y * gridDim.z;
    unsigned sum, cnt, mine, sp = 0u;
    for (;;) {
        sum = 0u; cnt = 0u; mine = 0u;
#pragma unroll
        for (unsigned j = 0; j < 16; ++j) { const unsigned c = xb_ld(&bar[XB_XCNT(j)]); sum += c; cnt += (c > 0u) ? 1u : 0u; mine = (j == x) ? c : mine; }
        if (sum == G) break;
        __builtin_amdgcn_s_sleep(1);
        if ((++sp & 255u) == 0u) { if (xb_ld(&bar[XB_TMO])) break; if (sp > XB_SPIN_CAP) { atomicAdd(&bar[XB_TMO], 1u); break; } }
    }
    nloc = mine > 0u ? mine : 1u; nx = cnt > 0u ? cnt : 1u;
}
__device__ __forceinline__ void xcd_barrier(const XcdBarrier& b) {
    asm volatile("s_waitcnt vmcnt(0)" ::: "memory");
    __syncthreads();
    if (threadIdx.x == 0) {
        unsigned* bar = b.bar; unsigned bx = b.x;
        asm volatile("" : "+s"(bx));
        __builtin_amdgcn_s_waitcnt(0);
        unsigned nloc = b.st[0], nx = b.st[1];
        if (nloc == 0u) { xcd_barrier_complete(bar, bx, nloc, nx); b.st[0] = nloc; b.st[1] = nx; }
        const unsigned old = xb_add(&bar[XB_XSUB(bx)], 1u);
        const unsigned gen = old / nloc;
        if (old + 1u == (gen + 1u) * nloc) {
            __builtin_amdgcn_fence(__ATOMIC_RELEASE, "agent");
            asm volatile("s_waitcnt vmcnt(0)" ::: "memory");
            const unsigned og = xb_add(&bar[XB_TOP], 1u);
            const unsigned tg = og / nx;
            if (og + 1u == (tg + 1u) * nx) xb_add(&bar[XB_TOPGEN], 1u);
            else XB_SPIN(xb_ld(&bar[XB_TOPGEN]) == tg, bar);
            __builtin_amdgcn_fence(__ATOMIC_ACQUIRE, "agent");
            xb_add(&bar[XB_XGEN(bx)], 1u);
            asm volatile("s_waitcnt vmcnt(0)" ::: "memory");
        } else {
            XB_SPIN(xb_ld(&bar[XB_XGEN(bx)]) == gen, bar);
            __builtin_amdgcn_fence(__ATOMIC_ACQUIRE, "agent");
            asm volatile("s_waitcnt vmcnt(0)" ::: "memory");
        }
    }
    __syncthreads();
}
typedef const Params __attribute__((address_space(4))) * KParamsPtr;
__device__ __forceinline__ const Params& kparams() { KParamsPtr kp = (KParamsPtr)__builtin_amdgcn_kernarg_segment_ptr(); asm volatile("" : "+s"(kp)); return *(const Params*)kp; }
#define KP kparams()
__global__ void __launch_bounds__(NT, 2) mega(Params p_unused) {
  (void)p_unused;
  LAS unsigned char* lds = (LAS unsigned char*)smem_dyn;
  if (threadIdx.x < 4) ((LAS unsigned*)(lds + XBW_OFF_))[threadIdx.x] = 0u;
  __syncthreads();
  XcdBarrier bar = xcd_barrier_post(KP.bar, (volatile LAS unsigned*)(lds + XBW_OFF_));
#ifdef TIMEMASK
  unsigned long long t_prev = __builtin_amdgcn_s_memrealtime(), t_acc = 0;
#define TSTAMP(k) do { const unsigned long long _t = __builtin_amdgcn_s_memrealtime(); if ((TIMEMASK >> (k)) & 1) t_acc += _t - t_prev; t_prev = _t; } while (0)
#else
#define TSTAMP(k) do { } while (0)
#endif
  phase_mod(KP);
  phase_cvt_static(KP);
  phase_cvt_small(KP);
  xcd_barrier(bar); TSTAMP(12);
  for (int l = 0; l < DEPTH_; ++l) {
    phase_norm<0>(KP, l); xcd_barrier(bar); TSTAMP(0);
    phase_gemm_in_mfma(KP, l, lds); xcd_barrier(bar); TSTAMP(1);
    phase_prepA(KP, l); xcd_barrier(bar); TSTAMP(2);
    phase_gemm_small_mfma(KP, l, lds); phase_retA_mfma(KP, lds); xcd_barrier(bar); TSTAMP(3);
    phase_prepC(KP, l); xcd_barrier(bar); TSTAMP(4);
    phase_mix<false, false, true>(KP, l); phase_attn(KP, l); phase_scan(KP, l, lds); xcd_barrier(bar); TSTAMP(5);
    phase_post_fast(KP, l); phase_retB_mfma(KP, l, lds); xcd_barrier(bar); TSTAMP(6);
    phase_gemm_out_mfma(KP, l, lds); xcd_barrier(bar); TSTAMP(7);
    phase_norm2_pf(KP, l); xcd_barrier(bar); TSTAMP(8);
    phase_topk(KP, l); xcd_barrier(bar); TSTAMP(9);
    phase_moe1_mfma(KP, l, lds); xcd_barrier(bar); TSTAMP(10);
    phase_moe2_mfma(KP, l, lds); xcd_barrier(bar); TSTAMP(11);
  }
  phase_norm<2>(KP, DEPTH_ - 1);
#ifdef TIMEMASK
  if (blockIdx.x == 0) { const unsigned long long t0 = __builtin_amdgcn_s_memrealtime(); while (__builtin_amdgcn_s_memrealtime() - t0 < t_acc * TIMEMULT) __builtin_amdgcn_s_sleep(16); }
#endif
}
#endif

#ifdef CPU_EMU
#define LAUNCH(PH, grid, p, l) emu_launch(dim3(grid), dim3(NT), LDS_BYTES_, [=]() { k_phase<PH>(p, l); })
#else
#define LAUNCH(PH, grid, p, l) hipLaunchKernelGGL(k_phase<PH>, dim3(grid), dim3(NT), LDS_BYTES_, stream, p, l)
#endif

static size_t align_up(size_t v) { return (v + 255) & ~(size_t)255; }

extern "C" void kernel_launch(void* const* d_in, const int* in_sizes, int n_in, void* d_out, int out_size, void* d_ws, size_t ws_size, hipStream_t stream) {
  (void)in_sizes; (void)n_in; (void)out_size; (void)ws_size;
  Params p;
  memset(&p, 0, sizeof(p));
  const float** ip = (const float**)&p.x;
  for (int i = 0; i < 34; ++i) ip[i] = (const float*)d_in[i];
  p.out = (float*)d_out;
  char* w = (char*)d_ws; size_t off = 0;
#define CARVE(field, type, count) do { p.field = (type*)(w + off); off = align_up(off + sizeof(type) * (size_t)(count)); } while (0)
  CARVE(bar, unsigned, 4096);
  CARVE(modv, float, (size_t)DEPTH_ * (B_ + 1) * 6 * D_);
  CARVE(xc, float, (size_t)NCTX_ * D_);
  CARVE(h, bf16_t, (size_t)NROWS_ * D_);
  CARVE(z, bf16_t, (size_t)NROWS_ * ZLD_);
  CARVE(y, bf16_t, (size_t)NROWS_ * D_);
  CARVE(qb, bf16_t, (size_t)NROWS_ * NH_ * QK_);
  CARVE(kb, bf16_t, (size_t)B_ * NH_ * LK_ * KLD_);
  CARVE(vb, bf16_t, (size_t)B_ * NH_ * LK_ * HD_);
  CARVE(sc_r, float, (size_t)NROWS_ * GWID_);
  CARVE(sc_v, float, (size_t)NROWS_ * GWID_);
  CARVE(sc_kk, float, (size_t)NROWS_ * GWID_);
  CARVE(sc_w, float, (size_t)2 * NROWS_ * GWID_);
  CARVE(sc_kka, float, (size_t)2 * NROWS_ * GWID_);
  CARVE(sc_kt, float, (size_t)2 * NROWS_ * GWID_);
  CARVE(sc_gate, float, (size_t)NROWS_ * GWID_);
  CARVE(sc_bonus, float, (size_t)2 * NROWS_ * NH_);
  CARVE(ys, float, (size_t)2 * NROWS_ * GWID_);
  CARVE(ob, float, (size_t)NROWS_ * GWID_);
  CARVE(rq, bf16_t, (size_t)NROWS_ * GWID_);
  CARVE(rk, bf16_t, (size_t)NROWS_ * GWID_);
  CARVE(rv, bf16_t, (size_t)NROWS_ * GWID_);
  CARVE(tab_mla, float, (size_t)L_ * ROPE_);
  CARVE(tab_ret, float, (size_t)L_ * HD_);
  CARVE(aff, float, (size_t)NROWS_ * NEXP_);
  CARVE(sel_idx, int, (size_t)XSLOTS_ + CSLOTS_);
  CARVE(sel_gate, float, (size_t)XSLOTS_ + CSLOTS_);
  CARVE(inv, int, (size_t)NROWS_ * NEXP_);
  CARVE(wb_in, bf16_t, (size_t)DEPTH_ * ZLD_ * D_);
  CARVE(wb_out, bf16_t, (size_t)DEPTH_ * D_ * D_);
  CARVE(kr2, float, (size_t)NROWS_);
  CARVE(bts, bf16_t, (size_t)DEPTH_ * ZS2W_ * AUXW_);
  CARVE(rg, bf16_t, (size_t)NROWS_ * GWID_);
  p.hid = (bf16_t*)p.z;
  p.ye = (bf16_t*)p.sc_w;
  p.zs2 = p.z;
  p.rd = (float*)p.h; p.rs = p.rd + (size_t)B_ * NH_ * NCH_ * 2 * HD_ * HD_;
  p.aux = (bf16_t*)p.ob;
  p.kbuf = (bf16_t*)p.ys; p.krp = p.kbuf + (size_t)NROWS_ * GWID_;
  p.wb_moe1 = p.z + (((size_t)(XSLOTS_ + CSLOTS_) * D_ + 127) / 128) * 128;
  p.wb_moe2 = p.wb_moe1 + (size_t)NEXP_ * 2 * D_ * D_;
#undef CARVE
#ifndef CPU_EMU
  {
    static int grid = 0;
    if (!grid) {
      int dev = 0, cus = 0, per_cu = 0;
      hipGetDevice(&dev);
      hipDeviceGetAttribute(&cus, hipDeviceAttributeMultiprocessorCount, dev);
      hipFuncSetAttribute((const void*)mega, hipFuncAttributeMaxDynamicSharedMemorySize, LDS_BYTES_);
      hipOccupancyMaxActiveBlocksPerMultiprocessor(&per_cu, mega, NT, LDS_BYTES_);
      grid = cus * (per_cu < 1 ? per_cu : 1);
    }
    hipMemsetAsync(p.bar, 0, 4096 * sizeof(unsigned), stream);
    hipLaunchKernelGGL(mega, dim3(grid), dim3(NT), LDS_BYTES_, stream, p);
    return;
  }
#else
  const int grid = 256;
  LAUNCH(PH_MOD, grid, p, 0);
  for (int l = 0; l < DEPTH_; ++l) {
    LAUNCH(PH_NORM1, grid, p, l);
    LAUNCH(PH_GEMM_IN, grid, p, l);
    LAUNCH(PH_PREP, grid, p, l);
    LAUNCH(PH_RETD, grid, p, l);
    LAUNCH(PH_PREPC, grid, p, l);
    LAUNCH(PH_MIX, grid, p, l);
    LAUNCH(PH_POST, grid, p, l);
    LAUNCH(PH_GEMM_OUT, grid, p, l);
    LAUNCH(PH_NORM2, grid, p, l);
    LAUNCH(PH_TOPK, grid, p, l);
    LAUNCH(PH_MOE1, grid, p, l);
    LAUNCH(PH_MOE2, grid, p, l);
    if (l == DEPTH_ - 1) LAUNCH(PH_FINAL, grid, p, l);
  }
#endif
}
```

```cpp
#include <hip/hip_runtime.h>
#include <stdint.h>
#include <math.h>
#include <string.h>

#if defined(MED_CFG)
#define D_ 1024
#define B_ 1
#define L_ 128
#define DEPTH_ 2
#define LC_ 128
#define GRIDW_ 64
#define HD_ 64
#define KVR_ 128
#define DLORA_ 64
#define ALORA_ 64
#define GLORA_ 128
#define NEXP_ 2
#elif defined(SMALL_CFG)
#define D_ 256
#define B_ 2
#define L_ 256
#define DEPTH_ 2
#define LC_ 128
#define GRIDW_ 64
#define HD_ 32
#define KVR_ 32
#define DLORA_ 16
#define ALORA_ 16
#define GLORA_ 32
#define NEXP_ 4
#else
#define D_ 1024
#define B_ 8
#define L_ 4096
#define DEPTH_ 4
#define LC_ 256
#define GRIDW_ 64
#define HD_ 64
#define KVR_ 128
#define DLORA_ 64
#define ALORA_ 64
#define GLORA_ 128
#define NEXP_ 16
#endif
#define CAPF_ 2
#define AUXW_ 384
#define ZS2W_ 1792
#define GWID_ (D_ / 4)
#define NH_ (GWID_ / HD_)
#define ROPE_ (HD_ / 2)
#define QK_ (HD_ + ROPE_)
#define NTOK_ (B_ * L_)
#define NCTX_ (B_ * LC_)
#define NROWS_ (NTOK_ + NCTX_)
#define LK_ (LC_ + L_)
#define COLS_MLA_ (NH_ * QK_ + KVR_ + ROPE_)
#define COLS_RWKV_ (3 * GWID_ + DLORA_ + ALORA_ + GLORA_)
#define MLA0_ (3 * GWID_)
#define RW0_ (MLA0_ + COLS_MLA_)
#define RT0_ (RW0_ + COLS_RWKV_)
#define INCOLS_ (RT0_ + 4 * GWID_)
#define ZLD_ (((INCOLS_ + 255) / 256) * 256)
#define CAP_ (CAPF_ * L_ / NEXP_)
#define CAPC_ (CAPF_ * LC_ / NEXP_)
#define XSLOTS_ (B_ * NEXP_ * CAP_)
#define CSLOTS_ (B_ * NEXP_ * CAPC_)
#define RCH_ 128
#define NCC_ (LC_ / RCH_)
#define NCX_ (L_ / RCH_)
#define NCH_ (NCC_ + NCX_)
#define KLD_ (((QK_ + 63) / 64) * 64)
#define NT 512
#define NWAVE (NT / 64)

typedef unsigned short bf16_t;

__device__ __forceinline__ float bf2f(bf16_t v) { union { unsigned u; float f; } x; x.u = ((unsigned)v) << 16; return x.f; }
__device__ __forceinline__ bf16_t f2bf(float f) { union { unsigned u; float f; } x; x.f = f; unsigned u = x.u; u += 0x7FFFu + ((u >> 16) & 1u); return (bf16_t)(u >> 16); }
__device__ __forceinline__ float wave_sum(float v) { for (int m = 32; m >= 1; m >>= 1) v += __shfl_xor(v, m); return v; }
__device__ __forceinline__ float wave_max(float v) { for (int m = 32; m >= 1; m >>= 1) v = fmaxf(v, __shfl_xor(v, m)); return v; }
#ifdef CPU_EMU
__device__ __forceinline__ float sigmoidf_(float x) { return 1.0f / (1.0f + expf(-x)); }
__device__ __forceinline__ float siluf_(float x) { return x / (1.0f + expf(-x)); }
__device__ __forceinline__ float tanhf_(float x) { return tanhf(x); }
__device__ __forceinline__ float fexp_(float x) { return expf(x); }
__device__ __forceinline__ float softplus_neg_(float x) { return (-x > 20.f) ? -x : log1pf(expf(-x)); }
#else
__device__ __forceinline__ float fexp_(float x) { return __builtin_amdgcn_exp2f(x * 1.4426950408889634f); }
__device__ __forceinline__ float sigmoidf_(float x) { return __builtin_amdgcn_rcpf(1.0f + fexp_(-x)); }
__device__ __forceinline__ float siluf_(float x) { return x * __builtin_amdgcn_rcpf(1.0f + fexp_(-x)); }
__device__ __forceinline__ float tanhf_(float x) { const float e = fexp_(-2.0f * fabsf(x)); const float t = (1.0f - e) * __builtin_amdgcn_rcpf(1.0f + e); return x < 0.f ? -t : t; }
__device__ __forceinline__ float softplus_neg_(float x) { return (-x > 20.f) ? -x : __builtin_amdgcn_logf(1.0f + fexp_(-x)) * 0.6931471805599453f; }
#endif


#ifdef CPU_EMU
__device__ __forceinline__ int otid() { return threadIdx.x; }
__device__ __forceinline__ int obid() { return blockIdx.x; }
#else
__device__ __forceinline__ int otid() { int t = threadIdx.x; asm volatile("" : "+v"(t)); return t; }
__device__ __forceinline__ int obid() { int b = blockIdx.x; asm volatile("" : "+s"(b)); return b; }
#endif

#define LDS_BYTES_ (132 * 1024)
#define XBW_OFF_ (128 * 1024)
#ifdef CPU_EMU
#define SMEM_PTR() ((unsigned char*)emu_dynshm())
#else
extern __shared__ __attribute__((aligned(16))) unsigned char smem_dyn[];
#define SMEM_PTR() (smem_dyn)
#endif
struct Params {
  const float *x, *c, *ctx, *c_ctx, *w_ada, *b_ada, *g_norm1, *g_norm2, *w_in, *w_out, *conv_w, *g_out_conv, *g_kv_norm, *w_uk, *w_uv,
      *g_q_norm, *g_k_norm, *g_out_mla, *rwkv_mu, *rwkv_w0, *rwkv_w2, *rwkv_a0, *rwkv_a2, *rwkv_g2, *rwkv_k_k, *rwkv_k_a, *rwkv_r_k, *g_ln_x,
      *g_ret_norm, *w_router, *b_router, *w_gate, *w_up, *w_down;
  float* out;
  unsigned* bar;
  float* modv;
  float* xc;
  bf16_t* h;
  bf16_t* z;
  bf16_t* y;
  bf16_t* qb;
  bf16_t* kb;
  bf16_t* vb;
  float* ob;
  float* sc_r;
  float* sc_v;
  float* sc_kk;
  float* sc_w;
  float* sc_kka;
  float* sc_kt;
  float* sc_gate;
  float* sc_bonus;
  bf16_t* aux;
  bf16_t* kbuf;
  bf16_t* krp;
  float* kr2;
  bf16_t* bts;
  bf16_t* zs2;
  bf16_t* rg;
  float* ys;
  bf16_t* rq;
  bf16_t* rk;
  bf16_t* rv;
  float* rd;
  float* rs;
  float* tab_mla;
  float* tab_ret;
  float* aff;
  int* sel_idx;
  float* sel_gate;
  int* inv;
  bf16_t* hid;
  bf16_t* ye;
  bf16_t* wb_in;
  bf16_t* wb_out;
  bf16_t* wb_moe1;
  bf16_t* wb_moe2;
};

enum { PH_MOD = 0, PH_NORM1, PH_GEMM_IN, PH_PREP, PH_RETD, PH_PREPC, PH_MIX, PH_POST, PH_GEMM_OUT, PH_NORM2, PH_TOPK, PH_MOE1, PH_MOE2, PH_FINAL, PH_COUNT };

__device__ __forceinline__ int row_batch(int row) { return row < NTOK_ ? row / L_ : (row - NTOK_) / LC_; }
__device__ __forceinline__ int row_modidx(int row) { return row < NTOK_ ? row / L_ : B_; }
__device__ __forceinline__ int row_pos(int row) { return row < NTOK_ ? row % L_ : (row - NTOK_) % LC_; }
__device__ __forceinline__ int row_len(int row) { return row < NTOK_ ? L_ : LC_; }

__device__ __forceinline__ void phase_mod(const Params& p) {
  const int tid = otid();
#ifndef CPU_EMU
  {
    float* sv = (float*)SMEM_PTR();
    float* red = sv + (B_ + 1) * D_;
    for (int i = tid; i < (B_ + 1) * D_; i += NT) { const int r = i / D_, k = i % D_; sv[i] = siluf_(r < B_ ? p.c[r * D_ + k] : p.c_ctx[k]); }
    __syncthreads();
    const int kp = tid >> 7, c = tid & 127;
    for (int u = obid(); u < DEPTH_ * (6 * D_ / 128); u += gridDim.x) {
      const int l = u / (6 * D_ / 128), col = (u % (6 * D_ / 128)) * 128 + c;
      float acc[B_ + 1];
#pragma unroll
      for (int r = 0; r <= B_; ++r) acc[r] = 0.f;
      const float* w = p.w_ada + (size_t)l * D_ * 6 * D_ + (size_t)(kp * (D_ / 4)) * 6 * D_ + col;
#pragma unroll 8
      for (int k = 0; k < D_ / 4; ++k) {
        const float wv = w[(size_t)k * 6 * D_];
#pragma unroll
        for (int r = 0; r <= B_; ++r) acc[r] += sv[r * D_ + kp * (D_ / 4) + k] * wv;
      }
#pragma unroll
      for (int r = 0; r <= B_; ++r) red[(kp * (B_ + 1) + r) * 128 + c] = acc[r];
      __syncthreads();
      for (int i = tid; i < (B_ + 1) * 128; i += NT) { const int r = i >> 7, cc = i & 127, cl = (u % (6 * D_ / 128)) * 128 + cc;
        const float v = red[(0 * (B_ + 1) + r) * 128 + cc] + red[(1 * (B_ + 1) + r) * 128 + cc] + red[(2 * (B_ + 1) + r) * 128 + cc] + red[(3 * (B_ + 1) + r) * 128 + cc];
        p.modv[((size_t)l * (B_ + 1) + r) * 6 * D_ + cl] = v + p.b_ada[l * 6 * D_ + cl]; }
      __syncthreads();
    }
  }
#else
  for (int idx = obid() * NT + tid; idx < DEPTH_ * 6 * D_; idx += gridDim.x * NT) {
    const int l = idx / (6 * D_), col = idx % (6 * D_);
    float acc[B_ + 1];
#pragma unroll
    for (int r = 0; r <= B_; ++r) acc[r] = 0.f;
    const float* w = p.w_ada + (size_t)l * D_ * 6 * D_ + col;
    for (int k = 0; k < D_; ++k) {
      const float wv = w[(size_t)k * 6 * D_];
#pragma unroll
      for (int r = 0; r < B_; ++r) acc[r] += siluf_(p.c[r * D_ + k]) * wv;
      acc[B_] += siluf_(p.c_ctx[k]) * wv;
    }
    const float bb = p.b_ada[l * 6 * D_ + col];
#pragma unroll
    for (int r = 0; r <= B_; ++r) p.modv[((size_t)l * (B_ + 1) + r) * 6 * D_ + col] = acc[r] + bb;
  }
#endif
  const int NF = ROPE_ / 4;
  for (int idx = obid() * NT + tid; idx < L_ * NF; idx += gridDim.x * NT) {
    const int t = idx / NF, i = idx % NF;
    const float inv = powf(10000.0f, -(float)(2 * i) / (float)(ROPE_ / 2));
    const float ar = (float)(t / GRIDW_) * inv, ac = (float)(t % GRIDW_) * inv;
    float* o = p.tab_mla + (size_t)t * 4 * NF;
    o[0 * NF + i] = cosf(ar); o[1 * NF + i] = sinf(ar); o[2 * NF + i] = cosf(ac); o[3 * NF + i] = sinf(ac);
  }
  const int NR = HD_ / 2;
  for (int idx = obid() * NT + tid; idx < L_ * NR; idx += gridDim.x * NT) {
    const int t = idx / NR, i = idx % NR;
    const float theta = 1.0f / powf(10000.0f, (float)i / (float)(NR - 1));
    const float a = (float)t * theta;
    p.tab_ret[(size_t)t * 2 * NR + i] = cosf(a); p.tab_ret[(size_t)t * 2 * NR + NR + i] = sinf(a);
  }
}

struct F4_ { float x, y, z, w; };
struct U2n_ { unsigned x, y; };
#ifdef CPU_EMU
__device__ __forceinline__ int lane_bcast_i(int v, int src) { return __shfl(v, src); }
#else
__device__ __forceinline__ int lane_bcast_i(int v, int src) { return __builtin_amdgcn_readlane(v, src); }
#endif

#ifndef CPU_EMU
template <int CTRL> __device__ __forceinline__ float dpp_mov_f(float v) { return __builtin_bit_cast(float, __builtin_amdgcn_update_dpp(0, __builtin_bit_cast(int, v), CTRL, 0xF, 0xF, true)); }
__device__ __forceinline__ float reduce_scatter16(const float (&v)[16], int lane) {
  float w[8], u[4];
#pragma unroll
  for (int i = 0; i < 8; ++i) { auto r = __builtin_amdgcn_permlane32_swap(__float_as_uint(v[i]), __float_as_uint(v[i + 8]), false, false); w[i] = __uint_as_float(r[0]) + __uint_as_float(r[1]); }
#pragma unroll
  for (int i = 0; i < 4; ++i) { auto r = __builtin_amdgcn_permlane16_swap(__float_as_uint(w[i]), __float_as_uint(w[i + 4]), false, false); u[i] = __uint_as_float(r[0]) + __uint_as_float(r[1]); }
  const bool b3 = (lane & 8) != 0, b2 = (lane & 4) != 0;
  float t[2];
#pragma unroll
  for (int i = 0; i < 2; ++i) { const float keep = b3 ? u[i + 2] : u[i], send = b3 ? u[i] : u[i + 2]; t[i] = keep + dpp_mov_f<0x128>(send); }
  const float keep = b2 ? t[1] : t[0], send = b2 ? t[0] : t[1];
  float x = keep + dpp_mov_f<0x141>(send);
  x += dpp_mov_f<0xB1>(x); x += dpp_mov_f<0x4E>(x);
  return x;
}
#endif
template <int MODE> __device__ __forceinline__ void phase_norm(const Params& p, int l) {
  const int tid = otid(), wave = tid >> 6, lane = tid & 63;
  const bool last = (l == DEPTH_ - 1);
  constexpr int R = 2, NI = D_ / 256;
  const bool combine = (MODE == 0 && l > 0) || MODE == 2;
  const int lprev = (MODE == 2) ? l : l - 1;
  const int stride = gridDim.x * NWAVE;
#ifndef CPU_EMU
  float* wr_s = (float*)SMEM_PTR();
  if (MODE == 1) { const float* wsrc = p.w_router + (size_t)l * D_ * NEXP_; for (int i = tid; i < D_ * NEXP_ / 4; i += NT) { const F4_ w4 = ((const F4_*)wsrc)[i]; const int col = (i * 4) / NEXP_, e0 = (i * 4) % NEXP_;
      wr_s[(e0 + 0) * D_ + col] = w4.x; wr_s[(e0 + 1) * D_ + col] = w4.y; wr_s[(e0 + 2) * D_ + col] = w4.z; wr_s[(e0 + 3) * D_ + col] = w4.w; } __syncthreads(); }
#else
  const float* wr_s = p.w_router + (size_t)l * D_ * NEXP_;
#endif
  for (int rbase = obid() * NWAVE + wave; rbase < NROWS_; rbase += stride * R) {
    F4_ v[R][NI]; bool ok[R]; int rows[R]; float* xr[R]; int slotv[R];
#pragma unroll
    for (int k = 0; k < R; ++k) {
      const int row = rbase + k * stride; rows[k] = row;
      const bool isx = row < NTOK_;
      ok[k] = row < NROWS_ && !(MODE == 2 && !isx) && !(MODE == 1 && !isx && last);
      xr[k] = nullptr; slotv[k] = -1;
      if (ok[k]) {
        xr[k] = isx ? p.out + (size_t)row * D_ : p.xc + (size_t)(row - NTOK_) * D_;
        const float* src = xr[k];
        if (MODE == 0 && l == 0) src = isx ? p.x + (size_t)row * D_ : p.ctx + (size_t)(row - NTOK_) * D_;
#pragma unroll
        for (int i = 0; i < NI; ++i) v[k][i] = *(const F4_*)(src + (i * 64 + lane) * 4);
        if (combine) slotv[k] = p.inv[(size_t)row * NEXP_ + (lane % NEXP_)];
      }
    }
    if (combine) {
#ifndef CPU_EMU
      F4_ sacc[R][NI];
      unsigned long long hm[R];
#pragma unroll
      for (int k = 0; k < R; ++k) { hm[k] = ok[k] ? (__builtin_amdgcn_ballot_w64(slotv[k] >= 0) & 0xFFFFull) : 0ull;
#pragma unroll
        for (int i = 0; i < NI; ++i) { sacc[k][i].x = 0.f; sacc[k][i].y = 0.f; sacc[k][i].z = 0.f; sacc[k][i].w = 0.f; } }
      while ((hm[0] | hm[1]) != 0ull) {
        U2n_ t[R][3][NI];
#pragma unroll
        for (int k = 0; k < R; ++k)
#pragma unroll
          for (int j = 0; j < 3; ++j) {
            if (hm[k] != 0ull) {
              const int e = __builtin_ctzll(hm[k]); hm[k] &= hm[k] - 1ull;
              const int slot = __builtin_amdgcn_readlane(slotv[k], e);
              const bf16_t* yr = p.ye + (size_t)slot * D_ + lane * 4;
#pragma unroll
              for (int i = 0; i < NI; ++i) t[k][j][i] = *(const U2n_*)(yr + i * 256);
            } else {
#pragma unroll
              for (int i = 0; i < NI; ++i) { t[k][j][i].x = 0u; t[k][j][i].y = 0u; }
            }
          }
#pragma unroll
        for (int k = 0; k < R; ++k)
#pragma unroll
          for (int j = 0; j < 3; ++j)
#pragma unroll
            for (int i = 0; i < NI; ++i) { union { unsigned u; float f; } a, b2, c, d; a.u = t[k][j][i].x << 16; b2.u = t[k][j][i].x & 0xFFFF0000u; c.u = t[k][j][i].y << 16; d.u = t[k][j][i].y & 0xFFFF0000u;
              sacc[k][i].x += a.f; sacc[k][i].y += b2.f; sacc[k][i].z += c.f; sacc[k][i].w += d.f; }
      }
#pragma unroll
      for (int k = 0; k < R; ++k) if (ok[k]) {
        const int mi = row_modidx(rows[k]);
        const float* ga2 = p.modv + ((size_t)lprev * (B_ + 1) + mi) * 6 * D_ + 5 * D_;
#pragma unroll
        for (int i = 0; i < NI; ++i) { const F4_ g = *(const F4_*)(ga2 + (i * 64 + lane) * 4);
          v[k][i].x += g.x * sacc[k][i].x; v[k][i].y += g.y * sacc[k][i].y; v[k][i].z += g.z * sacc[k][i].z; v[k][i].w += g.w * sacc[k][i].w; }
      }
#else
#pragma unroll
      for (int k = 0; k < R; ++k) if (ok[k]) {
        F4_ s[NI];
#pragma unroll
        for (int i = 0; i < NI; ++i) { s[i].x = 0.f; s[i].y = 0.f; s[i].z = 0.f; s[i].w = 0.f; }
        for (int e = 0; e < NEXP_; ++e) {
          const int slot = lane_bcast_i(slotv[k], e);
          if (slot >= 0) {
            const bf16_t* yr = p.ye + (size_t)slot * D_ + lane * 4;
            U2n_ t[NI];
#pragma unroll
            for (int i = 0; i < NI; ++i) t[i] = *(const U2n_*)(yr + i * 256);
#pragma unroll
            for (int i = 0; i < NI; ++i) { union { unsigned u; float f; } a, b2, c, d; a.u = t[i].x << 16; b2.u = t[i].x & 0xFFFF0000u; c.u = t[i].y << 16; d.u = t[i].y & 0xFFFF0000u;
              s[i].x += a.f; s[i].y += b2.f; s[i].z += c.f; s[i].w += d.f; }
          }
        }
        const int mi = row_modidx(rows[k]);
        const float* ga2 = p.modv + ((size_t)lprev * (B_ + 1) + mi) * 6 * D_ + 5 * D_;
#pragma unroll
        for (int i = 0; i < NI; ++i) { const F4_ g = *(const F4_*)(ga2 + (i * 64 + lane) * 4);
          v[k][i].x += g.x * s[i].x; v[k][i].y += g.y * s[i].y; v[k][i].z += g.z * s[i].z; v[k][i].w += g.w * s[i].w; }
      }
#endif
    }
    if (combine || (MODE == 0 && l == 0)) {
#pragma unroll
      for (int k = 0; k < R; ++k) if (ok[k]) {
#pragma unroll
        for (int i = 0; i < NI; ++i) *(F4_*)(xr[k] + (i * 64 + lane) * 4) = v[k][i];
      }
    }
    if (MODE == 2) continue;
#pragma unroll
    for (int k = 0; k < R; ++k) {
      if (!ok[k]) continue;
      const int row = rows[k];
      float ss = 0.f;
#pragma unroll
      for (int i = 0; i < NI; ++i) ss += v[k][i].x * v[k][i].x + v[k][i].y * v[k][i].y + v[k][i].z * v[k][i].z + v[k][i].w * v[k][i].w;
      ss = wave_sum(ss);
      const float rstd = rsqrtf(ss / (float)D_ + 1e-6f);
      const int mi = row_modidx(row);
      const float* g = (MODE == 0 ? p.g_norm1 : p.g_norm2) + (size_t)l * D_;
      const float* mv = p.modv + ((size_t)l * (B_ + 1) + mi) * 6 * D_ + (MODE == 0 ? 0 : 3 * D_);
      float lg[NEXP_];
#pragma unroll
      for (int e = 0; e < NEXP_; ++e) lg[e] = 0.f;
#pragma unroll
      for (int i = 0; i < NI; ++i) {
        const int col = (i * 64 + lane) * 4;
        const F4_ gg = *(const F4_*)(g + col), sh = *(const F4_*)(mv + col), sc = *(const F4_*)(mv + D_ + col);
        float hv[4];
        hv[0] = v[k][i].x * rstd * gg.x * (1.0f + sc.x) + sh.x; hv[1] = v[k][i].y * rstd * gg.y * (1.0f + sc.y) + sh.y;
        hv[2] = v[k][i].z * rstd * gg.z * (1.0f + sc.z) + sh.z; hv[3] = v[k][i].w * rstd * gg.w * (1.0f + sc.w) + sh.w;
        U2n_ o; o.x = (unsigned)f2bf(hv[0]) | ((unsigned)f2bf(hv[1]) << 16); o.y = (unsigned)f2bf(hv[2]) | ((unsigned)f2bf(hv[3]) << 16);
        *(U2n_*)(p.h + (size_t)row * D_ + col) = o;
        if (MODE == 1) {
#ifndef CPU_EMU
#pragma unroll
          for (int e = 0; e < NEXP_; ++e) { const F4_ w4 = *(const F4_*)(wr_s + (size_t)e * D_ + col); lg[e] += (hv[0] * w4.x + hv[1] * w4.y) + (hv[2] * w4.z + hv[3] * w4.w); }
#else
#pragma unroll
          for (int j = 0; j < 4; ++j)
#pragma unroll
            for (int e = 0; e < NEXP_; ++e) lg[e] += hv[j] * wr_s[(size_t)(col + j) * NEXP_ + e];
#endif
        }
      }
      if (MODE == 1) {
#if !defined(CPU_EMU) && NEXP_ == 16
        const int eid = ((lane >> 5) & 1) * 8 + ((lane >> 4) & 1) * 4 + ((lane >> 3) & 1) * 2 + ((lane >> 2) & 1);
        const float lgt = reduce_scatter16(lg, lane) + p.b_router[l * NEXP_ + eid];
        float mx = lgt;
        { auto r = __builtin_amdgcn_permlane32_swap(__float_as_uint(mx), __float_as_uint(mx), false, false); mx = fmaxf(__uint_as_float(r[0]), __uint_as_float(r[1])); }
        { auto r = __builtin_amdgcn_permlane16_swap(__float_as_uint(mx), __float_as_uint(mx), false, false); mx = fmaxf(__uint_as_float(r[0]), __uint_as_float(r[1])); }
        mx = fmaxf(mx, dpp_mov_f<0x128>(mx)); mx = fmaxf(mx, dpp_mov_f<0x141>(mx));
        const float ex = fexp_(lgt - mx);
        float sm = ex;
        { auto r = __builtin_amdgcn_permlane32_swap(__float_as_uint(sm), __float_as_uint(sm), false, false); sm = __uint_as_float(r[0]) + __uint_as_float(r[1]); }
        { auto r = __builtin_amdgcn_permlane16_swap(__float_as_uint(sm), __float_as_uint(sm), false, false); sm = __uint_as_float(r[0]) + __uint_as_float(r[1]); }
        sm += dpp_mov_f<0x128>(sm); sm += dpp_mov_f<0x141>(sm);
        if ((lane & 3) == 0) p.aff[(size_t)row * NEXP_ + eid] = ex / sm;
#else
        float mx = -1e30f;
#pragma unroll
        for (int e = 0; e < NEXP_; ++e) { lg[e] = wave_sum(lg[e]) + p.b_router[l * NEXP_ + e]; mx = fmaxf(mx, lg[e]); }
        float sum = 0.f;
#pragma unroll
        for (int e = 0; e < NEXP_; ++e) { lg[e] = expf(lg[e] - mx); sum += lg[e]; }
        const float is = 1.0f / sum;
        if (lane == 0) {
#pragma unroll
          for (int e = 0; e < NEXP_; ++e) p.aff[(size_t)row * NEXP_ + e] = lg[e] * is;
        }
#endif
      }
    }
  }
#ifndef CPU_EMU
  if (MODE == 1) __syncthreads();
#endif
}


#if !defined(CPU_EMU) && NEXP_ == 16
struct RawN2 { F4_ x[4], sh[4], sc[4]; };
__device__ __forceinline__ void norm2_load(const Params& p, int l, int row, int lane, RawN2& r) {
  const float* src = row < NTOK_ ? p.out + (size_t)row * D_ : p.xc + (size_t)(row - NTOK_) * D_;
  const float* mv = p.modv + ((size_t)l * (B_ + 1) + row_modidx(row)) * 6 * D_ + 3 * D_;
#pragma unroll
  for (int i = 0; i < 4; ++i) { const int col = (i * 64 + lane) * 4; r.x[i] = *(const F4_*)(src + col); r.sh[i] = *(const F4_*)(mv + col); r.sc[i] = *(const F4_*)(mv + D_ + col); }
}
__device__ __forceinline__ void phase_norm2_pf(const Params& p, int l) {
  const int tid = otid(), wave = tid >> 6, lane = tid & 63;
  const bool last = (l == DEPTH_ - 1);
  const int stride = gridDim.x * NWAVE;
  float* wr_s = (float*)SMEM_PTR();
  { const float* wsrc = p.w_router + (size_t)l * D_ * NEXP_;
    for (int i = tid; i < D_ * NEXP_ / 4; i += NT) { const F4_ w4 = ((const F4_*)wsrc)[i]; const int col = (i * 4) / NEXP_, e0 = (i * 4) % NEXP_;
      wr_s[(e0 + 0) * D_ + col] = w4.x; wr_s[(e0 + 1) * D_ + col] = w4.y; wr_s[(e0 + 2) * D_ + col] = w4.z; wr_s[(e0 + 3) * D_ + col] = w4.w; }
    __syncthreads(); }
  const int nrows = last ? NTOK_ : NROWS_;
  int row = obid() * NWAVE + wave;
  if (row < nrows) {
    F4_ gg[4];
#pragma unroll
    for (int i = 0; i < 4; ++i) gg[i] = *(const F4_*)(p.g_norm2 + (size_t)l * D_ + (i * 64 + lane) * 4);
    const int eid = ((lane >> 5) & 1) * 8 + ((lane >> 4) & 1) * 4 + ((lane >> 3) & 1) * 2 + ((lane >> 2) & 1);
    const float brt = p.b_router[l * NEXP_ + eid];
    RawN2 cur; norm2_load(p, l, row, lane, cur);
    for (; row < nrows; row += stride) {
      RawN2 nxt; const bool has = row + stride < nrows;
      norm2_load(p, l, has ? row + stride : row, lane, nxt);
      float ss = 0.f;
#pragma unroll
      for (int i = 0; i < 4; ++i) ss += cur.x[i].x * cur.x[i].x + cur.x[i].y * cur.x[i].y + cur.x[i].z * cur.x[i].z + cur.x[i].w * cur.x[i].w;
      ss = wave_sum(ss);
      const float rstd = rsqrtf(ss / (float)D_ + 1e-6f);
      float lg[NEXP_];
#pragma unroll
      for (int e = 0; e < NEXP_; ++e) lg[e] = 0.f;
#pragma unroll
      for (int i = 0; i < 4; ++i) {
        const int col = (i * 64 + lane) * 4;
        float hv[4];
        hv[0] = cur.x[i].x * rstd * gg[i].x * (1.0f + cur.sc[i].x) + cur.sh[i].x; hv[1] = cur.x[i].y * rstd * gg[i].y * (1.0f + cur.sc[i].y) + cur.sh[i].y;
        hv[2] = cur.x[i].z * rstd * gg[i].z * (1.0f + cur.sc[i].z) + cur.sh[i].z; hv[3] = cur.x[i].w * rstd * gg[i].w * (1.0f + cur.sc[i].w) + cur.sh[i].w;
        U2n_ o; o.x = (unsigned)f2bf(hv[0]) | ((unsigned)f2bf(hv[1]) << 16); o.y = (unsigned)f2bf(hv[2]) | ((unsigned)f2bf(hv[3]) << 16);
        *(U2n_*)(p.h + (size_t)row * D_ + col) = o;
#pragma unroll
        for (int eg = 0; eg < NEXP_; eg += 4) {
          const F4_ w0 = *(const F4_*)(wr_s + (size_t)(eg + 0) * D_ + col), w1 = *(const F4_*)(wr_s + (size_t)(eg + 1) * D_ + col), w2 = *(const F4_*)(wr_s + (size_t)(eg + 2) * D_ + col), w3 = *(const F4_*)(wr_s + (size_t)(eg + 3) * D_ + col);
          lg[eg + 0] += (hv[0] * w0.x + hv[1] * w0.y) + (hv[2] * w0.z + hv[3] * w0.w); lg[eg + 1] += (hv[0] * w1.x + hv[1] * w1.y) + (hv[2] * w1.z + hv[3] * w1.w);
          lg[eg + 2] += (hv[0] * w2.x + hv[1] * w2.y) + (hv[2] * w2.z + hv[3] * w2.w); lg[eg + 3] += (hv[0] * w3.x + hv[1] * w3.y) + (hv[2] * w3.z + hv[3] * w3.w);
          __builtin_amdgcn_sched_barrier(0);
        }
      }
      const float lgt = reduce_scatter16(lg, lane) + brt;
      float mx = lgt;
      { auto r = __builtin_amdgcn_permlane32_swap(__float_as_uint(mx), __float_as_uint(mx), false, false); mx = fmaxf(__uint_as_float(r[0]), __uint_as_float(r[1])); }
      { auto r = __builtin_amdgcn_permlane16_swap(__float_as_uint(mx), __float_as_uint(mx), false, false); mx = fmaxf(__uint_as_float(r[0]), __uint_as_float(r[1])); }
      mx = fmaxf(mx, dpp_mov_f<0x128>(mx)); mx = fmaxf(mx, dpp_mov_f<0x141>(mx));
      const float ex = fexp_(lgt - mx);
      float sm = ex;
      { auto r = __builtin_amdgcn_permlane32_swap(__float_as_uint(sm), __float_as_uint(sm), false, false); sm = __uint_as_float(r[0]) + __uint_as_float(r[1]); }
      { auto r = __builtin_amdgcn_permlane16_swap(__float_as_uint(sm), __float_as_uint(sm), false, false); sm = __uint_as_float(r[0]) + __uint_as_float(r[1]); }
      sm += dpp_mov_f<0x128>(sm); sm += dpp_mov_f<0x141>(sm);
      if ((lane & 3) == 0) p.aff[(size_t)row * NEXP_ + eid] = ex / sm;
      cur = nxt;
    }
  }
  __syncthreads();
}
#endif

struct GemmDesc { const bf16_t* A; int lda; const int* amap; const float* W; const float* W2; int ldw; int M, N, K; };
template <bool DUAL, class Epi> __device__ __forceinline__ void gemm_tile_f32(const GemmDesc& g, int tm, int tn, const Epi& epi) {
  float (*As)[132] = (float (*)[132])SMEM_PTR();
  float (*Bs)[64] = (float (*)[64])(SMEM_PTR() + 16 * 132 * 4);
  float (*Bs2)[64] = (float (*)[64])(SMEM_PTR() + 16 * 132 * 4 + 16 * 64 * 4);
  const int tid = otid(), ty = tid >> 4, tx = tid & 15;
  float acc[4][4], acc2[4][4];
#pragma unroll
  for (int i = 0; i < 4; ++i)
#pragma unroll
    for (int j = 0; j < 4; ++j) { acc[i][j] = 0.f; acc2[i][j] = 0.f; }
  const int ar = tid >> 2, ak = (tid & 3) * 4;
  int arow = tm * 128 + ar; if (arow >= g.M) arow = g.M - 1;
  const size_t asrc = (size_t)(g.amap ? g.amap[arow] : arow) * g.lda;
  const int bk = tid >> 5, bn = (tid & 31) * 2;
  for (int k0 = 0; k0 < g.K; k0 += 16) {
    __syncthreads();
#pragma unroll
    for (int j = 0; j < 4; ++j) As[ak + j][ar] = bf2f(g.A[asrc + k0 + ak + j]);
#pragma unroll
    for (int j = 0; j < 2; ++j) {
      const int n = tn * 64 + bn + j;
      Bs[bk][bn + j] = n < g.N ? g.W[(size_t)(k0 + bk) * g.ldw + n] : 0.f;
      if (DUAL) Bs2[bk][bn + j] = n < g.N ? g.W2[(size_t)(k0 + bk) * g.ldw + n] : 0.f;
    }
    __syncthreads();
#pragma unroll
    for (int kk = 0; kk < 16; ++kk) {
      float a[4], b[4], b2[4];
#pragma unroll
      for (int i = 0; i < 4; ++i) a[i] = As[kk][ty * 4 + i];
#pragma unroll
      for (int j = 0; j < 4; ++j) { b[j] = Bs[kk][tx * 4 + j]; if (DUAL) b2[j] = Bs2[kk][tx * 4 + j]; }
#pragma unroll
      for (int i = 0; i < 4; ++i)
#pragma unroll
        for (int j = 0; j < 4; ++j) { acc[i][j] += a[i] * b[j]; if (DUAL) acc2[i][j] += a[i] * b2[j]; }
    }
  }
#pragma unroll
  for (int i = 0; i < 4; ++i) {
    const int m = tm * 128 + ty * 4 + i;
    if (m >= g.M) continue;
#pragma unroll
    for (int j = 0; j < 4; ++j) { const int n = tn * 64 + tx * 4 + j; if (n < g.N) epi(m, n, acc[i][j], acc2[i][j]); }
  }
}

struct EpiZ { bf16_t* z; __device__ void operator()(int m, int n, float a, float) const { z[(size_t)m * ZLD_ + n] = f2bf(a); } };
struct EpiOut { const float* modv; float* out; float* xc; int l; __device__ void operator()(int m, int n, float a, float) const {
    const int mi = row_modidx(m); const float ga1 = modv[((size_t)l * (B_ + 1) + mi) * 6 * D_ + 2 * D_ + n];
    float* xr = m < NTOK_ ? out + (size_t)m * D_ : xc + (size_t)(m - NTOK_) * D_; xr[n] += ga1 * a; } };
struct EpiHid { bf16_t* hid; int row0; __device__ void operator()(int m, int n, float a, float b) const { hid[(size_t)(row0 + m) * D_ + n] = f2bf(siluf_(a) * b); } };
struct EpiYe { bf16_t* ye; const float* gate; int row0; __device__ void operator()(int m, int n, float a, float) const { ye[(size_t)(row0 + m) * D_ + n] = f2bf(a * gate[row0 + m]); } };

__device__ __forceinline__ void phase_gemm_in(const Params& p, int l) {
  GemmDesc g; g.A = p.h; g.lda = D_; g.amap = nullptr; g.W = p.w_in + (size_t)l * D_ * INCOLS_; g.W2 = nullptr; g.ldw = INCOLS_; g.M = NROWS_; g.N = INCOLS_; g.K = D_;
  EpiZ epi{p.z};
  const int ntm = (NROWS_ + 127) / 128, ntn = (INCOLS_ + 63) / 64;
  for (int u = obid(); u < ntm * ntn; u += gridDim.x) gemm_tile_f32<false>(g, u / ntn, u % ntn, epi);
}
__device__ __forceinline__ void phase_gemm_out(const Params& p, int l) {
  const bool last = (l == DEPTH_ - 1);
  GemmDesc g; g.A = p.y; g.lda = D_; g.amap = nullptr; g.W = p.w_out + (size_t)l * D_ * D_; g.W2 = nullptr; g.ldw = D_; g.M = last ? NTOK_ : NROWS_; g.N = D_; g.K = D_;
  EpiOut epi{p.modv, p.out, p.xc, l};
  const int ntm = (g.M + 127) / 128, ntn = D_ / 64;
  for (int u = obid(); u < ntm * ntn; u += gridDim.x) gemm_tile_f32<false>(g, u / ntn, u % ntn, epi);
}
__device__ __forceinline__ int slot_expert(int slotrow) { return slotrow < XSLOTS_ ? slotrow / (B_ * CAP_) : (slotrow - XSLOTS_) / (B_ * CAPC_); }
__device__ __forceinline__ void phase_moe1(const Params& p, int l) {
  const bool last = (l == DEPTH_ - 1);
  const int M = last ? XSLOTS_ : XSLOTS_ + CSLOTS_;
  const int ntm = M / 128, ntn = D_ / 64;
  for (int u = obid(); u < ntm * ntn; u += gridDim.x) {
    const int tm = u / ntn, tn = u % ntn, e = slot_expert(tm * 128);
    GemmDesc g; g.A = p.h; g.lda = D_; g.amap = p.sel_idx + tm * 128; g.W = p.w_gate + ((size_t)l * NEXP_ + e) * D_ * D_; g.W2 = p.w_up + ((size_t)l * NEXP_ + e) * D_ * D_;
    g.ldw = D_; g.M = 128; g.N = D_; g.K = D_;
    EpiHid epi{p.hid, tm * 128};
    gemm_tile_f32<true>(g, 0, tn, epi);
  }
}
__device__ __forceinline__ void phase_moe2(const Params& p, int l) {
  const bool last = (l == DEPTH_ - 1);
  const int M = last ? XSLOTS_ : XSLOTS_ + CSLOTS_;
  const int ntm = M / 128, ntn = D_ / 64;
  for (int u = obid(); u < ntm * ntn; u += gridDim.x) {
    const int tm = u / ntn, tn = u % ntn, e = slot_expert(tm * 128);
    GemmDesc g; g.A = p.hid + (size_t)tm * 128 * D_; g.lda = D_; g.amap = nullptr; g.W = p.w_down + ((size_t)l * NEXP_ + e) * D_ * D_; g.W2 = nullptr;
    g.ldw = D_; g.M = 128; g.N = D_; g.K = D_;
    EpiYe epi{p.ye, p.sel_gate, tm * 128};
    gemm_tile_f32<false>(g, 0, tn, epi);
  }
}


#ifndef CPU_EMU
#define LAS __attribute__((address_space(3)))
namespace pg8 {
typedef short bf16x8 __attribute__((ext_vector_type(8)));
typedef float f32x4 __attribute__((ext_vector_type(4)));
typedef unsigned u32x4 __attribute__((ext_vector_type(4)));
constexpr int BM = 256, BK = 64, HALF = 128, HTB = HALF * BK * 2, STAGE_BYTES = 8 * HTB, NXCD = 8, WGM = 8;
__device__ __forceinline__ int lds_byte(int r, int c) { const int st = (r >> 4) * 2 + (c >> 5), rr = r & 15, cc = c & 31, ob = rr * 64 + cc * 2; return st * 1024 + (ob ^ (((ob >> 9) & 1) << 5)); }
__device__ __forceinline__ void stage_rc(int b, int& R, int& C) { const int st = b / 1024, sb = b % 1024, swz = sb ^ (((sb >> 9) & 1) << 5); R = (st >> 1) * 16 + swz / 64; C = (st & 1) * 32 + (swz % 64) / 2; }
__device__ __forceinline__ int perm32(int rho) { const int n = rho >> 4, i = rho & 15; return 8 * (i >> 2) + 4 * n + (i & 3); }
struct Unit { int pm, pn; };
__device__ __forceinline__ bool static_order(int i, int nM, int nN, int G, int c, Unit& u) {
    const int nwg = nM * nN; const long L = (long)i * G + c; if (L >= nwg) return false;
    int wgid = (int)L; { const int q = nwg / NXCD, r = nwg % NXCD, xcd = wgid % NXCD, off = wgid / NXCD; wgid = (xcd < r ? xcd * (q + 1) : r * (q + 1) + (xcd - r) * q) + off; }
    const int nig = WGM * nN, gid = wgid / nig, fm = gid * WGM, gsz = (nM - fm) < WGM ? (nM - fm) : WGM;
    u.pm = fm + ((wgid % nig) % gsz); u.pn = (wgid % nig) / gsz; return true;
}
__device__ __forceinline__ unsigned cvt_pk_bf16(float lo, float hi) { unsigned r; asm volatile("v_cvt_pk_bf16_f32 %0, %1, %2" : "=v"(r) : "v"(lo), "v"(hi)); return r; }

template <class P> __device__ __forceinline__ void gemm_phase(LAS unsigned char* lds, const P& prob) {
    const int tid = otid(), wid = __builtin_amdgcn_readfirstlane(tid >> 6), lane = tid & 63, wr = wid >> 2, wc = wid & 3, fr = lane & 15, fq = lane >> 4;
    constexpr int K = P::KDIM, KS = P::KSTR, nt = K / BK;
    unsigned voffB[2]; int sR[2], sC[2];
#pragma unroll
    for (int i = 0; i < 2; ++i) { int R, C; stage_rc(tid * 16 + i * 8192, R, C); sR[i] = R; sC[i] = C; const int Rb = P::PERM ? ((R & ~31) + perm32(R & 31)) : R; voffB[i] = (unsigned)(Rb * KS + C) * 2u; }
    constexpr size_t kstep = (size_t)(BK * 2);
    constexpr size_t hstep = (size_t)HALF * KS * 2;
    const unsigned ldsw = (unsigned)wid * 1024u;
    const int aoff = lds_byte(wr * 64 + fr, fq * 8), boff = lds_byte(wc * 32 + fr, fq * 8);
#define PG8_SA(b, h) (((b) * 2 + (h)) * HTB)
#define PG8_SB(b, h) ((4 + (b) * 2 + (h)) * HTB)
#define PG8_STAGE(bufoff, gbase, voff) do { _Pragma("unroll") for (int _i = 0; _i < 2; ++_i) \
        __builtin_amdgcn_global_load_lds((const unsigned*)((const char*)(gbase) + (voff)[_i]), (LAS unsigned*)(lds + (bufoff) + ldsw + _i * 8192), 16, 0, 0); } while (0)
#define PG8_LDA(dst, b, h) do { _Pragma("unroll") for (int m = 0; m < 4; ++m) _Pragma("unroll") for (int k = 0; k < 2; ++k) dst[m][k] = *(const LAS bf16x8*)(lds + PG8_SA(b, h) + aoff + m * 2048 + k * 1024); } while (0)
#define PG8_LDB(dst, b, h) do { _Pragma("unroll") for (int n = 0; n < 2; ++n) _Pragma("unroll") for (int k = 0; k < 2; ++k) dst[n][k] = *(const LAS bf16x8*)(lds + PG8_SB(b, h) + boff + n * 2048 + k * 1024); } while (0)
#define PG8_MMA(ai, bj, At, Bt) do { __builtin_amdgcn_s_setprio(1); _Pragma("unroll") for (int m = 0; m < 4; ++m) _Pragma("unroll") for (int n = 0; n < 2; ++n) _Pragma("unroll") for (int k = 0; k < 2; ++k) \
        acc[ai][bj][m][n] = __builtin_amdgcn_mfma_f32_16x16x32_bf16(Bt[n][k], At[m][k], acc[ai][bj][m][n], 0, 0, 0); __builtin_amdgcn_s_setprio(0); } while (0)
#define PG8_WAIT_V(n) asm volatile("s_waitcnt vmcnt(" #n ")" ::: "memory")
#define PG8_WAIT_L(n) asm volatile("s_waitcnt lgkmcnt(" #n ")" ::: "memory")
#define PG8_BAR __builtin_amdgcn_s_barrier()
#define PG8_SCHED __builtin_amdgcn_sched_barrier(0)
    Unit cur, nxt; int ui = 0;
    if (!prob.unit(0, cur)) return;
    f32x4 acc[2][2][4][2];
#pragma unroll
    for (int a = 0; a < 2; ++a)
#pragma unroll
        for (int b = 0; b < 2; ++b)
#pragma unroll
            for (int m = 0; m < 4; ++m)
#pragma unroll
                for (int n = 0; n < 2; ++n) acc[a][b][m][n] = (f32x4){0.f, 0.f, 0.f, 0.f};
    bf16x8 At[4][2], B0[2][2], B1[2][2];
    unsigned vc[2][2], vn[2][2];
#pragma unroll
    for (int h = 0; h < 2; ++h)
#pragma unroll
        for (int i = 0; i < 2; ++i) vc[h][i] = prob.a_voff(cur, h * HALF + sR[i], sC[i]);
    const char* Ab = prob.a_base();
    const char* cB = prob.b_base(cur);
    PG8_STAGE(PG8_SB(0, 0), cB, voffB); PG8_STAGE(PG8_SA(0, 0), Ab, vc[0]); PG8_STAGE(PG8_SB(0, 1), cB + hstep, voffB); PG8_STAGE(PG8_SA(0, 1), Ab, vc[1]);
    if (wr == 1) PG8_BAR;
    PG8_WAIT_V(4); PG8_BAR;
    PG8_STAGE(PG8_SB(1, 0), cB + kstep, voffB); PG8_STAGE(PG8_SA(1, 0), Ab + kstep, vc[0]); PG8_STAGE(PG8_SB(1, 1), cB + hstep + kstep, voffB);
    PG8_WAIT_V(6); PG8_BAR;
    for (;;) {
        const bool has_next = prob.unit(ui + 1, nxt);
        const char* nB = has_next ? prob.b_base(nxt) : cB;
#pragma unroll
        for (int h = 0; h < 2; ++h)
#pragma unroll
            for (int i = 0; i < 2; ++i) vn[h][i] = has_next ? prob.a_voff(nxt, h * HALF + sR[i], sC[i]) : vc[h][i];
        for (int t = 0; t < nt; t += 2) {
            const bool last = (t == nt - 2);
            const char* a1 = Ab + (size_t)(t + 1) * kstep;
            const char* a2 = last ? Ab : Ab + (size_t)(t + 2) * kstep; const char* b2 = last ? nB : cB + (size_t)(t + 2) * kstep;
            const char* a3 = a2 + kstep; const char* b3 = b2 + kstep;
            unsigned v2[2][2];
#pragma unroll
            for (int h = 0; h < 2; ++h)
#pragma unroll
                for (int i = 0; i < 2; ++i) v2[h][i] = last ? vn[h][i] : vc[h][i];
            PG8_LDB(B0, 0, 0); PG8_SCHED; PG8_LDA(At, 0, 0); PG8_STAGE(PG8_SA(1, 1), a1, vc[1]);
            PG8_WAIT_L(8); PG8_BAR; PG8_WAIT_L(0); PG8_MMA(0, 0, At, B0); PG8_BAR; PG8_SCHED;
            PG8_LDB(B1, 0, 1); PG8_STAGE(PG8_SB(0, 0), b2, voffB);
            PG8_BAR; PG8_WAIT_L(0); PG8_MMA(0, 1, At, B1); PG8_BAR;
            PG8_LDA(At, 0, 1); PG8_STAGE(PG8_SA(0, 0), a2, v2[0]);
            PG8_BAR; PG8_WAIT_L(0); PG8_MMA(1, 0, At, B0); PG8_BAR; PG8_SCHED;
            PG8_STAGE(PG8_SB(0, 1), b2 + hstep, voffB);
            PG8_WAIT_V(6); PG8_BAR; PG8_MMA(1, 1, At, B1); PG8_BAR;
            PG8_LDB(B0, 1, 0); PG8_SCHED; PG8_LDA(At, 1, 0); PG8_STAGE(PG8_SA(0, 1), a2, v2[1]);
            PG8_WAIT_L(8); PG8_BAR; PG8_WAIT_L(0); PG8_MMA(0, 0, At, B0); PG8_BAR; PG8_SCHED;
            PG8_LDB(B1, 1, 1); PG8_STAGE(PG8_SB(1, 0), b3, voffB);
            PG8_BAR; PG8_WAIT_L(0); PG8_MMA(0, 1, At, B1); PG8_BAR;
            PG8_LDA(At, 1, 1); PG8_STAGE(PG8_SA(1, 0), a3, v2[0]);
            PG8_BAR; PG8_WAIT_L(0); PG8_MMA(1, 0, At, B0); PG8_BAR; PG8_SCHED;
            PG8_STAGE(PG8_SB(1, 1), b3 + hstep, voffB);
            PG8_WAIT_V(6); PG8_BAR; PG8_MMA(1, 1, At, B1); PG8_BAR;
        }
        prob.epi(acc, cur, wr, wc, fr, fq);
        if (!has_next) break;
#pragma unroll
        for (int a = 0; a < 2; ++a)
#pragma unroll
            for (int b = 0; b < 2; ++b)
#pragma unroll
                for (int m = 0; m < 4; ++m)
#pragma unroll
                    for (int n = 0; n < 2; ++n) acc[a][b][m][n] = (f32x4){0.f, 0.f, 0.f, 0.f};
        cur = nxt; cB = nB; ++ui;
#pragma unroll
        for (int h = 0; h < 2; ++h)
#pragma unroll
            for (int i = 0; i < 2; ++i) vc[h][i] = vn[h][i];
    }
    PG8_WAIT_V(0);
    if (wr == 0) PG8_BAR;
    PG8_BAR;
#undef PG8_SA
#undef PG8_SB
#undef PG8_STAGE
#undef PG8_LDA
#undef PG8_LDB
#undef PG8_MMA
#undef PG8_WAIT_V
#undef PG8_WAIT_L
#undef PG8_BAR
#undef PG8_SCHED
}
typedef f32x4 Acc[2][2][4][2];

template <int KD, int LDC, int NTN, int KW = 0> struct ProbBf16 {
    static constexpr int KDIM = KW > 0 ? KW : KD, KSTR = KD;
    static constexpr bool PERM = true;
    __device__ __forceinline__ static int koff(int pn) { return (KW > 0 && pn >= 2) ? KD - KW : 0; }
    const bf16_t* A; const bf16_t* Bt; bf16_t* z; int G, c;
    __device__ __forceinline__ bool unit(int i, Unit& u) const { return static_order(i, NROWS_ / BM, NTN, G, c, u); }
    __device__ __forceinline__ const char* a_base() const { return (const char*)A; }
    __device__ __forceinline__ unsigned a_voff(const Unit& u, int r, int cc) const { return (unsigned)((u.pm * BM + r) * KD + koff(u.pn) + cc) * 2u; }
    __device__ __forceinline__ const char* b_base(const Unit& u) const { return (const char*)Bt + ((size_t)u.pn * BM * KD + koff(u.pn)) * 2; }
    __device__ __forceinline__ void epi(const Acc& acc, const Unit& u, int wr, int wc, int fr, int fq) const {
        const int row0 = u.pm * BM + wr * 64 + fr, col0 = u.pn * BM + wc * 32 + 8 * fq;
#pragma unroll
        for (int ai = 0; ai < 2; ++ai)
#pragma unroll
            for (int m = 0; m < 4; ++m) { bf16_t* rowp = z + (size_t)(row0 + ai * HALF + m * 16) * LDC + col0;
#pragma unroll
                for (int bj = 0; bj < 2; ++bj) { const f32x4 v0 = acc[ai][bj][m][0], v1 = acc[ai][bj][m][1];
                    u32x4 w; w.x = cvt_pk_bf16(v0[0], v0[1]); w.y = cvt_pk_bf16(v0[2], v0[3]); w.z = cvt_pk_bf16(v1[0], v1[1]); w.w = cvt_pk_bf16(v1[2], v1[3]);
                    *(u32x4*)(rowp + bj * HALF) = w; } }
    }
};
typedef ProbBf16<D_, ZLD_, ZLD_ / BM> ProbIn;
struct ProbOut {
    static constexpr int KDIM = D_, KSTR = D_;
    static constexpr bool PERM = false;
    const bf16_t* A; const bf16_t* Bt; float* out; float* xc; const float* modv_l; int nM, G, c;
    __device__ __forceinline__ bool unit(int i, Unit& u) const { return static_order(i, nM, D_ / BM, G, c, u); }
    __device__ __forceinline__ const char* a_base() const { return (const char*)A; }
    __device__ __forceinline__ unsigned a_voff(const Unit& u, int r, int cc) const { return (unsigned)((u.pm * BM + r) * D_ + cc) * 2u; }
    __device__ __forceinline__ const char* b_base(const Unit& u) const { return (const char*)Bt + (size_t)u.pn * BM * D_ * 2; }
    __device__ __forceinline__ void epi(const Acc& acc, const Unit& u, int wr, int wc, int fr, int fq) const {
        const int rt = u.pm * BM; const bool isx = rt < NTOK_;
        const int mi = isx ? rt / L_ : B_;
        float* xb = isx ? out + (size_t)rt * D_ : xc + (size_t)(rt - NTOK_) * D_;
        const int rl = wr * 64 + fr, col0 = u.pn * BM + wc * 32 + 4 * fq;
        const float* gp = modv_l + (size_t)mi * 6 * D_ + 2 * D_ + col0;
        f32x4 ga[2][2];
#pragma unroll
        for (int bj = 0; bj < 2; ++bj)
#pragma unroll
            for (int n = 0; n < 2; ++n) ga[bj][n] = *(const f32x4*)(gp + bj * HALF + n * 16);
#pragma unroll
        for (int ai = 0; ai < 2; ++ai)
#pragma unroll
          for (int mh = 0; mh < 2; ++mh) {
            f32x4 xv[2][2][2];
#pragma unroll
            for (int mm = 0; mm < 2; ++mm) { const float* rowp = xb + (size_t)(rl + ai * HALF + (mh * 2 + mm) * 16) * D_ + col0;
#pragma unroll
                for (int bj = 0; bj < 2; ++bj)
#pragma unroll
                    for (int n = 0; n < 2; ++n) xv[mm][bj][n] = *(const f32x4*)(rowp + bj * HALF + n * 16); }
#pragma unroll
            for (int mm = 0; mm < 2; ++mm) { float* rowp = xb + (size_t)(rl + ai * HALF + (mh * 2 + mm) * 16) * D_ + col0;
#pragma unroll
                for (int bj = 0; bj < 2; ++bj)
#pragma unroll
                    for (int n = 0; n < 2; ++n) *(f32x4*)(rowp + bj * HALF + n * 16) = xv[mm][bj][n] + ga[bj][n] * acc[ai][bj][mh * 2 + mm][n]; }
          }
    }
};
struct ProbMoe1 {
    static constexpr int KDIM = D_, KSTR = D_;
    static constexpr bool PERM = true;
    const bf16_t* A; const bf16_t* Bt; const int* sel; bf16_t* hid; int nM, G, c;
    __device__ __forceinline__ bool unit(int i, Unit& u) const { return static_order(i, nM, 2 * D_ / BM, G, c, u); }
    __device__ __forceinline__ const char* a_base() const { return (const char*)A; }
    __device__ __forceinline__ unsigned a_voff(const Unit& u, int r, int cc) const { return (unsigned)(sel[u.pm * BM + r] * D_ + cc) * 2u; }
    __device__ __forceinline__ const char* b_base(const Unit& u) const { const int rt = u.pm * BM; const int e = rt < XSLOTS_ ? rt / (B_ * CAP_) : (rt - XSLOTS_) / (B_ * CAPC_);
        return (const char*)Bt + ((size_t)e * 2 * D_ + (size_t)u.pn * BM) * D_ * 2; }
    __device__ __forceinline__ void epi(const Acc& acc, const Unit& u, int wr, int wc, int fr, int fq) const {
        const int row0 = u.pm * BM + wr * 64 + fr, col0 = u.pn * HALF + wc * 32 + 8 * fq;
#pragma unroll
        for (int ai = 0; ai < 2; ++ai)
#pragma unroll
            for (int m = 0; m < 4; ++m) { bf16_t* rowp = hid + (size_t)(row0 + ai * HALF + m * 16) * D_ + col0;
                float r[8];
#pragma unroll
                for (int n = 0; n < 2; ++n)
#pragma unroll
                    for (int j = 0; j < 4; ++j) { const float g = acc[ai][0][m][n][j], uu = acc[ai][1][m][n][j]; r[n * 4 + j] = g * __builtin_amdgcn_rcpf(1.0f + __expf(-g)) * uu; }
                u32x4 w; w.x = cvt_pk_bf16(r[0], r[1]); w.y = cvt_pk_bf16(r[2], r[3]); w.z = cvt_pk_bf16(r[4], r[5]); w.w = cvt_pk_bf16(r[6], r[7]);
                *(u32x4*)rowp = w; }
    }
};
struct ProbMoe2 {
    static constexpr int KDIM = D_, KSTR = D_;
    static constexpr bool PERM = true;
    const bf16_t* A; const bf16_t* Bt; const float* gate; bf16_t* ye; int nM, G, c;
    __device__ __forceinline__ bool unit(int i, Unit& u) const { return static_order(i, nM, D_ / BM, G, c, u); }
    __device__ __forceinline__ const char* a_base() const { return (const char*)A; }
    __device__ __forceinline__ unsigned a_voff(const Unit& u, int r, int cc) const { return (unsigned)((u.pm * BM + r) * D_ + cc) * 2u; }
    __device__ __forceinline__ const char* b_base(const Unit& u) const { const int rt = u.pm * BM; const int e = rt < XSLOTS_ ? rt / (B_ * CAP_) : (rt - XSLOTS_) / (B_ * CAPC_);
        return (const char*)Bt + ((size_t)e * D_ + (size_t)u.pn * BM) * D_ * 2; }
    __device__ __forceinline__ void epi(const Acc& acc, const Unit& u, int wr, int wc, int fr, int fq) const {
        const int row0 = u.pm * BM + wr * 64 + fr, col0 = u.pn * BM + wc * 32 + 8 * fq;
        float gts[2][4];
#pragma unroll
        for (int ai = 0; ai < 2; ++ai)
#pragma unroll
            for (int m = 0; m < 4; ++m) gts[ai][m] = gate[row0 + ai * HALF + m * 16];
        __builtin_amdgcn_sched_barrier(0);
#pragma unroll
        for (int ai = 0; ai < 2; ++ai)
#pragma unroll
            for (int m = 0; m < 4; ++m) { const int row = row0 + ai * HALF + m * 16; const float gt = gts[ai][m]; bf16_t* rowp = ye + (size_t)row * D_ + col0;
#pragma unroll
                for (int bj = 0; bj < 2; ++bj) { const f32x4 v0 = acc[ai][bj][m][0] * gt, v1 = acc[ai][bj][m][1] * gt;
                    u32x4 w; w.x = cvt_pk_bf16(v0[0], v0[1]); w.y = cvt_pk_bf16(v0[2], v0[3]); w.z = cvt_pk_bf16(v1[0], v1[1]); w.w = cvt_pk_bf16(v1[2], v1[3]);
                    *(u32x4*)(rowp + bj * HALF) = w; } }
    }
};
}

__device__ __forceinline__ void cvt_wave_tile(const float* src, int ld, int nvalid, int k0, int n0, bf16_t* dst, int dld, int dst_row0, int lane) {
  typedef float f32x4 __attribute__((ext_vector_type(4)));
  typedef unsigned u32x4 __attribute__((ext_vector_type(4)));
  const int n4 = lane >> 3, kq = lane & 7, n = n0 + 4 * n4;
  f32x4 r[8];
  const bool ok = n < nvalid;
#pragma unroll
  for (int j = 0; j < 8; ++j) r[j] = ok ? __builtin_nontemporal_load((const f32x4*)(src + (size_t)(k0 + 8 * kq + j) * ld + n)) : (f32x4){0.f, 0.f, 0.f, 0.f};
#pragma unroll
  for (int i = 0; i < 4; ++i) {
    u32x4 w; w.x = pg8::cvt_pk_bf16(r[0][i], r[1][i]); w.y = pg8::cvt_pk_bf16(r[2][i], r[3][i]); w.z = pg8::cvt_pk_bf16(r[4][i], r[5][i]); w.w = pg8::cvt_pk_bf16(r[6][i], r[7][i]);
    *(u32x4*)(dst + (size_t)(dst_row0 + 4 * n4 + i) * dld + k0 + 8 * kq) = w;
  }
}
__device__ __forceinline__ void phase_cvt_static(const Params& p) {
  const int tid = otid(), wave = tid >> 6, lane = tid & 63;
  constexpr int KT = D_ / 64, NTI = ZLD_ / 32, NTO = D_ / 32;
  const int nin = DEPTH_ * KT * NTI, nout = DEPTH_ * KT * NTO;
  for (int u = obid() * NWAVE + wave; u < nin + nout; u += gridDim.x * NWAVE) {
    if (u < nin) { const int l = u / (KT * NTI), r = u % (KT * NTI), kt = r / NTI, ntl = r % NTI;
      cvt_wave_tile(p.w_in + (size_t)l * D_ * INCOLS_, INCOLS_, INCOLS_, kt * 64, ntl * 32, p.wb_in + (size_t)l * ZLD_ * D_, D_, ntl * 32, lane); }
    else { const int v = u - nin; const int l = v / (KT * NTO), r = v % (KT * NTO), kt = r / NTO, ntl = r % NTO;
      cvt_wave_tile(p.w_out + (size_t)l * D_ * D_, D_, D_, kt * 64, ntl * 32, p.wb_out + (size_t)l * D_ * D_, D_, ntl * 32, lane); }
  }
}
__device__ __forceinline__ void cvt_moe_tile(const Params& p, int l, int u, int lane) {
  constexpr int KT = D_ / 64, NTL = D_ / 32, per = KT * NTL;
  const int mat = u / (NEXP_ * per), e = (u / per) % NEXP_, r = u % per, kt = r / NTL, ntl = r % NTL;
  const size_t so = ((size_t)l * NEXP_ + e) * D_ * D_;
  const int n0 = ntl * 32;
  if (mat == 0) cvt_wave_tile(p.w_gate + so, D_, D_, kt * 64, n0, p.wb_moe1 + (size_t)e * 2 * D_ * D_, D_, (n0 / 128) * 256 + (n0 % 128), lane);
  else if (mat == 1) cvt_wave_tile(p.w_up + so, D_, D_, kt * 64, n0, p.wb_moe1 + (size_t)e * 2 * D_ * D_, D_, (n0 / 128) * 256 + 128 + (n0 % 128), lane);
  else cvt_wave_tile(p.w_down + so, D_, D_, kt * 64, n0, p.wb_moe2 + (size_t)e * D_ * D_, D_, n0, lane);
}
typedef float cvt_f32x4 __attribute__((ext_vector_type(4)));
__device__ __forceinline__ void cvt_moe_tile_load(const Params& p, int l, int u, int lane, cvt_f32x4 (&r)[8]) {
  constexpr int KT = D_ / 64, NTL = D_ / 32, per = KT * NTL;
  const int mat = u / (NEXP_ * per), e = (u / per) % NEXP_, rr = u % per, kt = rr / NTL, ntl = rr % NTL;
  const float* src = (mat == 0 ? p.w_gate : mat == 1 ? p.w_up : p.w_down) + ((size_t)l * NEXP_ + e) * D_ * D_;
  const int n4 = lane >> 3, kq = lane & 7, n = ntl * 32 + 4 * n4;
#pragma unroll
  for (int j = 0; j < 8; ++j) r[j] = __builtin_nontemporal_load((const cvt_f32x4*)(src + (size_t)(kt * 64 + 8 * kq + j) * D_ + n));
}
__device__ __forceinline__ void cvt_moe_tile_store(const Params& p, int u, int lane, const cvt_f32x4 (&r)[8]) {
  typedef unsigned u32x4 __attribute__((ext_vector_type(4)));
  constexpr int KT = D_ / 64, NTL = D_ / 32, per = KT * NTL;
  const int mat = u / (NEXP_ * per), e = (u / per) % NEXP_, rr = u % per, kt = rr / NTL, ntl = rr % NTL;
  const int n0 = ntl * 32, n4 = lane >> 3, kq = lane & 7;
  bf16_t* dst; int row0;
  if (mat == 0) { dst = p.wb_moe1 + (size_t)e * 2 * D_ * D_; row0 = (n0 / 128) * 256 + (n0 % 128); }
  else if (mat == 1) { dst = p.wb_moe1 + (size_t)e * 2 * D_ * D_; row0 = (n0 / 128) * 256 + 128 + (n0 % 128); }
  else { dst = p.wb_moe2 + (size_t)e * D_ * D_; row0 = n0; }
#pragma unroll
  for (int i = 0; i < 4; ++i) {
    u32x4 w; w.x = pg8::cvt_pk_bf16(r[0][i], r[1][i]); w.y = pg8::cvt_pk_bf16(r[2][i], r[3][i]); w.z = pg8::cvt_pk_bf16(r[4][i], r[5][i]); w.w = pg8::cvt_pk_bf16(r[6][i], r[7][i]);
    *(u32x4*)(dst + (size_t)(row0 + 4 * n4 + i) * D_ + kt * 64 + 8 * kq) = w;
  }
}
__device__ __forceinline__ void phase_cvt_moe_steal(const Params& p, int l, LAS unsigned char* lds) {
  const int tid = otid(), wave = tid >> 6, lane = tid & 63;
  constexpr int total = 3 * NEXP_ * (D_ / 64) * (D_ / 32);
  unsigned* ctr = p.bar + 3584 + 64 * l;
  volatile LAS int* slot = (volatile LAS int*)(lds + 64);
  for (;;) {
    __syncthreads();
    if (tid == 0) *slot = (int)__hip_atomic_fetch_add(ctr, (unsigned)(2 * NWAVE), __ATOMIC_RELAXED, __HIP_MEMORY_SCOPE_AGENT);
    __syncthreads();
    const int t0 = *slot;
    if (t0 >= total) break;
#pragma unroll
    for (int j = 0; j < 2; ++j) { const int u = t0 + j * NWAVE + wave; if (u < total) cvt_moe_tile(p, l, u, lane); }
  }
}
__device__ __forceinline__ void phase_cvt_small(const Params& p) {
  const int tid = otid(), wave = tid >> 6, lane = tid & 63;
  typedef unsigned u32x4 __attribute__((ext_vector_type(4)));
  const int nchunk = DEPTH_ * ZS2W_ * (AUXW_ / 8);
  for (int idx = obid() * NT + tid; idx < nchunk; idx += gridDim.x * NT) {
    const int k8 = (idx % (AUXW_ / 8)) * 8, n = (idx / (AUXW_ / 8)) % ZS2W_, pn = n >> 8;
    const int lo = pn <= 1 ? 0 : pn <= 3 ? 128 : pn <= 5 ? 192 : 256, hi = pn <= 1 ? 128 : pn <= 3 ? 192 : pn <= 5 ? 256 : 384;
    if (k8 < lo || k8 >= hi) *(u32x4*)(p.bts + (size_t)idx * 8) = (u32x4){0u, 0u, 0u, 0u};
  }
  for (int u = obid() * NWAVE + wave; u < DEPTH_ * 80; u += gridDim.x * NWAVE) {
    const int l = u / 80; int r = u % 80; int pn, kt, ntl;
    if (r < 32) { pn = r / 16; r %= 16; kt = r / 8; ntl = r % 8; }
    else if (r < 64) { pn = 2 + (r - 32) / 8; kt = 0; ntl = (r - 32) % 8; }
    else { pn = 6; r -= 64; kt = r / 8; ntl = r % 8; }
    const float* src; int koff;
    if (pn == 0) { src = p.w_uk + (size_t)l * KVR_ * GWID_; koff = 0; }
    else if (pn == 1) { src = p.w_uv + (size_t)l * KVR_ * GWID_; koff = 0; }
    else if (pn <= 3) { src = p.rwkv_w2 + ((size_t)l * 2 + (pn - 2)) * DLORA_ * GWID_; koff = 128; }
    else if (pn <= 5) { src = p.rwkv_a2 + ((size_t)l * 2 + (pn - 4)) * ALORA_ * GWID_; koff = 192; }
    else { src = p.rwkv_g2 + (size_t)l * GLORA_ * GWID_; koff = 256; }
    cvt_wave_tile(src, GWID_, GWID_, kt * 64, ntl * 32, p.bts + (size_t)l * ZS2W_ * AUXW_ + koff, AUXW_, pn * 256 + ntl * 32, lane);
  }
}
__device__ __forceinline__ void phase_gemm_small_mfma(const Params& p, int l, LAS unsigned char* lds) {
  pg8::ProbBf16<AUXW_, ZS2W_, ZS2W_ / 256, 256> pr; pr.A = p.aux; pr.Bt = p.bts + (size_t)l * ZS2W_ * AUXW_; pr.z = p.zs2; pr.G = gridDim.x; pr.c = obid();
  pg8::gemm_phase(lds, pr);
}
__device__ __forceinline__ void phase_gemm_in_mfma(const Params& p, int l, LAS unsigned char* lds) {
  pg8::ProbIn pr; pr.A = p.h; pr.Bt = p.wb_in + (size_t)l * ZLD_ * D_; pr.z = p.z; pr.G = gridDim.x; pr.c = obid();
  pg8::gemm_phase(lds, pr);
}
__device__ __forceinline__ void phase_gemm_out_mfma(const Params& p, int l, LAS unsigned char* lds) {
  pg8::ProbOut pr; pr.A = p.y; pr.Bt = p.wb_out + (size_t)l * D_ * D_; pr.out = p.out; pr.xc = p.xc; pr.modv_l = p.modv + (size_t)l * (B_ + 1) * 6 * D_;
  pr.nM = (l == DEPTH_ - 1 ? NTOK_ : NROWS_) / 256; pr.G = gridDim.x; pr.c = obid();
  pg8::gemm_phase(lds, pr);
}
__device__ __forceinline__ void phase_moe1_mfma(const Params& p, int l, LAS unsigned char* lds) {
  pg8::ProbMoe1 pr; pr.A = p.h; pr.Bt = p.wb_moe1; pr.sel = p.sel_idx; pr.hid = p.hid; pr.nM = (l == DEPTH_ - 1 ? XSLOTS_ : XSLOTS_ + CSLOTS_) / 256; pr.G = gridDim.x; pr.c = obid();
  pg8::gemm_phase(lds, pr);
}
__device__ __forceinline__ void phase_moe2_mfma(const Params& p, int l, LAS unsigned char* lds) {
  pg8::ProbMoe2 pr; pr.A = p.hid; pr.Bt = p.wb_moe2; pr.gate = p.sel_gate; pr.ye = p.ye; pr.nM = (l == DEPTH_ - 1 ? XSLOTS_ : XSLOTS_ + CSLOTS_) / 256; pr.G = gridDim.x; pr.c = obid();
  pg8::gemm_phase(lds, pr);
}
#endif


#if D_ == 1024 && HD_ == 64 && KVR_ == 128 && DLORA_ == 64 && ALORA_ == 64 && GLORA_ == 128
#define HAVE_PREPA 1
struct U2_ { unsigned x, y; };
struct U4_ { unsigned x, y, z, w; };
__device__ __forceinline__ float bflo(unsigned u) { union { unsigned u; float f; } x; x.u = u << 16; return x.f; }
__device__ __forceinline__ float bfhi(unsigned u) { union { unsigned u; float f; } x; x.u = u & 0xFFFF0000u; return x.f; }
__device__ __forceinline__ unsigned pk2(float a, float b) { return (unsigned)f2bf(a) | ((unsigned)f2bf(b) << 16); }
__device__ __forceinline__ void ld2(const bf16_t* p, float* o) { const unsigned u = *(const unsigned*)p; o[0] = bflo(u); o[1] = bfhi(u); }
__device__ __forceinline__ void ld4(const bf16_t* p, float* o) { const U2_ u = *(const U2_*)p; o[0] = bflo(u.x); o[1] = bfhi(u.x); o[2] = bflo(u.y); o[3] = bfhi(u.y); }
__device__ __forceinline__ void ld8(const bf16_t* p, float* o) { const U4_ u = *(const U4_*)p; o[0] = bflo(u.x); o[1] = bfhi(u.x); o[2] = bflo(u.y); o[3] = bfhi(u.y); o[4] = bflo(u.z); o[5] = bfhi(u.z); o[6] = bflo(u.w); o[7] = bfhi(u.w); }
__device__ __forceinline__ void st2(bf16_t* p, const float* v) { *(unsigned*)p = pk2(v[0], v[1]); }
__device__ __forceinline__ void st4(bf16_t* p, const float* v) { U2_ u; u.x = pk2(v[0], v[1]); u.y = pk2(v[2], v[3]); *(U2_*)p = u; }
__device__ __forceinline__ void st8(bf16_t* p, const float* v) { U4_ u; u.x = pk2(v[0], v[1]); u.y = pk2(v[2], v[3]); u.z = pk2(v[4], v[5]); u.w = pk2(v[6], v[7]); *(U4_*)p = u; }
__device__ __forceinline__ void unp2(unsigned u, float* o) { o[0] = bflo(u); o[1] = bfhi(u); }
__device__ __forceinline__ void unp4(U2_ u, float* o) { o[0] = bflo(u.x); o[1] = bfhi(u.x); o[2] = bflo(u.y); o[3] = bfhi(u.y); }
__device__ __forceinline__ void unp8(U4_ u, float* o) { o[0] = bflo(u.x); o[1] = bfhi(u.x); o[2] = bflo(u.y); o[3] = bfhi(u.y); o[4] = bflo(u.z); o[5] = bfhi(u.z); o[6] = bflo(u.w); o[7] = bfhi(u.w); }
struct RawA { U2_ bb, cg, hh, cgp, hp, cgn, hn, qn; unsigned qr, c2, kr; U4_ a, ap, an, b, bp, bn; U2_ q, k, v, g; float tc0, ts0, tc1, ts1; F4_ rc4, rs4; };
struct ParA { F4_ w0, w1, w2, go, gq4, ma0, ma1, mb0, mb1, kk0, kk1; float gq_r0, gq_r1, gkv0, gkv1, gk0, gk1; };
__device__ __forceinline__ void prepA_params(const Params& p, int l, int lane, ParA& P) {
  const int c4 = 4 * lane, sub = lane & 15;
  const float* cw = p.conv_w + (size_t)l * 3 * GWID_ + c4;
  P.w0 = *(const F4_*)cw; P.w1 = *(const F4_*)(cw + GWID_); P.w2 = *(const F4_*)(cw + 2 * GWID_); P.go = *(const F4_*)(p.g_out_conv + l * GWID_ + c4);
  const float* gq = p.g_q_norm + (size_t)l * QK_;
  P.gq4 = *(const F4_*)(gq + 4 * sub); P.gq_r0 = gq[HD_ + 2 * sub]; P.gq_r1 = gq[HD_ + 2 * sub + 1];
  P.gkv0 = p.g_kv_norm[l * KVR_ + 2 * lane]; P.gkv1 = p.g_kv_norm[l * KVR_ + 2 * lane + 1];
  const float* gk = p.g_k_norm + (size_t)l * QK_ + HD_; P.gk0 = gk[2 * sub]; P.gk1 = gk[2 * sub + 1];
  const float* mu = p.rwkv_mu + (size_t)l * COLS_RWKV_;
  P.ma0 = *(const F4_*)(mu + 8 * lane); P.ma1 = *(const F4_*)(mu + 8 * lane + 4); P.mb0 = *(const F4_*)(mu + 512 + 8 * lane); P.mb1 = *(const F4_*)(mu + 512 + 8 * lane + 4);
  const int kch = 8 * (lane & 31);
  P.kk0 = *(const F4_*)(p.rwkv_k_k + l * GWID_ + kch); P.kk1 = *(const F4_*)(p.rwkv_k_k + l * GWID_ + kch + 4);
}
__device__ __forceinline__ void prepA_load(const Params& p, int row, int lane, RawA& r) {
  const int c4 = 4 * lane, head = lane >> 4, sub = lane & 15;
  const int pos = row_pos(row), len = row_len(row);
  const bf16_t* zr = p.z + (size_t)row * ZLD_;
  const bool hasp = pos > 0, hasn = pos < len - 1;
  const bf16_t* zp = hasp ? zr - ZLD_ : zr; const bf16_t* zn = hasn ? zr + ZLD_ : zr;
  const bf16_t* zm = zr + MLA0_;
  const bf16_t* zw = zr + RW0_; const bf16_t* zwp = zp + RW0_; const bf16_t* zwn = zn + RW0_;
  const bf16_t* zt = zr + RT0_;
  r.bb = *(const U2_*)(zr + c4); r.cg = *(const U2_*)(zr + GWID_ + c4); r.hh = *(const U2_*)(zr + 2 * GWID_ + c4);
  r.cgp = *(const U2_*)(zp + GWID_ + c4); r.hp = *(const U2_*)(zp + 2 * GWID_ + c4); r.cgn = *(const U2_*)(zn + GWID_ + c4); r.hn = *(const U2_*)(zn + 2 * GWID_ + c4);
  r.qn = *(const U2_*)(zm + head * HD_ + 4 * sub);
  r.qr = *(const unsigned*)(zm + NH_ * HD_ + head * ROPE_ + 2 * sub); r.c2 = *(const unsigned*)(zm + NH_ * QK_ + 2 * lane); r.kr = *(const unsigned*)(zm + NH_ * QK_ + KVR_ + 2 * sub);
  r.a = *(const U4_*)(zw + 8 * lane); r.ap = *(const U4_*)(zwp + 8 * lane); r.an = *(const U4_*)(zwn + 8 * lane);
  r.b = *(const U4_*)(zw + 512 + 8 * lane); r.bp = *(const U4_*)(zwp + 512 + 8 * lane); r.bn = *(const U4_*)(zwn + 512 + 8 * lane);
  r.q = *(const U2_*)(zt + c4); r.k = *(const U2_*)(zt + GWID_ + c4); r.v = *(const U2_*)(zt + 2 * GWID_ + c4); r.g = *(const U2_*)(zt + 3 * GWID_ + c4);
  { const float* tab = p.tab_mla + (size_t)pos * 32; const int ax = sub >> 3, f0 = (2 * sub) & 7;
    r.tc0 = tab[(ax * 2) * 8 + f0]; r.ts0 = tab[(ax * 2 + 1) * 8 + f0]; r.tc1 = tab[(ax * 2) * 8 + f0 + 1]; r.ts1 = tab[(ax * 2 + 1) * 8 + f0 + 1];
    const float* tr = p.tab_ret + (size_t)pos * HD_; const int fr0 = 4 * (lane & 7); r.rc4 = *(const F4_*)(tr + fr0); r.rs4 = *(const F4_*)(tr + HD_ / 2 + fr0); }
}
__device__ __forceinline__ void prepA_compute(const Params& p, int l, int row, int lane, const RawA& R, const ParA& P) {
  const bool last = (l == DEPTH_ - 1);
  const int c4 = 4 * lane, head = lane >> 4, sub = lane & 15;
  const bool isx = row < NTOK_;
  const int pos = row_pos(row), len = row_len(row);
  const bool hasp = pos > 0, hasn = pos < len - 1;
  const float fp = hasp ? 1.f : 0.f, fn = hasn ? 1.f : 0.f;
  const bool need_out = isx || !last;
  const U2_ r_bb = R.bb, r_cg = R.cg, r_hh = R.hh, r_cgp = R.cgp, r_hp = R.hp, r_cgn = R.cgn, r_hn = R.hn, r_qn = R.qn;
  const unsigned r_qr = R.qr, r_c2 = R.c2, r_kr = R.kr;
  const U4_ r_a = R.a, r_ap = R.ap, r_an = R.an, r_b = R.b, r_bp = R.bp, r_bn = R.bn;
  const U2_ r_q = R.q, r_k = R.k, r_v = R.v, r_g = R.g;
  {
    if (need_out) {
      float bb[4], cg[4], hh[4], cgp[4], hp[4], cgn[4], hn[4], t[4];
      unp4(r_bb, bb); unp4(r_cg, cg); unp4(r_hh, hh); unp4(r_cgp, cgp); unp4(r_hp, hp); unp4(r_cgn, cgn); unp4(r_hn, hn);
      const F4_ w0 = P.w0, w1 = P.w1, w2 = P.w2, go = P.go;
      const float w0a[4] = {w0.x, w0.y, w0.z, w0.w}, w1a[4] = {w1.x, w1.y, w1.z, w1.w}, w2a[4] = {w2.x, w2.y, w2.z, w2.w}, goa[4] = {go.x, go.y, go.z, go.w};
      float ss = 0.f;
#pragma unroll
      for (int j = 0; j < 4; ++j) { const float yv = w0a[j] * (fp * cgp[j] * hp[j]) + w1a[j] * (cg[j] * hh[j]) + w2a[j] * (fn * cgn[j] * hn[j]); t[j] = bb[j] * yv; ss += t[j] * t[j]; }
      ss = wave_sum(ss);
      const float rstd = rsqrtf(ss / (float)GWID_ + 1e-6f);
#pragma unroll
      for (int j = 0; j < 4; ++j) t[j] = t[j] * rstd * goa[j];
      st4(p.y + (size_t)row * D_ + c4, t);
    }
    {
      float qn[4], qr[2];
      unp4(r_qn, qn); unp2(r_qr, qr);
      float ss = qn[0] * qn[0] + qn[1] * qn[1] + qn[2] * qn[2] + qn[3] * qn[3] + qr[0] * qr[0] + qr[1] * qr[1];
      ss += __shfl_xor(ss, 1); ss += __shfl_xor(ss, 2); ss += __shfl_xor(ss, 4); ss += __shfl_xor(ss, 8);
      const float rs = rsqrtf(ss / (float)QK_ + 1e-6f) * 0.10206207261596575f;
      const F4_ gq4 = P.gq4;
      qn[0] *= rs * gq4.x; qn[1] *= rs * gq4.y; qn[2] *= rs * gq4.z; qn[3] *= rs * gq4.w;
      float v0 = qr[0] * rs * P.gq_r0, v1 = qr[1] * rs * P.gq_r1;
      const float p0 = __shfl_xor(v0, 4), p1 = __shfl_xor(v1, 4);
      if (isx) {
        const int half = (sub >> 2) & 1;
        const float c0 = R.tc0, s0 = R.ts0, c1 = R.tc1, s1 = R.ts1;
        v0 = half == 0 ? v0 * c0 - p0 * s0 : p0 * s0 + v0 * c0;
        v1 = half == 0 ? v1 * c1 - p1 * s1 : p1 * s1 + v1 * c1;
      }
      if (need_out) { bf16_t* qd = p.qb + ((size_t)row * NH_ + head) * QK_; st4(qd + 4 * sub, qn); float o2[2] = {v0, v1}; st2(qd + HD_ + 2 * sub, o2); }
    }
    {
      float c2[2]; unp2(r_c2, c2);
      const float ss = wave_sum(c2[0] * c2[0] + c2[1] * c2[1]);
      const float rstd = rsqrtf(ss / (float)KVR_ + 1e-6f);
      float o2[2] = {c2[0] * rstd * P.gkv0, c2[1] * rstd * P.gkv1};
      st2(p.aux + (size_t)row * AUXW_ + 2 * lane, o2);
      float kr[2]; unp2(r_kr, kr);
      float s2 = kr[0] * kr[0] + kr[1] * kr[1];
      s2 += __shfl_xor(s2, 1); s2 += __shfl_xor(s2, 2); s2 += __shfl_xor(s2, 4); s2 += __shfl_xor(s2, 8);
      float v0 = kr[0] * P.gk0, v1 = kr[1] * P.gk1;
      const float p0 = __shfl_xor(v0, 4), p1 = __shfl_xor(v1, 4);
      if (isx) {
        const int half = (sub >> 2) & 1;
        const float c0 = R.tc0, s0 = R.ts0, c1 = R.tc1, s1 = R.ts1;
        v0 = half == 0 ? v0 * c0 - p0 * s0 : p0 * s0 + v0 * c0;
        v1 = half == 0 ? v1 * c1 - p1 * s1 : p1 * s1 + v1 * c1;
      }
      if (lane < 16) { float o[2] = {v0, v1}; st2(p.krp + (size_t)row * ROPE_ + 2 * sub, o); if (lane == 0) p.kr2[row] = s2; }
    }
    {
      float a[8], ap[8], an[8], bq[8], bp[8], bn[8];
      unp8(r_a, a); unp8(r_ap, ap); unp8(r_an, an); unp8(r_b, bq); unp8(r_bp, bp); unp8(r_bn, bn);
      const F4_ ma0 = P.ma0, ma1 = P.ma1, mb0 = P.mb0, mb1 = P.mb1;
      const float mua[8] = {ma0.x, ma0.y, ma0.z, ma0.w, ma1.x, ma1.y, ma1.z, ma1.w}, mub[8] = {mb0.x, mb0.y, mb0.z, mb0.w, mb1.x, mb1.y, mb1.z, mb1.w};
#pragma unroll
      for (int j = 0; j < 8; ++j) { a[j] = a[j] + mua[j] * (0.5f * (fp * ap[j] + fn * an[j]) - a[j]); bq[j] = bq[j] + mub[j] * (0.5f * (fp * bp[j] + fn * bn[j]) - bq[j]); }
      {
        const int kch = 8 * (lane & 31);
        const F4_ kk0 = P.kk0, kk1 = P.kk1;
        const float kkw[8] = {kk0.x, kk0.y, kk0.z, kk0.w, kk1.x, kk1.y, kk1.z, kk1.w};
        float kkr[8]; float s2 = 0.f;
#pragma unroll
        for (int j = 0; j < 8; ++j) { kkr[j] = a[j] * kkw[j]; s2 += kkr[j] * kkr[j]; }
        s2 += __shfl_xor(s2, 1); s2 += __shfl_xor(s2, 2); s2 += __shfl_xor(s2, 4);
        const float inv = rsqrtf(s2 + 1e-12f);
        if (lane < 32) { F4_* d = (F4_*)(p.sc_r + (size_t)row * GWID_ + kch); F4_ o0 = {a[0], a[1], a[2], a[3]}, o1 = {a[4], a[5], a[6], a[7]}; d[0] = o0; d[1] = o1; }
        else { st8(p.kbuf + (size_t)row * GWID_ + kch, a); F4_* d = (F4_*)(p.sc_kk + (size_t)row * GWID_ + kch);
          F4_ o0 = {kkr[0] * inv, kkr[1] * inv, kkr[2] * inv, kkr[3] * inv}, o1 = {kkr[4] * inv, kkr[5] * inv, kkr[6] * inv, kkr[7] * inv}; d[0] = o0; d[1] = o1; }
      }
      if (lane < 32) { F4_* d = (F4_*)(p.sc_v + (size_t)row * GWID_ + 8 * lane); F4_ o0 = {bq[0], bq[1], bq[2], bq[3]}, o1 = {bq[4], bq[5], bq[6], bq[7]}; d[0] = o0; d[1] = o1; }
      else {
        float o[8];
        if (lane < 40) {
#pragma unroll
          for (int j = 0; j < 8; ++j) o[j] = tanhf_(bq[j]); }
        else if (lane < 48) {
#pragma unroll
          for (int j = 0; j < 8; ++j) o[j] = bq[j]; }
        else {
#pragma unroll
          for (int j = 0; j < 8; ++j) o[j] = sigmoidf_(bq[j]); }
        st8(p.aux + (size_t)row * AUXW_ + KVR_ + 8 * (lane - 32), o);
      }
    }
    {
      float q[4], k[4];
      unp4(r_q, q); unp4(r_k, k);
#pragma unroll
      for (int j = 0; j < 4; ++j) q[j] *= 0.125f;
      float pq[4], pk[4];
#pragma unroll
      for (int j = 0; j < 4; ++j) { pq[j] = __shfl_xor(q[j], 8); pk[j] = __shfl_xor(k[j], 8); }
      if (isx) {
        const int half = (lane >> 3) & 1, f0 = 4 * (lane & 7);
        const F4_ c4v = R.rc4, s4v = R.rs4;
        const float csa[4] = {c4v.x, c4v.y, c4v.z, c4v.w}, sna[4] = {s4v.x, s4v.y, s4v.z, s4v.w};
#pragma unroll
        for (int j = 0; j < 4; ++j) { const float cs = csa[j], sn = sna[j];
          q[j] = half == 0 ? q[j] * cs - pq[j] * sn : pq[j] * sn + q[j] * cs;
          k[j] = half == 0 ? k[j] * cs - pk[j] * sn : pk[j] * sn + k[j] * cs; }
      }
      st4(p.rq + (size_t)row * GWID_ + c4, q); st4(p.rk + (size_t)row * GWID_ + c4, k);
      *(U2_*)(p.rv + (size_t)row * GWID_ + c4) = r_v;
      float g4[4]; unp4(r_g, g4);
#pragma unroll
      for (int j = 0; j < 4; ++j) g4[j] = siluf_(g4[j]);
      st4(p.rg + (size_t)row * GWID_ + c4, g4);
    }
  }
}
__device__ __forceinline__ void phase_prepA(const Params& p, int l) {
  const int tid = otid(), wave = tid >> 6, lane = tid & 63;
  const int stride = gridDim.x * NWAVE;
  int row = obid() * NWAVE + wave;
  if (row >= NROWS_) return;
  ParA P; prepA_params(p, l, lane, P);
  RawA cur; prepA_load(p, row, lane, cur);
  for (; row < NROWS_; row += stride) {
    RawA nxt; const bool has = row + stride < NROWS_;
    prepA_load(p, has ? row + stride : row, lane, nxt);
    prepA_compute(p, l, row, lane, cur, P);
    cur = nxt;
  }
}
__device__ __forceinline__ void phase_prepB_naive(const Params& p, int l) {
  const int tid = otid(), wave = tid >> 6, lane = tid & 63;
  for (int row = obid() * NWAVE + wave; row < NROWS_; row += gridDim.x * NWAVE) {
    const bf16_t* ax = p.aux + (size_t)row * AUXW_;
    for (int n = lane; n < ZS2W_; n += 64) {
      const int pn = n >> 8, ch = n & 255; float acc = 0.f;
      if (pn == 0) for (int k = 0; k < 128; ++k) acc += bf2f(ax[k]) * p.w_uk[((size_t)l * KVR_ + k) * GWID_ + ch];
      else if (pn == 1) for (int k = 0; k < 128; ++k) acc += bf2f(ax[k]) * p.w_uv[((size_t)l * KVR_ + k) * GWID_ + ch];
      else if (pn <= 3) for (int k = 0; k < 64; ++k) acc += bf2f(ax[128 + k]) * p.rwkv_w2[(((size_t)l * 2 + (pn - 2)) * DLORA_ + k) * GWID_ + ch];
      else if (pn <= 5) for (int k = 0; k < 64; ++k) acc += bf2f(ax[192 + k]) * p.rwkv_a2[(((size_t)l * 2 + (pn - 4)) * ALORA_ + k) * GWID_ + ch];
      else for (int k = 0; k < 128; ++k) acc += bf2f(ax[256 + k]) * p.rwkv_g2[((size_t)l * GLORA_ + k) * GWID_ + ch];
      p.zs2[(size_t)row * ZS2W_ + n] = f2bf(acc);
    }
  }
}
struct RawC { U2_ kn, v, lw0, lw1, la0, la1, k0; F4_ kk, rr; unsigned kr; float kr2; };
__device__ __forceinline__ void prepC_load(const Params& p, int row, int lane, RawC& r) {
  const int head = lane >> 4, sub = lane & 15, ch = 64 * head + 4 * sub;
  const bf16_t* zs = p.zs2 + (size_t)row * ZS2W_;
  r.kn = *(const U2_*)(zs + ch); r.v = *(const U2_*)(zs + 256 + ch); r.lw0 = *(const U2_*)(zs + 512 + ch); r.lw1 = *(const U2_*)(zs + 768 + ch);
  r.la0 = *(const U2_*)(zs + 1024 + ch); r.la1 = *(const U2_*)(zs + 1280 + ch);
  r.kk = *(const F4_*)(p.sc_kk + (size_t)row * GWID_ + ch); r.rr = *(const F4_*)(p.sc_r + (size_t)row * GWID_ + ch);
  r.k0 = *(const U2_*)(p.kbuf + (size_t)row * GWID_ + ch);
  r.kr = *(const unsigned*)(p.krp + (size_t)row * ROPE_ + 2 * sub);
  r.kr2 = p.kr2[row];
}
__device__ __forceinline__ void phase_prepC(const Params& p, int l) {
  const int tid = otid(), wave = tid >> 6, lane = tid & 63;
  const int head = lane >> 4, sub = lane & 15, ch = 64 * head + 4 * sub;
  const int stride = gridDim.x * NWAVE;
  int row = obid() * NWAVE + wave;
  if (row >= NROWS_) return;
  const F4_ gk4 = *(const F4_*)(p.g_k_norm + (size_t)l * QK_ + 4 * sub);
  const F4_ w00 = *(const F4_*)(p.rwkv_w0 + (l * 2 + 0) * GWID_ + ch), w01 = *(const F4_*)(p.rwkv_w0 + (l * 2 + 1) * GWID_ + ch);
  const F4_ a00 = *(const F4_*)(p.rwkv_a0 + (l * 2 + 0) * GWID_ + ch), a01 = *(const F4_*)(p.rwkv_a0 + (l * 2 + 1) * GWID_ + ch);
  const F4_ ka4 = *(const F4_*)(p.rwkv_k_a + l * GWID_ + ch), rk4 = *(const F4_*)(p.rwkv_r_k + l * GWID_ + ch);
  RawC cur; prepC_load(p, row, lane, cur);
  for (; row < NROWS_; row += stride) {
    RawC nxt; const bool has = row + stride < NROWS_;
    prepC_load(p, has ? row + stride : row, lane, nxt);
    const bool isx = row < NTOK_; const int pos = row_pos(row), b = row_batch(row);
    const int kpos = isx ? LC_ + pos : pos;
    const U2_ r_kn = cur.kn, r_v = cur.v, r_lw0 = cur.lw0, r_lw1 = cur.lw1, r_la0 = cur.la0, r_la1 = cur.la1, r_k0 = cur.k0;
    const F4_ r_kk = cur.kk, r_rr = cur.rr; const unsigned r_kr = cur.kr; const float kr2 = cur.kr2;
    {
      float kn[4]; unp4(r_kn, kn);
      float ss = kn[0] * kn[0] + kn[1] * kn[1] + kn[2] * kn[2] + kn[3] * kn[3];
      ss += __shfl_xor(ss, 1); ss += __shfl_xor(ss, 2); ss += __shfl_xor(ss, 4); ss += __shfl_xor(ss, 8);
      const float rstd = rsqrtf((ss + kr2) / (float)QK_ + 1e-6f);
      bf16_t* kd = p.kb + (((size_t)b * NH_ + head) * LK_ + kpos) * KLD_;
      kn[0] *= rstd * gk4.x; kn[1] *= rstd * gk4.y; kn[2] *= rstd * gk4.z; kn[3] *= rstd * gk4.w;
      st4(kd + 4 * sub, kn);
      float kr[2]; unp2(r_kr, kr); kr[0] *= rstd; kr[1] *= rstd;
      st2(kd + HD_ + 2 * sub, kr);
      *(unsigned*)(kd + QK_ + 2 * sub) = 0u;
      *(U2_*)(p.vb + (((size_t)b * NH_ + head) * LK_ + kpos) * HD_ + 4 * sub) = r_v;
    }
    {
      const float kk[4] = {r_kk.x, r_kk.y, r_kk.z, r_kk.w}, rr[4] = {r_rr.x, r_rr.y, r_rr.z, r_rr.w};
      const float kaa[4] = {ka4.x, ka4.y, ka4.z, ka4.w}, rka[4] = {rk4.x, rk4.y, rk4.z, rk4.w};
      float k0[4]; unp4(r_k0, k0);
      float bsum = 0.f;
#pragma unroll
      for (int d = 0; d < 2; ++d) {
        float lw[4], la[4];
        unp4(d == 0 ? r_lw0 : r_lw1, lw); unp4(d == 0 ? r_la0 : r_la1, la);
        const F4_ w0v = d == 0 ? w00 : w01, a0v = d == 0 ? a00 : a01;
        const float w0a[4] = {w0v.x, w0v.y, w0v.z, w0v.w}, a0a[4] = {a0v.x, a0v.y, a0v.z, a0v.w};
        float ow[4], oka[4], okt[4];
#pragma unroll
        for (int j = 0; j < 4; ++j) {
          const float x = lw[j] + w0a[j];
          const float sp = softplus_neg_(x);
          ow[j] = fexp_(-fexp_(-sp - 0.5f));
          const float a = sigmoidf_(la[j] + a0a[j]);
          const float kt = k0[j] * (1.0f + (a - 1.0f) * kaa[j]);
          oka[j] = kk[j] * a; okt[j] = kt; bsum += rr[j] * kt * rka[j];
        }
        const size_t o = ((size_t)d * NROWS_ + row) * GWID_ + ch;
        { F4_ t = {ow[0], ow[1], ow[2], ow[3]}; *(F4_*)(p.sc_w + o) = t; }
        { F4_ t = {oka[0], oka[1], oka[2], oka[3]}; *(F4_*)(p.sc_kka + o) = t; }
        { F4_ t = {okt[0], okt[1], okt[2], okt[3]}; *(F4_*)(p.sc_kt + o) = t; }
      }
      bsum += __shfl_xor(bsum, 1); bsum += __shfl_xor(bsum, 2); bsum += __shfl_xor(bsum, 4); bsum += __shfl_xor(bsum, 8);
      if (sub == 0) { p.sc_bonus[(size_t)row * NH_ + head] = bsum; p.sc_bonus[(size_t)(NROWS_ + row) * NH_ + head] = 0.f; }
    }
    cur = nxt;
  }
}
struct RawP { F4_ ob, y0, y1, v; U2_ gt; float bon; };
__device__ __forceinline__ void post_load(const Params& p, int row, int lane, RawP& r) {
  const int ch = 4 * lane, head = lane >> 4; const size_t o = (size_t)row * GWID_ + ch;
  r.ob = *(const F4_*)(p.ob + o); r.y0 = *(const F4_*)(p.ys + o); r.y1 = *(const F4_*)(p.ys + (size_t)NROWS_ * GWID_ + o);
  r.v = *(const F4_*)(p.sc_v + o); r.gt = *(const U2_*)(p.zs2 + (size_t)row * ZS2W_ + 1536 + ch);
  r.bon = p.sc_bonus[(size_t)row * NH_ + head];
}
__device__ __forceinline__ void phase_post_fast(const Params& p, int l) {
  const int tid = otid(), wave = tid >> 6, lane = tid & 63;
  const bool last = (l == DEPTH_ - 1);
  const int nrow = last ? NTOK_ : NROWS_;
  const int ch = 4 * lane;
  const int stride = gridDim.x * NWAVE;
  int row = obid() * NWAVE + wave;
  if (row >= nrow) return;
  const F4_ gm = *(const F4_*)(p.g_out_mla + l * GWID_ + ch), gl = *(const F4_*)(p.g_ln_x + l * GWID_ + ch);
  RawP cur; post_load(p, row, lane, cur);
  for (; row < nrow; row += stride) {
    RawP nxt; const bool has = row + stride < nrow;
    post_load(p, has ? row + stride : row, lane, nxt);
    const F4_ r_ob = cur.ob, r_y0 = cur.y0, r_y1 = cur.y1, r_v = cur.v; const U2_ r_gt = cur.gt; const float bon = cur.bon;
    {
      const float ss = wave_sum(r_ob.x * r_ob.x + r_ob.y * r_ob.y + r_ob.z * r_ob.z + r_ob.w * r_ob.w);
      const float rstd = rsqrtf(ss / (float)GWID_ + 1e-6f);
      float t[4] = {r_ob.x * rstd * gm.x, r_ob.y * rstd * gm.y, r_ob.z * rstd * gm.z, r_ob.w * rstd * gm.w};
      st4(p.y + (size_t)row * D_ + GWID_ + ch, t);
    }
    {
      float yv[4] = {r_y0.x + r_y1.x, r_y0.y + r_y1.y, r_y0.z + r_y1.z, r_y0.w + r_y1.w};
      float s1 = yv[0] + yv[1] + yv[2] + yv[3];
      s1 += __shfl_xor(s1, 1); s1 += __shfl_xor(s1, 2); s1 += __shfl_xor(s1, 4); s1 += __shfl_xor(s1, 8);
      const float mean = s1 / (float)HD_;
      float s2 = 0.f;
#pragma unroll
      for (int j = 0; j < 4; ++j) { yv[j] -= mean; s2 += yv[j] * yv[j]; }
      s2 += __shfl_xor(s2, 1); s2 += __shfl_xor(s2, 2); s2 += __shfl_xor(s2, 4); s2 += __shfl_xor(s2, 8);
      const float rstd = rsqrtf(s2 / (float)HD_ + 64e-5f);
      const float gla[4] = {gl.x, gl.y, gl.z, gl.w}, va[4] = {r_v.x, r_v.y, r_v.z, r_v.w};
      float ga[4]; unp4(r_gt, ga);
      float t[4];
#pragma unroll
      for (int j = 0; j < 4; ++j) t[j] = (yv[j] * rstd * gla[j] + bon * va[j]) * ga[j];
      st4(p.y + (size_t)row * D_ + 2 * GWID_ + ch, t);
    }
    cur = nxt;
  }
}
#endif

__device__ __forceinline__ void phase_prep(const Params& p, int l) {
  float (*sm)[COLS_RWKV_ + 64] = (float (*)[COLS_RWKV_ + 64])SMEM_PTR();
  const int tid = otid(), wave = tid >> 6, lane = tid & 63;
  float* ws = sm[wave];
  const bool last = (l == DEPTH_ - 1);
  for (int row = obid() * NWAVE + wave; row < NROWS_; row += gridDim.x * NWAVE) {
    const bool isx = row < NTOK_;
    const int pos = row_pos(row), len = row_len(row), b = row_batch(row);
    const bf16_t* zr = p.z + (size_t)row * ZLD_;
    const bool hasp = pos > 0, hasn = pos < len - 1;
    const bf16_t* zp = zr - ZLD_; const bf16_t* zn = zr + ZLD_;
    const bool need_out = isx || !last;
    if (need_out) {
      const float* cw = p.conv_w + (size_t)l * 3 * GWID_;
      float t[GWID_ / 64]; float ss = 0.f;
#pragma unroll
      for (int i = 0; i < GWID_ / 64; ++i) {
        const int ch = i * 64 + lane;
        const float bv = bf2f(zr[ch]);
        const float u0 = bf2f(zr[GWID_ + ch]) * bf2f(zr[2 * GWID_ + ch]);
        const float up = hasp ? bf2f(zp[GWID_ + ch]) * bf2f(zp[2 * GWID_ + ch]) : 0.f;
        const float un = hasn ? bf2f(zn[GWID_ + ch]) * bf2f(zn[2 * GWID_ + ch]) : 0.f;
        const float yv = cw[ch] * up + cw[GWID_ + ch] * u0 + cw[2 * GWID_ + ch] * un;
        t[i] = bv * yv; ss += t[i] * t[i];
      }
      ss = wave_sum(ss);
      const float rstd = rsqrtf(ss / (float)GWID_ + 1e-6f);
#pragma unroll
      for (int i = 0; i < GWID_ / 64; ++i) { const int ch = i * 64 + lane; p.y[(size_t)row * D_ + ch] = f2bf(t[i] * rstd * p.g_out_conv[l * GWID_ + ch]); }
    }
    {
      const bf16_t* zm = zr + MLA0_;
      const int NF = ROPE_ / 4;
      const float* tab = p.tab_mla + (size_t)pos * 4 * NF;
      if (need_out) {
        for (int hh = 0; hh < NH_; ++hh) {
          float q0 = 0.f, q1 = 0.f;
          { const int e = lane; if (e < QK_) q0 = bf2f(e < HD_ ? zm[hh * HD_ + e] : zm[NH_ * HD_ + hh * ROPE_ + (e - HD_)]); }
          { const int e = lane + 64; if (e < QK_) q1 = bf2f(e < HD_ ? zm[hh * HD_ + e] : zm[NH_ * HD_ + hh * ROPE_ + (e - HD_)]); }
          const float ss = wave_sum(q0 * q0 + q1 * q1);
          const float rstd = rsqrtf(ss / (float)QK_ + 1e-6f);
          if (lane < QK_) ws[lane] = q0 * rstd * p.g_q_norm[l * QK_ + lane];
          if (lane + 64 < QK_) ws[lane + 64] = q1 * rstd * p.g_q_norm[l * QK_ + lane + 64];
          __builtin_amdgcn_wave_barrier();
          const float scale = 1.0f / sqrtf((float)QK_);
          for (int e = lane; e < QK_; e += 64) {
            float v = ws[e];
            if (isx && e >= HD_) {
              const int r = e - HD_; const int ax = r / (ROPE_ / 2), ri = r % (ROPE_ / 2); const int half = ri / NF, fi = ri % NF;
              const float cs = tab[(ax * 2 + 0) * NF + fi], sn = tab[(ax * 2 + 1) * NF + fi];
              const int base = HD_ + ax * (ROPE_ / 2);
              const float t1 = ws[base + fi], t2 = ws[base + NF + fi];
              v = half == 0 ? t1 * cs - t2 * sn : t1 * sn + t2 * cs;
            }
            p.qb[((size_t)row * NH_ + hh) * QK_ + e] = f2bf(v * scale);
          }
          __builtin_amdgcn_wave_barrier();
        }
      }
      float cs2 = 0.f;
      for (int e = lane; e < KVR_; e += 64) { const float v = bf2f(zm[NH_ * QK_ + e]); cs2 += v * v; }
      cs2 = wave_sum(cs2);
      const float crstd = rsqrtf(cs2 / (float)KVR_ + 1e-6f);
      for (int e = lane; e < KVR_; e += 64) ws[e] = bf2f(zm[NH_ * QK_ + e]) * crstd * p.g_kv_norm[l * KVR_ + e];
      __builtin_amdgcn_wave_barrier();
      float kn[GWID_ / 64], vv[GWID_ / 64];
#pragma unroll
      for (int i = 0; i < GWID_ / 64; ++i) { kn[i] = 0.f; vv[i] = 0.f; }
      const float* wuk = p.w_uk + (size_t)l * KVR_ * GWID_; const float* wuv = p.w_uv + (size_t)l * KVR_ * GWID_;
#pragma unroll 4
      for (int k = 0; k < KVR_; ++k) {
        const float cv = ws[k];
#pragma unroll
        for (int i = 0; i < GWID_ / 64; ++i) { kn[i] += cv * wuk[k * GWID_ + i * 64 + lane]; vv[i] += cv * wuv[k * GWID_ + i * 64 + lane]; }
      }
      __builtin_amdgcn_wave_barrier();
      const int kpos = isx ? LC_ + pos : pos;
#pragma unroll
      for (int i = 0; i < GWID_ / 64; ++i) {
        const int cidx = i * 64 + lane, hh = cidx / HD_, e = cidx % HD_;
        p.vb[(((size_t)b * NH_ + hh) * LK_ + kpos) * HD_ + e] = f2bf(vv[i]);
        ws[64 + cidx] = kn[i];
      }
      for (int e = lane; e < ROPE_; e += 64) ws[64 + GWID_ + e] = bf2f(zm[NH_ * QK_ + KVR_ + e]);
      __builtin_amdgcn_wave_barrier();
      float kr2 = 0.f;
      for (int e = lane; e < ROPE_; e += 64) { const float v = ws[64 + GWID_ + e]; kr2 += v * v; }
      kr2 = wave_sum(kr2);
      for (int hh = 0; hh < NH_; ++hh) {
        float s2 = 0.f;
        for (int e = lane; e < HD_; e += 64) { const float v = ws[64 + hh * HD_ + e]; s2 += v * v; }
        s2 = wave_sum(s2) + kr2;
        const float rstd = rsqrtf(s2 / (float)QK_ + 1e-6f);
        for (int e = lane; e < QK_; e += 64) {
          float v;
          if (e < HD_) v = ws[64 + hh * HD_ + e] * rstd * p.g_k_norm[l * QK_ + e];
          else {
            const int r = e - HD_;
            if (!isx) v = ws[64 + GWID_ + r] * rstd * p.g_k_norm[l * QK_ + e];
            else {
              const int ax = r / (ROPE_ / 2), ri = r % (ROPE_ / 2); const int half = ri / NF, fi = ri % NF;
              const float cs = tab[(ax * 2 + 0) * NF + fi], sn = tab[(ax * 2 + 1) * NF + fi];
              const int i1 = ax * (ROPE_ / 2) + fi, i2 = i1 + NF;
              const float t1 = ws[64 + GWID_ + i1] * rstd * p.g_k_norm[l * QK_ + HD_ + i1], t2 = ws[64 + GWID_ + i2] * rstd * p.g_k_norm[l * QK_ + HD_ + i2];
              v = half == 0 ? t1 * cs - t2 * sn : t1 * sn + t2 * cs;
            }
          }
          p.kb[(((size_t)b * NH_ + hh) * LK_ + kpos) * KLD_ + e] = f2bf(v);
        }
        for (int e = QK_ + lane; e < KLD_; e += 64) p.kb[(((size_t)b * NH_ + hh) * LK_ + kpos) * KLD_ + e] = 0;
      }
      __builtin_amdgcn_wave_barrier();
    }
    {
      const bf16_t* zw = zr + RW0_; const bf16_t* zwp = zp + RW0_; const bf16_t* zwn = zn + RW0_;
      const float* mu = p.rwkv_mu + (size_t)l * COLS_RWKV_;
      for (int e = lane; e < COLS_RWKV_; e += 64) {
        const float zc = bf2f(zw[e]); const float pv = hasp ? bf2f(zwp[e]) : 0.f; const float nv = hasn ? bf2f(zwn[e]) : 0.f;
        ws[e] = zc + mu[e] * (0.5f * (pv + nv) - zc);
      }
      __builtin_amdgcn_wave_barrier();
      for (int j = lane; j < DLORA_; j += 64) ws[3 * GWID_ + j] = tanhf(ws[3 * GWID_ + j]);
      for (int j = lane; j < GLORA_; j += 64) ws[3 * GWID_ + DLORA_ + ALORA_ + j] = sigmoidf_(ws[3 * GWID_ + DLORA_ + ALORA_ + j]);
      __builtin_amdgcn_wave_barrier();
      const float* zs = ws;
      const float* w2 = p.rwkv_w2 + (size_t)l * 2 * DLORA_ * GWID_; const float* a2 = p.rwkv_a2 + (size_t)l * 2 * ALORA_ * GWID_; const float* g2 = p.rwkv_g2 + (size_t)l * GLORA_ * GWID_;
      float bon[GWID_ / 64];
#pragma unroll
      for (int i = 0; i < GWID_ / 64; ++i) {
        const int ch = i * 64 + lane;
        const float rr = zs[ch], kk0 = zs[GWID_ + ch], vvv = zs[2 * GWID_ + ch];
        const float kkr = kk0 * p.rwkv_k_k[l * GWID_ + ch];
        float s2 = kkr * kkr;
        for (int m = 1; m < HD_ && m < 64; m <<= 1) s2 += __shfl_xor(s2, m);
        const float kkn = kkr * rsqrtf(s2 + 1e-12f);
        float gacc = 0.f;
#pragma unroll 4
        for (int j = 0; j < GLORA_; ++j) gacc += zs[3 * GWID_ + DLORA_ + ALORA_ + j] * g2[j * GWID_ + ch];
        float ksum = 0.f;
#pragma unroll 1
        for (int d = 0; d < 2; ++d) {
          float lw = p.rwkv_w0[(l * 2 + d) * GWID_ + ch], la = p.rwkv_a0[(l * 2 + d) * GWID_ + ch];
#pragma unroll 4
          for (int j = 0; j < DLORA_; ++j) lw += zs[3 * GWID_ + j] * w2[(d * DLORA_ + j) * GWID_ + ch];
#pragma unroll 4
          for (int j = 0; j < ALORA_; ++j) la += zs[3 * GWID_ + DLORA_ + j] * a2[(d * ALORA_ + j) * GWID_ + ch];
          const float sp = (-lw > 20.f) ? -lw : log1pf(expf(-lw));
          const float wdec = expf(-expf(-sp - 0.5f));
          const float a = sigmoidf_(la);
          const float kt = kk0 * (1.0f + (a - 1.0f) * p.rwkv_k_a[l * GWID_ + ch]);
          const size_t o = ((size_t)d * NROWS_ + row) * GWID_ + ch;
          p.sc_w[o] = wdec; p.sc_kka[o] = kkn * a; p.sc_kt[o] = kt; ksum += kt;
        }
        const size_t o = (size_t)row * GWID_ + ch;
        p.sc_r[o] = rr; p.sc_v[o] = vvv; p.sc_kk[o] = kkn; p.sc_gate[o] = gacc;
        float bs = rr * ksum * p.rwkv_r_k[l * GWID_ + ch];
        for (int m = 1; m < HD_ && m < 64; m <<= 1) bs += __shfl_xor(bs, m);
        bon[i] = bs;
      }
#pragma unroll
      for (int i = 0; i < GWID_ / 64; ++i) {
        const int ch = i * 64 + lane;
        if ((ch % HD_) == 0) { p.sc_bonus[(size_t)row * NH_ + ch / HD_] = bon[i]; p.sc_bonus[(size_t)(NROWS_ + row) * NH_ + ch / HD_] = 0.f; }
      }
      __builtin_amdgcn_wave_barrier();
    }
    {
      const bf16_t* zt = zr + RT0_;
      const int NR = HD_ / 2;
      const float* tab = p.tab_ret + (size_t)pos * 2 * NR;
      const float qs = 1.0f / sqrtf((float)HD_);
#pragma unroll
      for (int i = 0; i < GWID_ / 64; ++i) {
        const int ch = i * 64 + lane, hh = ch / HD_, e = ch % HD_;
        float q = bf2f(zt[ch]) * qs, k = bf2f(zt[GWID_ + ch]);
        if (isx) {
          const int fi = e % NR; const int half = e / NR;
          const int c1 = hh * HD_ + fi, c2 = c1 + NR;
          const float q1 = bf2f(zt[c1]) * qs, q2 = bf2f(zt[c2]) * qs, k1 = bf2f(zt[GWID_ + c1]), k2 = bf2f(zt[GWID_ + c2]);
          const float cs = tab[fi], sn = tab[NR + fi];
          q = half == 0 ? q1 * cs - q2 * sn : q1 * sn + q2 * cs;
          k = half == 0 ? k1 * cs - k2 * sn : k1 * sn + k2 * cs;
        }
        p.rq[(size_t)row * GWID_ + ch] = f2bf(q); p.rk[(size_t)row * GWID_ + ch] = f2bf(k); p.rv[(size_t)row * GWID_ + ch] = zt[2 * GWID_ + ch];
      }
    }
  }
}

__device__ __forceinline__ int chunk_row0(int b, int n) { return n < NCC_ ? NTOK_ + b * LC_ + n * RCH_ : b * L_ + (n - NCC_) * RCH_; }
__device__ __forceinline__ float ret_lg(int hh) { return log1pf(-exp2f(-5.0f - (float)hh)); }

__device__ __forceinline__ void phase_retd(const Params& p, int l) {
  const int tid = otid();
  const int nunits = B_ * NH_ * NCH_ * 2;
  for (int u = obid(); u < nunits; u += gridDim.x) {
    const int d = u & 1, n = (u >> 1) % NCH_, hh = ((u >> 1) / NCH_) % NH_, b = (u >> 1) / (NCH_ * NH_);
    const int r0 = chunk_row0(b, n);
    const float lg = ret_lg(hh);
    float* o = p.rd + ((((size_t)b * NH_ + hh) * NCH_ + n) * 2 + d) * HD_ * HD_;
    for (int e = tid; e < HD_ * HD_; e += NT) {
      const int kc = e / HD_, vc = e % HD_;
      float acc = 0.f;
      for (int c = 0; c < RCH_; ++c) {
        const float zeta = expf((d == 0 ? (float)(RCH_ - 1 - c) : (float)c) * lg);
        acc += zeta * bf2f(p.rk[(size_t)(r0 + c) * GWID_ + hh * HD_ + kc]) * bf2f(p.rv[(size_t)(r0 + c) * GWID_ + hh * HD_ + vc]);
      }
      o[e] = acc;
    }
  }
}

template <bool WITH_ATTN, bool WITH_SCAN, bool RS_BF16 = false> __device__ __forceinline__ void phase_mix(const Params& p, int l) {
  const int tid = otid(), wave = tid >> 6, lane = tid & 63;
  const bool last = (l == DEPTH_ - 1);
  for (int u = obid(); u < B_ * NH_ * 2; u += gridDim.x) {
    const int d = u & 1, hh = (u >> 1) % NH_, b = (u >> 1) / NH_;
    const float dec = expf((float)RCH_ * ret_lg(hh));
    for (int e = tid; e < HD_ * HD_; e += NT) {
      float st = 0.f;
      for (int i = 0; i < NCH_; ++i) {
        int n;
        if (d == 0) n = i; else n = i < NCC_ ? (NCC_ - 1 - i) : (NCC_ + (NCH_ - 1 - i));
        const size_t o = ((((size_t)b * NH_ + hh) * NCH_ + n) * 2 + d) * HD_ * HD_ + e;
        if (RS_BF16) ((bf16_t*)p.rs)[o] = f2bf(st); else p.rs[o] = st;
        st = st * dec + p.rd[o];
      }
    }
  }
  if (WITH_SCAN) for (int u = obid() * NWAVE + wave; u < B_ * NH_ * 2; u += gridDim.x * NWAVE) {
    const int d = u & 1, hh = (u >> 1) % NH_, b = (u >> 1) / NH_;
    float s[HD_];
#pragma unroll
    for (int k = 0; k < HD_; ++k) s[k] = 0.f;
    const int vr = lane % HD_;
    for (int i = 0; i < LK_; ++i) {
      int row;
      if (d == 0) row = i < LC_ ? NTOK_ + b * LC_ + i : b * L_ + (i - LC_);
      else row = i < LC_ ? NTOK_ + b * LC_ + (LC_ - 1 - i) : b * L_ + (L_ - 1 - (i - LC_));
      const size_t o1 = (size_t)row * GWID_ + hh * HD_, o2 = ((size_t)d * NROWS_ + row) * GWID_ + hh * HD_;
      const float vt = p.sc_v[o1 + vr];
      float sa = 0.f;
#pragma unroll
      for (int k = 0; k < HD_; ++k) sa += s[k] * p.sc_kk[o1 + k];
      float yv = 0.f;
#pragma unroll
      for (int k = 0; k < HD_; ++k) { s[k] = s[k] * p.sc_w[o2 + k] - sa * p.sc_kka[o2 + k] + vt * p.sc_kt[o2 + k]; yv += s[k] * p.sc_r[o1 + k]; }
      if (lane < HD_) p.ys[o2 + vr] = yv;
    }
  }
  if (WITH_ATTN) {
    const int nq = last ? NTOK_ : NROWS_;
    for (int idx = obid() * NT + tid; idx < ((nq + NT - 1) / NT) * NT * NH_; idx += gridDim.x * NT) {
      const int blk = idx / (NT * NH_), rem = idx % (NT * NH_), hh = rem / NT, row = blk * NT + rem % NT;
      if (row >= nq) continue;
      const bool isx = row < NTOK_; const int b = row_batch(row);
      const int nk = isx ? LK_ : LC_;
      unsigned q[QK_ / 2]; float o[HD_];
      { const unsigned* qp = (const unsigned*)(p.qb + ((size_t)row * NH_ + hh) * QK_);
#pragma unroll
        for (int e = 0; e < QK_ / 2; ++e) q[e] = qp[e]; }
#pragma unroll
      for (int e = 0; e < HD_; ++e) o[e] = 0.f;
      float m = -1e30f, lsum = 0.f;
      const bf16_t* kbase = p.kb + ((size_t)b * NH_ + hh) * LK_ * KLD_; const bf16_t* vbase = p.vb + ((size_t)b * NH_ + hh) * LK_ * HD_;
      for (int j = 0; j < nk; ++j) {
        float sdot = 0.f;
        const unsigned* kp = (const unsigned*)(kbase + (size_t)j * KLD_);
#pragma unroll
        for (int e = 0; e < QK_ / 2; ++e) { const unsigned kq = kp[e], qq = q[e];
          union { unsigned u; float f; } a0, a1, b0, b1; a0.u = qq << 16; a1.u = qq & 0xFFFF0000u; b0.u = kq << 16; b1.u = kq & 0xFFFF0000u;
          sdot += a0.f * b0.f + a1.f * b1.f; }
        if (sdot > m) { const float corr = expf(m - sdot); lsum *= corr;
#pragma unroll
          for (int e = 0; e < HD_; ++e) o[e] *= corr;
          m = sdot; }
        const float pj = expf(sdot - m); lsum += pj;
#pragma unroll
        for (int e = 0; e < HD_; ++e) o[e] += pj * bf2f(vbase[(size_t)j * HD_ + e]);
      }
      const float il = 1.0f / lsum;
#pragma unroll
      for (int e = 0; e < HD_; ++e) p.ob[(size_t)row * GWID_ + hh * HD_ + e] = o[e] * il;
    }
  }
}


#ifndef CPU_EMU
namespace fa {
using bf16x8 = __attribute__((ext_vector_type(8))) short;
using s16x4  = __attribute__((ext_vector_type(4))) short;
using f32x16 = __attribute__((ext_vector_type(16))) float;
using u32x4  = __attribute__((ext_vector_type(4))) unsigned;
constexpr int NW = 8, QBLK = 32, KVBLK = 64, ND0 = QK_ / 16, NDV = HD_ / 32;
constexpr float THR = 8.f;
constexpr int LDQ = NH_ * QK_, LDKK = KLD_, LDV = HD_, LDO = GWID_;
constexpr size_t SHM_V = KVBLK * HD_ * 2, SHM_K = KVBLK * KLD_ * 2, SHM_ATTN = 2 * SHM_V + 2 * SHM_K + NW * 64 * 4;
#define KSWZ(row, colB) ((row) * 256 + ((colB) ^ (((row) & 7) << 4)))
#define SBAR() __builtin_amdgcn_sched_barrier(0)
__device__ __forceinline__ int crow(int r, int hi) { return (r & 3) + 8 * (r >> 2) + 4 * hi; }
__device__ __forceinline__ unsigned cvtpk(float lo, float hi) { unsigned r; asm volatile("v_cvt_pk_bf16_f32 %0, %1, %2" : "=v"(r) : "v"(lo), "v"(hi)); return r; }
__device__ __forceinline__ void partialSM(f32x16& p0, f32x16& p1, float& m_reg, float& mn, float& alpha) {
  constexpr float C = 1.4426950408889634f;
  float pmax = p0[0];
#pragma unroll
  for (int r = 1; r < 16; ++r) pmax = fmaxf(pmax, p0[r]);
#pragma unroll
  for (int r = 0; r < 16; ++r) pmax = fmaxf(pmax, p1[r]);
  { auto rr = __builtin_amdgcn_permlane32_swap(__float_as_uint(pmax), __float_as_uint(pmax), false, false);
    pmax = fmaxf(__uint_as_float(rr[0]), __uint_as_float(rr[1])); }
  if (__builtin_expect(__all(pmax - m_reg <= THR), 1)) { mn = m_reg; alpha = 1.f; }
  else { mn = fmaxf(m_reg, pmax); alpha = __builtin_amdgcn_exp2f((m_reg - mn) * C); m_reg = mn; }
  const float mnC = -mn * C;
#pragma unroll
  for (int r = 0; r < 16; ++r) p0[r] = fmaf(p0[r], C, mnC);
#pragma unroll
  for (int r = 0; r < 16; ++r) p1[r] = fmaf(p1[r], C, mnC);
#pragma unroll
  for (int r = 0; r < 16; ++r) p0[r] = __builtin_amdgcn_exp2f(p0[r]);
}
__device__ __forceinline__ void finishSM(f32x16& p0, f32x16& p1, float alpha, float& l_reg, bf16x8& pa0, bf16x8& pa1, bf16x8& pa2, bf16x8& pa3) {
#pragma unroll
  for (int r = 0; r < 16; ++r) p1[r] = __builtin_amdgcn_exp2f(p1[r]);
  float ps = 0;
#pragma unroll
  for (int r = 0; r < 16; ++r) ps += p0[r];
#pragma unroll
  for (int r = 0; r < 16; ++r) ps += p1[r];
  { auto rr = __builtin_amdgcn_permlane32_swap(__float_as_uint(ps), __float_as_uint(ps), false, false);
    ps = __uint_as_float(rr[0]) + __uint_as_float(rr[1]); }
  l_reg = l_reg * alpha + ps;
#define PK4(P, BASE, OUT) do { unsigned a0 = cvtpk(P[BASE + 0], P[BASE + 1]), a1 = cvtpk(P[BASE + 2], P[BASE + 3]);   \
    unsigned b0 = cvtpk(P[BASE + 4], P[BASE + 5]), b1 = cvtpk(P[BASE + 6], P[BASE + 7]);                              \
    auto r0 = __builtin_amdgcn_permlane32_swap(a0, b0, false, false); auto r1 = __builtin_amdgcn_permlane32_swap(a1, b1, false, false); \
    u32x4 w = {r0[0], r1[0], r0[1], r1[1]}; OUT = *reinterpret_cast<bf16x8*>(&w); } while (0)
  PK4(p0, 0, pa0); PK4(p0, 8, pa1); PK4(p1, 0, pa2); PK4(p1, 8, pa3);
#undef PK4
}
__device__ __forceinline__ void qkt(f32x16& p0, f32x16& p1, const char* Ks, const bf16x8* qr, int r32, int hi) {
  p0 = f32x16{}; p1 = f32x16{};
#pragma unroll
  for (int d0 = 0; d0 < ND0; ++d0) { const int cb = (d0 * 16 + hi * 8) * 2;
    bf16x8 b0 = *reinterpret_cast<const bf16x8*>(Ks + KSWZ(r32, cb));
    bf16x8 b1 = *reinterpret_cast<const bf16x8*>(Ks + KSWZ(32 + r32, cb));
    p0 = __builtin_amdgcn_mfma_f32_32x32x16_bf16(b0, qr[d0], p0, 0, 0, 0);
    p1 = __builtin_amdgcn_mfma_f32_32x32x16_bf16(b1, qr[d0], p1, 0, 0, 0); }
}
__device__ __forceinline__ int v_st(int k, int c) { const int kk = (k & ~0xC) | ((k & 4) << 1) | ((k & 8) >> 1); return ((kk >> 3) * NDV + (c >> 5)) * 512 + ((kk & 7) * 32 + (c & 31)) * 2; }
__device__ __forceinline__ int v_rd_base(int lane) { return ((lane & 3) << 3) | (((lane >> 2) & 3) << 6) | (((lane >> 4) & 1) << 5) | (((lane >> 5) & 1) << 8); }
constexpr int v_rd_off(int d0, int ks, int half) { return d0 * 512 + ks * (2 * NDV * 512) + half * (NDV * 512); }
template <int OFF> __device__ __forceinline__ s16x4 tr_read(int vb) { s16x4 r; asm volatile("ds_read_b64_tr_b16 %0, %1 offset:%2" : "=&v"(r) : "v"(vb), "i"(OFF) : "memory"); return r; }
template <int D0> __device__ __forceinline__ void pv_one(f32x16& od, int vb, bf16x8 pa0, bf16x8 pa1, bf16x8 pa2, bf16x8 pa3) {
  const s16x4 l0 = tr_read<v_rd_off(D0, 0, 0)>(vb), h0 = tr_read<v_rd_off(D0, 0, 1)>(vb), l1 = tr_read<v_rd_off(D0, 1, 0)>(vb), h1 = tr_read<v_rd_off(D0, 1, 1)>(vb);
  const s16x4 l2 = tr_read<v_rd_off(D0, 2, 0)>(vb), h2 = tr_read<v_rd_off(D0, 2, 1)>(vb), l3 = tr_read<v_rd_off(D0, 3, 0)>(vb), h3 = tr_read<v_rd_off(D0, 3, 1)>(vb);
  asm volatile("s_waitcnt lgkmcnt(0)" ::: "memory"); SBAR();
#define PK(L, H) (bf16x8){L[0], L[1], L[2], L[3], H[0], H[1], H[2], H[3]}
  od = __builtin_amdgcn_mfma_f32_32x32x16_bf16(pa0, PK(l0, h0), od, 0, 0, 0);
  od = __builtin_amdgcn_mfma_f32_32x32x16_bf16(pa1, PK(l1, h1), od, 0, 0, 0);
  od = __builtin_amdgcn_mfma_f32_32x32x16_bf16(pa2, PK(l2, h2), od, 0, 0, 0);
  od = __builtin_amdgcn_mfma_f32_32x32x16_bf16(pa3, PK(l3, h3), od, 0, 0, 0);
#undef PK
}
__device__ __forceinline__ void pv_d0(f32x16* o, int vb, bf16x8 pa0, bf16x8 pa1, bf16x8 pa2, bf16x8 pa3) {
  pv_one<0>(o[0], vb, pa0, pa1, pa2, pa3); pv_one<1>(o[1], vb, pa0, pa1, pa2, pa3);
}
__device__ __forceinline__ void attn_body(const bf16_t* __restrict__ Qb, const bf16_t* __restrict__ Kh, const bf16_t* __restrict__ Vh, float* __restrict__ Ob, int seq, char* lds) {
  const int tid = otid(), wid = tid >> 6, lane = tid & 63, r32 = lane & 31, hi = lane >> 5;
  char* V_lds = lds; char* K_lds = lds + 2 * SHM_V;
  float* ws = (float*)(lds + 2 * SHM_V + 2 * SHM_K) + wid * 64; float* li_l = ws; float* al_l = ws + 32;
  float m_reg = -1e30f, l_reg = 0; f32x16 o[NDV] = {}; bf16x8 qr[ND0];
  const bf16_t* Qw = Qb + (long)(wid * QBLK + r32) * LDQ + hi * 8;
#pragma unroll
  for (int d0 = 0; d0 < ND0; ++d0) qr[d0] = *reinterpret_cast<const bf16x8*>(Qw + d0 * 16);
  const int sr = tid >> 4, sc = (tid & 15) * 8;
  const int vr = tid >> 3, vc = (tid & 7) * 8, vst0 = v_st(vr, vc);
  const int vb0 = (int)(uintptr_t)V_lds + v_rd_base(lane);
  struct { bf16x8 vs0, ks0, ks1; } sr_[2];
#define SLOAD(i, k0) do { sr_[i].vs0 = *reinterpret_cast<const bf16x8*>(&Vh[(long)((k0) + vr) * LDV + vc]); \
    sr_[i].ks0 = *reinterpret_cast<const bf16x8*>(&Kh[(long)((k0) + sr) * LDKK + sc]); sr_[i].ks1 = *reinterpret_cast<const bf16x8*>(&Kh[(long)((k0) + 32 + sr) * LDKK + sc]); } while (0)
#define SWRITE(b, i) do { *(bf16x8*)(V_lds + (b) * SHM_V + vst0) = sr_[i].vs0; const int kc = sc * 2;               \
    *(bf16x8*)(K_lds + (b) * SHM_K + KSWZ(sr, kc)) = sr_[i].ks0;                       \
    *(bf16x8*)(K_lds + (b) * SHM_K + KSWZ(32 + sr, kc)) = sr_[i].ks1; } while (0)
#define SWAIT() asm volatile("s_waitcnt vmcnt(3)" ::: "memory")
#define RESC(a) do { if (__any((a) < 1.f)) { if (hi == 0) al_l[r32] = (a); asm volatile("s_waitcnt lgkmcnt(0)" ::: "memory"); \
    _Pragma("unroll") for (int d = 0; d < NDV; ++d) _Pragma("unroll") for (int r = 0; r < 16; ++r) o[d][r] *= al_l[crow(r, hi)]; } } while (0)
  f32x16 pA0, pA1, pB0, pB1; float mnA, mnB, alA, alB; bf16x8 pa0, pa1, pa2, pa3; const int NTL = seq / KVBLK;
  constexpr int SE = 0, SO = 1;
  SLOAD(SE, 0); asm volatile("s_waitcnt vmcnt(0)" ::: "memory"); SWRITE(0, SE); __syncthreads();
  qkt(pA0, pA1, K_lds, qr, r32, hi); partialSM(pA0, pA1, m_reg, mnA, alA);
  SLOAD(SO, KVBLK); if (2 < NTL) SLOAD(SE, 2 * KVBLK);
  SWAIT(); SWRITE(1, SO); __syncthreads();
  for (int j = 1; j + 1 < NTL; j += 2) {
    SBAR(); qkt(pB0, pB1, K_lds + SHM_K, qr, r32, hi);
    finishSM(pA0, pA1, alA, l_reg, pa0, pa1, pa2, pa3); SBAR();
    SLOAD(SO, (j + 2) * KVBLK); SBAR();
    pv_d0(o, vb0, pa0, pa1, pa2, pa3); partialSM(pB0, pB1, m_reg, mnB, alB);
    __syncthreads(); SWAIT(); SWRITE(0, SE);
    RESC(alB); __syncthreads();
    SBAR(); qkt(pA0, pA1, K_lds, qr, r32, hi);
    finishSM(pB0, pB1, alB, l_reg, pa0, pa1, pa2, pa3); SBAR();
    if (j + 3 < NTL) SLOAD(SE, (j + 3) * KVBLK); SBAR();
    pv_d0(o, vb0 + (int)SHM_V, pa0, pa1, pa2, pa3); partialSM(pA0, pA1, m_reg, mnA, alA);
    __syncthreads(); SWAIT(); SWRITE(1, SO);
    RESC(alA); __syncthreads();
  }
  SBAR(); qkt(pB0, pB1, K_lds + SHM_K, qr, r32, hi);
  finishSM(pA0, pA1, alA, l_reg, pa0, pa1, pa2, pa3); SBAR();
  pv_d0(o, vb0, pa0, pa1, pa2, pa3); partialSM(pB0, pB1, m_reg, mnB, alB);
  __syncthreads(); RESC(alB);
  finishSM(pB0, pB1, alB, l_reg, pa0, pa1, pa2, pa3); SBAR();
  pv_d0(o, vb0 + (int)SHM_V, pa0, pa1, pa2, pa3);
  if (hi == 0) li_l[r32] = l_reg; asm volatile("s_waitcnt lgkmcnt(0)" ::: "memory");
  float rli[16];
#pragma unroll
  for (int r = 0; r < 16; ++r) rli[r] = __builtin_amdgcn_rcpf(li_l[crow(r, hi)]);
  float* Ow = Ob + (long)(wid * QBLK) * LDO;
#pragma unroll
  for (int r = 0; r < 16; ++r) { const int orow = crow(r, hi);
#pragma unroll
    for (int d0 = 0; d0 < NDV; ++d0) Ow[(long)orow * LDO + d0 * 32 + r32] = o[d0][r] * rli[r]; }
#undef SLOAD
#undef SWRITE
#undef SWAIT
#undef RESC
}
}

__device__ __forceinline__ void phase_attn(const Params& p, int l) {
  const bool last = (l == DEPTH_ - 1);
  const int c = obid(), G = gridDim.x;
  const int nx = B_ * NH_ * (L_ / 256), nc = last ? 0 : B_ * NH_ * (LC_ / 256);
  char* lds = (char*)SMEM_PTR();
  for (int i = 0; i * G + c < nx + nc; ++i) {
    const int u = i * G + c;
    int b, hh, r0, seq;
    if (u < nx) {
      int pair, qb;
      if (G == 256) { pair = i * 16 + 2 * (c & 7) + ((c >> 3) >> 4); qb = (c >> 3) & 15; } else { pair = u / (L_ / 256); qb = u % (L_ / 256); }
      b = pair / NH_; hh = pair % NH_; r0 = b * L_ + qb * 256; seq = LK_;
    } else { const int v = u - nx; hh = v % NH_; b = v / NH_; r0 = NTOK_ + b * LC_; seq = LC_; }
    __syncthreads();
    fa::attn_body(p.qb + ((size_t)r0 * NH_ + hh) * QK_, p.kb + ((size_t)b * NH_ + hh) * LK_ * KLD_, p.vb + ((size_t)b * NH_ + hh) * LK_ * HD_, p.ob + (size_t)r0 * GWID_ + hh * HD_, seq, lds);
  }
  __syncthreads();
}
#endif


#ifndef CPU_EMU
namespace sc {
typedef float f2 __attribute__((ext_vector_type(2)));
typedef float f4 __attribute__((ext_vector_type(4)));
constexpr int CH = 32, NCHK = LK_ / CH, VECB = CH * HD_ * 4, VOFF = 5 * VECB, BUFB = VOFF + CH * 16 * 4;
static_assert(3 * BUFB <= XBW_OFF_, "scan ring fits LDS");
template <int CTRL> __device__ __forceinline__ float dpp_add(float v) {
  return v + __builtin_bit_cast(float, __builtin_amdgcn_update_dpp(0, __builtin_bit_cast(int, v), CTRL, 0xF, 0xF, true));
}
__device__ __forceinline__ float allreduce16(float v) { v = dpp_add<0xB1>(v); v = dpp_add<0x4E>(v); v = dpp_add<0x141>(v); v = dpp_add<0x140>(v); return v; }
__device__ __forceinline__ int step_row(int s, int b, int d) {
  if (d == 0) return s < LC_ ? NTOK_ + b * LC_ + s : b * L_ + (s - LC_);
  return s < LC_ ? NTOK_ + b * LC_ + (LC_ - 1 - s) : b * L_ + (L_ - 1 - (s - LC_));
}
struct In { f4 kk, kka, w, kt, r; float v; };
}
__device__ __forceinline__ void phase_scan(const Params& p, int l, LAS unsigned char* lds) {
  using namespace sc;
  const int tid = otid(), wid = __builtin_amdgcn_readfirstlane(tid >> 6), lane = tid & 63;
  const int G = gridDim.x;
  for (int u = obid(); u < B_ * NH_ * 2 * 4; u += G) {
    const int rg = (u >> 3) & 3, pi = (u & 7) + 8 * (u >> 5), d = pi & 1, hh = (pi >> 1) % NH_, b = pi / (2 * NH_);
    __syncthreads();
    if (wid >= 4) {
      const int lw = wid - 4;
      const size_t doff = (size_t)d * NROWS_ * GWID_;
      const float* b0 = p.sc_kk + hh * HD_ + (lane & 15) * 4;
      const float* b1 = p.sc_kka + doff + hh * HD_ + (lane & 15) * 4;
      const float* b2 = p.sc_w + doff + hh * HD_ + (lane & 15) * 4;
      const float* b3 = p.sc_kt + doff + hh * HD_ + (lane & 15) * 4;
      const float* b4 = p.sc_r + hh * HD_ + (lane & 15) * 4;
      const float* bv = p.sc_v + hh * HD_ + rg * 16 + (lane & 3) * 4;
#define SC_ISSUE(chunk) do { const int _ck = (chunk); LAS unsigned char* _buf = lds + (_ck % 3) * BUFB; \
        _Pragma("unroll") for (int k = 0; k < 10; ++k) { const int tg = (k & 1) * 4 + lw; const int srow = step_row(_ck * CH + tg * 4 + (lane >> 4), b, d); \
          const float* bp = (k >> 1) == 0 ? b0 : (k >> 1) == 1 ? b1 : (k >> 1) == 2 ? b2 : (k >> 1) == 3 ? b3 : b4; \
          __builtin_amdgcn_global_load_lds((const unsigned*)(bp + (size_t)srow * GWID_), (LAS unsigned*)(_buf + (k >> 1) * VECB + tg * 1024), 16, 0, 0); } \
        if (lw < 2) { const int srow = step_row(_ck * CH + lw * 16 + (lane >> 2), b, d); \
          __builtin_amdgcn_global_load_lds((const unsigned*)(bv + (size_t)srow * GWID_), (LAS unsigned*)(_buf + VOFF + lw * 1024), 16, 0, 0); } } while (0)
#define SC_WAITK() do { if (lw < 2) asm volatile("s_waitcnt vmcnt(11)" ::: "memory"); else asm volatile("s_waitcnt vmcnt(10)" ::: "memory"); } while (0)
      SC_ISSUE(0); SC_ISSUE(1);
      SC_WAITK();
      __builtin_amdgcn_s_barrier();
      constexpr int CVT_TOTAL = 3 * NEXP_ * (D_ / 64) * (D_ / 32);
      const int need = (u == obid()) ? (CVT_TOTAL + 4 * G - 1) / (4 * G) : 0;
      cvt_f32x4 rcur[8], rnew[8];
#pragma unroll
      for (int j = 0; j < 8; ++j) { rcur[j] = (cvt_f32x4){0.f, 0.f, 0.f, 0.f}; rnew[j] = rcur[j]; }
      for (int ck = 0; ck < NCHK; ++ck) {
        const bool dma = ck + 2 < NCHK;
        const int tnew = (ck * 4 + lw) * G + obid(), tcur = ((ck - 1) * 4 + lw) * G + obid();
        const bool ldn = ck < need && tnew < CVT_TOTAL, stc = ck >= 1 && ck <= need && tcur < CVT_TOTAL;
        if (dma) SC_ISSUE(ck + 2);
        if (ldn) cvt_moe_tile_load(p, l, tnew, lane, rnew);
        if (dma && ldn) { if (lw < 2) asm volatile("s_waitcnt vmcnt(19)" ::: "memory"); else asm volatile("s_waitcnt vmcnt(18)" ::: "memory"); }
        else if (dma) SC_WAITK();
        else asm volatile("s_waitcnt vmcnt(0)" ::: "memory");
        if (stc) cvt_moe_tile_store(p, tcur, lane, rcur);
#pragma unroll
        for (int j = 0; j < 8; ++j) rcur[j] = rnew[j];
        __builtin_amdgcn_s_barrier();
      }
#undef SC_ISSUE
#undef SC_WAITK
    } else {
      const int seg = lane & 15, rowl = wid * 4 + (lane >> 4);
      f2 s01 = {0.f, 0.f}, s23 = {0.f, 0.f};
      float* yb = p.ys + (size_t)d * NROWS_ * GWID_ + hh * HD_ + rg * 16 + rowl;
      __builtin_amdgcn_s_barrier();
      for (int ck = 0; ck < NCHK; ++ck) {
        const LAS unsigned char* buf = lds + (ck % 3) * BUFB;
        const LAS unsigned char* vb = buf + seg * 16;
        const LAS unsigned char* vv = buf + VOFF + rowl * 4;
        const int row0 = step_row(ck * CH, b, d);
        const long rstep = d == 0 ? (long)GWID_ : -(long)GWID_;
        float* yp = yb + (size_t)row0 * GWID_;
        In in[3]; float ykeep = 0.f, ypend = 0.f;
#define SC_LOAD(dst, t) do { dst.kk = *(const LAS f4*)(vb + 0 * VECB + (t) * 256); dst.kka = *(const LAS f4*)(vb + 1 * VECB + (t) * 256); dst.w = *(const LAS f4*)(vb + 2 * VECB + (t) * 256); \
          dst.kt = *(const LAS f4*)(vb + 3 * VECB + (t) * 256); dst.r = *(const LAS f4*)(vb + 4 * VECB + (t) * 256); dst.v = *(const LAS float*)(vv + (t) * 64); } while (0)
#define SC_YDONE(tt) do { const float _yy = allreduce16(ypend); ykeep = (seg == ((tt) & 15)) ? _yy : ykeep; \
          if (((tt) & 15) == 15) yp[(long)(((tt) & ~15) + seg) * rstep] = ykeep; } while (0)
        SC_LOAD(in[0], 0); SC_LOAD(in[1], 1);
#pragma unroll
        for (int t = 0; t < CH; ++t) {
          if (t + 2 < CH) SC_LOAD(in[(t + 2) % 3], t + 2);
          __builtin_amdgcn_sched_barrier(0);
          const In& x = in[t % 3];
          f2 p2 = s01 * (f2){x.kk[0], x.kk[1]}; p2 = s23 * (f2){x.kk[2], x.kk[3]} + p2;
          const float sa = allreduce16(p2[0] + p2[1]);
          if (t > 0) SC_YDONE(t - 1);
          const f2 vv2 = {x.v, x.v};
          s01 = s01 * (f2){x.w[0], x.w[1]} + vv2 * (f2){x.kt[0], x.kt[1]};
          s23 = s23 * (f2){x.w[2], x.w[3]} + vv2 * (f2){x.kt[2], x.kt[3]};
          const f2 nsa = {-sa, -sa};
          s01 = nsa * (f2){x.kka[0], x.kka[1]} + s01;
          s23 = nsa * (f2){x.kka[2], x.kka[3]} + s23;
          f2 y2 = s01 * (f2){x.r[0], x.r[1]}; y2 = s23 * (f2){x.r[2], x.r[3]} + y2;
          ypend = y2[0] + y2[1];
          __builtin_amdgcn_sched_barrier(0);
        }
        SC_YDONE(CH - 1);
#undef SC_YDONE
#undef SC_LOAD
        __builtin_amdgcn_s_barrier();
      }
    }
  }
  __syncthreads();
}
#endif


#ifndef CPU_EMU
namespace rt {
typedef short bf16x8 __attribute__((ext_vector_type(8)));
typedef float f32x4 __attribute__((ext_vector_type(4)));
typedef unsigned u32x4 __attribute__((ext_vector_type(4)));
typedef unsigned u32x2 __attribute__((ext_vector_type(2)));
constexpr int QS = 72, TS = 136;
__device__ __forceinline__ f32x4 mm(bf16x8 a, bf16x8 b, f32x4 c) { return __builtin_amdgcn_mfma_f32_16x16x32_bf16(a, b, c, 0, 0, 0); }
__device__ __forceinline__ float lg2_gamma(int hh) { return __builtin_amdgcn_logf(1.0f - __builtin_amdgcn_exp2f(-5.0f - (float)hh)); }
__device__ __forceinline__ unsigned pkbf(float a, float b) { unsigned r; asm volatile("v_cvt_pk_bf16_f32 %0, %1, %2" : "=v"(r) : "v"(a), "v"(b)); return r; }
}
__device__ __forceinline__ void phase_retA_mfma(const Params& p, LAS unsigned char* lds) {
  using namespace rt;
  const int tid = otid(), wid = tid >> 6, lane = tid & 63, fr = lane & 15, fq = lane >> 4;
  LAS bf16_t* Kf = (LAS bf16_t*)lds; LAS bf16_t* Kb = Kf + 64 * TS; LAS bf16_t* Vt = Kb + 64 * TS;
  for (int u = obid(); u < B_ * NH_ * NCH_; u += gridDim.x) {
    const int n = u % NCH_, hh = (u / NCH_) % NH_, b = u / (NCH_ * NH_);
    const int r0 = chunk_row0(b, n);
    const float lg2 = lg2_gamma(hh);
    __syncthreads();
    {
      const int tok = tid >> 2, part = tid & 3;
      const bf16_t* kp = p.rk + (size_t)(r0 + tok) * GWID_ + hh * HD_ + 16 * part; const bf16_t* vp = p.rv + (size_t)(r0 + tok) * GWID_ + hh * HD_ + 16 * part;
      const u32x4 k0 = *(const u32x4*)kp, k1 = *(const u32x4*)(kp + 8), v0 = *(const u32x4*)vp, v1 = *(const u32x4*)(vp + 8);
      const unsigned kw[8] = {k0.x, k0.y, k0.z, k0.w, k1.x, k1.y, k1.z, k1.w}, vw[8] = {v0.x, v0.y, v0.z, v0.w, v1.x, v1.y, v1.z, v1.w};
      const float zf = __builtin_amdgcn_exp2f((float)(RCH_ - 1 - tok) * lg2), zb = __builtin_amdgcn_exp2f((float)tok * lg2);
#pragma unroll
      for (int j = 0; j < 8; ++j) {
        const float ka = __uint_as_float(kw[j] << 16), kc = __uint_as_float(kw[j] & 0xFFFF0000u);
        const unsigned f = pkbf(ka * zf, kc * zf), g = pkbf(ka * zb, kc * zb);
        const int dd = 16 * part + 2 * j;
        Kf[dd * TS + tok] = (bf16_t)(f & 0xFFFFu); Kf[(dd + 1) * TS + tok] = (bf16_t)(f >> 16);
        Kb[dd * TS + tok] = (bf16_t)(g & 0xFFFFu); Kb[(dd + 1) * TS + tok] = (bf16_t)(g >> 16);
        Vt[dd * TS + tok] = (bf16_t)(vw[j] & 0xFFFFu); Vt[(dd + 1) * TS + tok] = (bf16_t)(vw[j] >> 16);
      }
    }
    __syncthreads();
    {
      const int d = wid >> 2, kt = wid & 3;
      const LAS bf16_t* Kd = d == 0 ? Kf : Kb;
      f32x4 acc[4];
#pragma unroll
      for (int vt = 0; vt < 4; ++vt) acc[vt] = (f32x4){0.f, 0.f, 0.f, 0.f};
#pragma unroll
      for (int ts = 0; ts < 4; ++ts) {
        const bf16x8 kfr = *(const LAS bf16x8*)(Kd + (16 * kt + fr) * TS + 32 * ts + 8 * fq);
#pragma unroll
        for (int vt = 0; vt < 4; ++vt) { const bf16x8 vfr = *(const LAS bf16x8*)(Vt + (16 * vt + fr) * TS + 32 * ts + 8 * fq); acc[vt] = mm(kfr, vfr, acc[vt]); }
      }
      float* o = p.rd + ((((size_t)b * NH_ + hh) * NCH_ + n) * 2 + d) * HD_ * HD_;
#pragma unroll
      for (int vt = 0; vt < 4; ++vt) *(f32x4*)(o + (16 * vt + fr) * HD_ + 16 * kt + 4 * fq) = acc[vt];
    }
  }
  __syncthreads();
}
__device__ __forceinline__ void phase_retB_mfma(const Params& p, int l, LAS unsigned char* lds) {
  using namespace rt;
  const int tid = otid(), wid = tid >> 6, lane = tid & 63, fr = lane & 15, fq = lane >> 4;
  const bool last = (l == DEPTH_ - 1);
  LAS bf16_t* Qs = (LAS bf16_t*)lds; LAS bf16_t* Ks = Qs + 128 * QS; LAS bf16_t* Vt = Ks + 128 * QS; LAS bf16_t* Rt = Vt + 64 * TS; LAS bf16_t* Ss = Rt + 2 * 64 * QS + wid * 16 * TS;
  const bf16_t* rs16 = (const bf16_t*)p.rs;
  for (int u = obid(); u < B_ * NH_ * NCH_; u += gridDim.x) {
    const int n = u % NCH_, hh = (u / NCH_) % NH_, b = u / (NCH_ * NH_);
    if (last && n < NCC_) continue;
    const int r0 = chunk_row0(b, n);
    const float lg2 = lg2_gamma(hh);
    __syncthreads();
    {
      const int tok = tid >> 2, part = tid & 3;
      const size_t go = (size_t)(r0 + tok) * GWID_ + hh * HD_ + 16 * part;
      const u32x4 q0 = *(const u32x4*)(p.rq + go), q1 = *(const u32x4*)(p.rq + go + 8), k0 = *(const u32x4*)(p.rk + go), k1 = *(const u32x4*)(p.rk + go + 8);
      const u32x4 v0 = *(const u32x4*)(p.rv + go), v1 = *(const u32x4*)(p.rv + go + 8);
      *(LAS u32x4*)(Qs + tok * QS + 16 * part) = q0; *(LAS u32x4*)(Qs + tok * QS + 16 * part + 8) = q1;
      *(LAS u32x4*)(Ks + tok * QS + 16 * part) = k0; *(LAS u32x4*)(Ks + tok * QS + 16 * part + 8) = k1;
      const unsigned vw[8] = {v0.x, v0.y, v0.z, v0.w, v1.x, v1.y, v1.z, v1.w};
#pragma unroll
      for (int j = 0; j < 8; ++j) { const int dd = 16 * part + 2 * j; Vt[dd * TS + tok] = (bf16_t)(vw[j] & 0xFFFFu); Vt[(dd + 1) * TS + tok] = (bf16_t)(vw[j] >> 16); }
      const int vi = tid >> 3, k0i = (tid & 7) * 8;
#pragma unroll
      for (int d = 0; d < 2; ++d) {
        const u32x4 rr = *(const u32x4*)(rs16 + ((((size_t)b * NH_ + hh) * NCH_ + n) * 2 + d) * HD_ * HD_ + vi * HD_ + k0i);
        *(LAS u32x4*)(Rt + d * 64 * QS + vi * QS + k0i) = rr;
      }
    }
    __syncthreads();
    const int i0 = 16 * wid, qpos = i0 + fr;
    bf16x8 qf[2];
#pragma unroll
    for (int kc = 0; kc < 2; ++kc) qf[kc] = *(const LAS bf16x8*)(Qs + (i0 + fr) * QS + 32 * kc + 8 * fq);
#pragma unroll
    for (int nt = 0; nt < 8; ++nt) {
      f32x4 sacc = (f32x4){0.f, 0.f, 0.f, 0.f};
#pragma unroll
      for (int kc = 0; kc < 2; ++kc) { const bf16x8 kf = *(const LAS bf16x8*)(Ks + (16 * nt + fr) * QS + 32 * kc + 8 * fq); sacc = mm(kf, qf[kc], sacc); }
      float sv[4];
#pragma unroll
      for (int t = 0; t < 4; ++t) { const int key = 16 * nt + 4 * fq + t; const int dist = qpos > key ? qpos - key : key - qpos; sv[t] = sacc[t] * __builtin_amdgcn_exp2f((float)dist * lg2); }
      u32x2 w; w.x = pkbf(sv[0], sv[1]); w.y = pkbf(sv[2], sv[3]);
      *(LAS u32x2*)(Ss + fr * TS + 16 * nt + 4 * fq) = w;
    }
    f32x4 yv[4], tf[4], tb[4];
#pragma unroll
    for (int vt = 0; vt < 4; ++vt) { yv[vt] = (f32x4){0.f, 0.f, 0.f, 0.f}; tf[vt] = yv[vt]; tb[vt] = yv[vt]; }
#pragma unroll
    for (int ks = 0; ks < 4; ++ks) {
      const bf16x8 sf = *(const LAS bf16x8*)(Ss + fr * TS + 32 * ks + 8 * fq);
#pragma unroll
      for (int vt = 0; vt < 4; ++vt) { const bf16x8 vf = *(const LAS bf16x8*)(Vt + (16 * vt + fr) * TS + 32 * ks + 8 * fq); yv[vt] = mm(vf, sf, yv[vt]); }
    }
#pragma unroll
    for (int kc = 0; kc < 2; ++kc)
#pragma unroll
      for (int vt = 0; vt < 4; ++vt) {
        const bf16x8 rf = *(const LAS bf16x8*)(Rt + (16 * vt + fr) * QS + 32 * kc + 8 * fq), rb = *(const LAS bf16x8*)(Rt + 64 * QS + (16 * vt + fr) * QS + 32 * kc + 8 * fq);
        tf[vt] = mm(rf, qf[kc], tf[vt]); tb[vt] = mm(rb, qf[kc], tb[vt]);
      }
    const float xf = __builtin_amdgcn_exp2f((float)(qpos + 1) * lg2), xb = __builtin_amdgcn_exp2f((float)(RCH_ - qpos) * lg2);
    float ss = 0.f;
#pragma unroll
    for (int vt = 0; vt < 4; ++vt)
#pragma unroll
      for (int t = 0; t < 4; ++t) { const float v = yv[vt][t] + xf * tf[vt][t] + xb * tb[vt][t]; yv[vt][t] = v; ss += v * v; }
    ss += __shfl_xor(ss, 16); ss += __shfl_xor(ss, 32);
    const float rstd = rsqrtf(ss * (1.0f / (float)HD_) + 1e-6f);
    const int row = r0 + qpos;
    f32x4 gv[4]; u32x2 rgv[4];
#pragma unroll
    for (int vt = 0; vt < 4; ++vt) { const int ch = hh * HD_ + 16 * vt + 4 * fq; gv[vt] = *(const f32x4*)(p.g_ret_norm + (size_t)l * GWID_ + ch); rgv[vt] = *(const u32x2*)(p.rg + (size_t)row * GWID_ + ch); }
#pragma unroll
    for (int vt = 0; vt < 4; ++vt) {
      const int ch = hh * HD_ + 16 * vt + 4 * fq;
      const f32x4 g = gv[vt]; const u32x2 rgw = rgv[vt];
      const float o0 = yv[vt][0] * rstd * g[0] * __uint_as_float(rgw.x << 16), o1 = yv[vt][1] * rstd * g[1] * __uint_as_float(rgw.x & 0xFFFF0000u);
      const float o2 = yv[vt][2] * rstd * g[2] * __uint_as_float(rgw.y << 16), o3 = yv[vt][3] * rstd * g[3] * __uint_as_float(rgw.y & 0xFFFF0000u);
      u32x2 w; w.x = pkbf(o0, o1); w.y = pkbf(o2, o3);
      *(u32x2*)(p.y + (size_t)row * D_ + 3 * GWID_ + ch) = w;
    }
  }
  __syncthreads();
}
#endif

template <bool WITH_RET> __device__ __forceinline__ void phase_post(const Params& p, int l) {
  float (*sm)[RCH_ + 2 * HD_] = (float (*)[RCH_ + 2 * HD_])SMEM_PTR();
  const int tid = otid(), wave = tid >> 6, lane = tid & 63;
  float* ws = sm[wave];
  const bool last = (l == DEPTH_ - 1);
  const int nrow = last ? NTOK_ : NROWS_;
  for (int row = obid() * NWAVE + wave; row < nrow; row += gridDim.x * NWAVE) {
    const int pos = row_pos(row), b = row_batch(row); const bool isx = row < NTOK_;
    {
      float t[GWID_ / 64]; float ss = 0.f;
#pragma unroll
      for (int i = 0; i < GWID_ / 64; ++i) { t[i] = p.ob[(size_t)row * GWID_ + i * 64 + lane]; ss += t[i] * t[i]; }
      ss = wave_sum(ss); const float rstd = rsqrtf(ss / (float)GWID_ + 1e-6f);
#pragma unroll
      for (int i = 0; i < GWID_ / 64; ++i) p.y[(size_t)row * D_ + GWID_ + i * 64 + lane] = f2bf(t[i] * rstd * p.g_out_mla[l * GWID_ + i * 64 + lane]);
    }
    {
#pragma unroll
      for (int i = 0; i < GWID_ / 64; ++i) {
        const int ch = i * 64 + lane; const size_t o = (size_t)row * GWID_ + ch;
        const float yv = p.ys[o] + p.ys[(size_t)NROWS_ * GWID_ + o];
        float s1 = yv;
        for (int m = 1; m < HD_ && m < 64; m <<= 1) s1 += __shfl_xor(s1, m);
        const float mean = s1 / (float)HD_;
        const float dv = yv - mean; float s2 = dv * dv;
        for (int m = 1; m < HD_ && m < 64; m <<= 1) s2 += __shfl_xor(s2, m);
        const float var = s2 / (float)HD_;
        float r = dv * rsqrtf(var + 64e-5f) * p.g_ln_x[l * GWID_ + ch];
        r += (p.sc_bonus[(size_t)row * NH_ + ch / HD_] + p.sc_bonus[(size_t)(NROWS_ + row) * NH_ + ch / HD_]) * p.sc_v[o];
        p.y[(size_t)row * D_ + 2 * GWID_ + ch] = f2bf(r * p.sc_gate[o]);
      }
    }
    if (WITH_RET) {
      const int n = isx ? NCC_ + pos / RCH_ : pos / RCH_, c = pos % RCH_;
      const int r0 = chunk_row0(b, n);
      for (int hh = 0; hh < NH_; ++hh) {
        const float lg = ret_lg(hh);
        for (int j = lane; j < RCH_; j += 64) {
          float sdot = 0.f;
          for (int e = 0; e < HD_; ++e) sdot += bf2f(p.rq[(size_t)row * GWID_ + hh * HD_ + e]) * bf2f(p.rk[(size_t)(r0 + j) * GWID_ + hh * HD_ + e]);
          const int dist = c > j ? c - j : j - c;
          ws[j] = sdot * expf((float)dist * lg);
        }
        for (int e = lane; e < HD_; e += 64) ws[RCH_ + e] = bf2f(p.rq[(size_t)row * GWID_ + hh * HD_ + e]);
        __builtin_amdgcn_wave_barrier();
        float yv = 0.f;
        const int vc = lane % HD_;
        for (int j = 0; j < RCH_; ++j) yv += ws[j] * bf2f(p.rv[(size_t)(r0 + j) * GWID_ + hh * HD_ + vc]);
        const float xf = expf((float)(c + 1) * lg), xb = expf((float)(RCH_ - c) * lg);
        const float* sf = p.rs + ((((size_t)b * NH_ + hh) * NCH_ + n) * 2 + 0) * HD_ * HD_;
        const float* sb = sf + HD_ * HD_;
        float cf = 0.f, cb = 0.f;
        for (int k = 0; k < HD_; ++k) { const float qk = ws[RCH_ + k]; cf += qk * sf[k * HD_ + vc]; cb += qk * sb[k * HD_ + vc]; }
        yv += xf * cf + xb * cb;
        float s2 = yv * yv;
        for (int m = 1; m < HD_ && m < 64; m <<= 1) s2 += __shfl_xor(s2, m);
        const float rstd = rsqrtf(s2 / (float)HD_ + 1e-6f);
        const int ch = hh * HD_ + vc;
#ifdef HAVE_PREPA
        const float sg = bf2f(p.rg[(size_t)row * GWID_ + ch]);
#else
        const float sg = siluf_(bf2f(p.z[(size_t)row * ZLD_ + RT0_ + 3 * GWID_ + ch]));
#endif
        if (lane < HD_) p.y[(size_t)row * D_ + 3 * GWID_ + ch] = f2bf(sg * yv * rstd * p.g_ret_norm[l * GWID_ + ch]);
        __builtin_amdgcn_wave_barrier();
      }
    }
  }
}

__device__ __forceinline__ void phase_topk(const Params& p, int l) {
  unsigned* vals = (unsigned*)SMEM_PTR();
  int* hist = (int*)(vals + (L_ > LC_ ? L_ : LC_));
  int* scan_gt = hist + 256; int* scan_eq = scan_gt + NT + 1;
  unsigned& s_prefix = *(unsigned*)(scan_eq + NT + 1); int& s_need = *(scan_eq + NT + 2);
  const int tid = otid();
  const bool last = (l == DEPTH_ - 1);
  const int nunits = (last ? B_ : 2 * B_) * NEXP_;
  for (int u = obid(); u < nunits; u += gridDim.x) {
    const int e = u % NEXP_, set = u / NEXP_; const bool isx = set < B_; const int b = isx ? set : set - B_;
    const int N = isx ? L_ : LC_, cap = isx ? CAP_ : CAPC_;
    const int row0 = isx ? b * L_ : NTOK_ + b * LC_;
    __syncthreads();
    for (int i = tid; i < N; i += NT) { union { float f; unsigned u; } x; x.f = p.aff[(size_t)(row0 + i) * NEXP_ + e]; vals[i] = x.u; }
    if (tid == 0) { s_prefix = 0u; s_need = cap; }
    __syncthreads();
    for (int pass = 0; pass < 4; ++pass) {
      const int shift = 24 - 8 * pass;
      for (int i = tid; i < 256; i += NT) hist[i] = 0;
      __syncthreads();
      const unsigned prefix = s_prefix; const unsigned himask = pass == 0 ? 0u : (0xFFFFFFFFu << (shift + 8));
      for (int i = tid; i < N; i += NT) { const unsigned v = vals[i]; if ((v & himask) == prefix) atomicAdd(&hist[(v >> shift) & 255], 1); }
      __syncthreads();
      if (tid < 64) {
        const int h0 = hist[4 * tid], h1 = hist[4 * tid + 1], h2 = hist[4 * tid + 2], h3 = hist[4 * tid + 3];
        const int c = h0 + h1 + h2 + h3;
        int suf = c;
        for (int d = 1; d < 64; d <<= 1) { const int o = __shfl_down(suf, d); if (tid + d < 64) suf += o; }
        const int above = suf - c;
        const int need0 = s_need;
        int need = need0 - above;
        const bool mine = (need > 0 && need <= c) || (tid == 0 && need > c);
        if (mine) {
          int bin;
          if (h3 >= need) bin = 3; else { need -= h3; if (h2 >= need) bin = 2; else { need -= h2; if (h1 >= need) bin = 1; else { need -= h1; bin = 0; } } }
          s_prefix = prefix | ((unsigned)(4 * tid + bin) << shift); s_need = need;
        }
      }
      __syncthreads();
    }
    const unsigned T = s_prefix; const int need_eq = s_need;
    const int per = (N + NT - 1) / NT;
    int cg = 0, ce = 0;
    for (int j = 0; j < per; ++j) { const int i = tid * per + j; if (i < N) { const unsigned v = vals[i]; cg += v > T; ce += v == T; } }
    int ig = cg, ie = ce;
    { const int ln = tid & 63;
      for (int d = 1; d < 64; d <<= 1) { const int og = __shfl_up(ig, d), oe = __shfl_up(ie, d); if (ln >= d) { ig += og; ie += oe; } }
      if (ln == 63) { scan_gt[tid >> 6] = ig; scan_eq[tid >> 6] = ie; } }
    __syncthreads();
    int rg = ig - cg, re = ie - ce;
    for (int w = 0; w < (tid >> 6); ++w) { rg += scan_gt[w]; re += scan_eq[w]; }
    const int slot0 = isx ? (e * B_ + b) * CAP_ : XSLOTS_ + (e * B_ + b) * CAPC_;
    for (int j = 0; j < per; ++j) {
      const int i = tid * per + j; if (i >= N) break;
      const unsigned v = vals[i];
      int slot = -1;
      if (v > T) { slot = rg + (re < need_eq ? re : need_eq); ++rg; }
      else if (v == T) { if (re < need_eq) slot = rg + re; ++re; }
      if (slot >= 0) { union { float f; unsigned u; } x; x.u = v; p.sel_idx[slot0 + slot] = row0 + i; p.sel_gate[slot0 + slot] = x.f; }
      p.inv[(size_t)(row0 + i) * NEXP_ + e] = slot >= 0 ? slot0 + slot : -1;
    }
  }
}

#ifndef CPU_EMU
#define XB_SPIN_CAP (1u << 24)
#endif
__device__ __forceinline__ void grid_sync(const Params& p) { (void)p; }

template <int PH> __device__ __forceinline__ void run_phase(const Params& p, int l) {
  if (PH == PH_MOD) phase_mod(p);
  if (PH == PH_NORM1) phase_norm<0>(p, l);
  if (PH == PH_GEMM_IN) phase_gemm_in(p, l);
#ifdef HAVE_PREPA
  if (PH == PH_PREP) phase_prepA(p, l);
  if (PH == PH_RETD) phase_prepB_naive(p, l);
  if (PH == PH_PREPC) phase_prepC(p, l);
#else
  if (PH == PH_PREP) phase_prep(p, l);
#endif
  if (PH == PH_RETD) phase_retd(p, l);
  if (PH == PH_MIX) phase_mix<true, true>(p, l);
#ifdef HAVE_PREPA
  if (PH == PH_POST) { phase_post<true>(p, l); phase_post_fast(p, l); }
#else
  if (PH == PH_POST) phase_post<true>(p, l);
#endif
  if (PH == PH_GEMM_OUT) phase_gemm_out(p, l);
  if (PH == PH_NORM2) phase_norm<1>(p, l);
  if (PH == PH_TOPK) phase_topk(p, l);
  if (PH == PH_MOE1) phase_moe1(p, l);
  if (PH == PH_MOE2) phase_moe2(p, l);
  if (PH == PH_FINAL) phase_norm<2>(p, l);
}
template <int PH> __global__ void __launch_bounds__(NT) k_phase(Params p, int l) { run_phase<PH>(p, l); }

#ifndef CPU_EMU
#define XB_TMO      128
#define XB_XCNT(j)  (256  + 64 * (j))
#define XB_XSUB(j)  (1280 + 64 * (j))
#define XB_XGEN(j)  (2304 + 64 * (j))
#define XB_TOP      3328
#define XB_TOPGEN   3392
#define XCD_BAR_WORDS 3456
#define XB_SPIN_CAP (1u << 23)
__device__ __forceinline__ unsigned xb_ld(unsigned* p)              { return __hip_atomic_load(p, __ATOMIC_RELAXED, __HIP_MEMORY_SCOPE_AGENT); }
__device__ __forceinline__ unsigned xb_add(unsigned* p, unsigned v) { return __hip_atomic_fetch_add(p, v, __ATOMIC_RELAXED, __HIP_MEMORY_SCOPE_AGENT); }
__device__ __forceinline__ unsigned xb_xcc_id() { return (unsigned)__builtin_amdgcn_s_getreg((3 << 11) | 20) & 0xFu; }
#define XB_SPIN(cond, bar) do { unsigned _sp = 0; while (cond) { __builtin_amdgcn_s_sleep(1); \
    if ((++_sp & 255u) == 0u) { if (xb_ld(&(bar)[XB_TMO])) break; if (_sp > XB_SPIN_CAP) { atomicAdd(&(bar)[XB_TMO], 1u); break; } } } } while (0)
struct XcdBarrier { unsigned* bar; unsigned x; volatile LAS unsigned* st; };
__device__ __forceinline__ XcdBarrier xcd_barrier_post(unsigned* bar, volatile LAS unsigned* st) {
    XcdBarrier b; b.bar = bar; b.x = xb_xcc_id(); b.st = st;
    if (threadIdx.x == 0) (void)xb_add(&bar[XB_XCNT(b.x)], 1u);
    return b;
}
__device__ __forceinline__ void xcd_barrier_complete(unsigned* bar, unsigned x, unsigned& nloc, unsigned& nx) {
    const unsigned G = gridDim.x * gridDim.y * gridDim.z;
    unsigned sum, cnt, mine, sp = 0u;
    for (;;) {
        sum = 0u; cnt = 0u; mine = 0u;
#pragma unroll
        for (unsigned j = 0; j < 16; ++j) { const unsigned c = xb_ld(&bar[XB_XCNT(j)]); sum += c; cnt += (c > 0u) ? 1u : 0u; mine = (j == x) ? c : mine; }
        if (sum == G) break;
        __builtin_amdgcn_s_sleep(1);
        if ((++sp & 255u) == 0u) { if (xb_ld(&bar[XB_TMO])) break; if (sp > XB_SPIN_CAP) { atomicAdd(&bar[XB_TMO], 1u); break; } }
    }
    nloc = mine > 0u ? mine : 1u; nx = cnt > 0u ? cnt : 1u;
}
__device__ __forceinline__ void xcd_barrier(const XcdBarrier& b) {
    asm volatile("s_waitcnt vmcnt(0)" ::: "memory");
    __syncthreads();
    if (threadIdx.x == 0) {
        unsigned* bar = b.bar; unsigned bx = b.x;
        asm volatile("" : "+s"(bx));
        __builtin_amdgcn_s_waitcnt(0);
        unsigned nloc = b.st[0], nx = b.st[1];
        if (nloc == 0u) { xcd_barrier_complete(bar, bx, nloc, nx); b.st[0] = nloc; b.st[1] = nx; }
        const unsigned old = xb_add(&bar[XB_XSUB(bx)], 1u);
        const unsigned gen = old / nloc;
        if (old + 1u == (gen + 1u) * nloc) {
            __builtin_amdgcn_fence(__ATOMIC_RELEASE, "agent");
            asm volatile("s_waitcnt vmcnt(0)" ::: "memory");
            const unsigned og = xb_add(&bar[XB_TOP], 1u);
            const unsigned tg = og / nx;
            if (og + 1u == (tg + 1u) * nx) xb_add(&bar[XB_TOPGEN], 1u);
            else XB_SPIN(xb_ld(&bar[XB_TOPGEN]) == tg, bar);
            __builtin_amdgcn_fence(__ATOMIC_ACQUIRE, "agent");
            xb_add(&bar[XB_XGEN(bx)], 1u);
            asm volatile("s_waitcnt vmcnt(0)" ::: "memory");
        } else {
            XB_SPIN(xb_ld(&bar[XB_XGEN(bx)]) == gen, bar);
            __builtin_amdgcn_fence(__ATOMIC_ACQUIRE, "agent");
            asm volatile("s_waitcnt vmcnt(0)" ::: "memory");
        }
    }
    __syncthreads();
}
typedef const Params __attribute__((address_space(4))) * KParamsPtr;
__device__ __forceinline__ const Params& kparams() { KParamsPtr kp = (KParamsPtr)__builtin_amdgcn_kernarg_segment_ptr(); asm volatile("" : "+s"(kp)); return *(const Params*)kp; }
#define KP kparams()
__global__ void __launch_bounds__(NT, 2) mega(Params p_unused) {
  (void)p_unused;
  LAS unsigned char* lds = (LAS unsigned char*)smem_dyn;
  if (threadIdx.x < 4) ((LAS unsigned*)(lds + XBW_OFF_))[threadIdx.x] = 0u;
  __syncthreads();
  XcdBarrier bar = xcd_barrier_post(KP.bar, (volatile LAS unsigned*)(lds + XBW_OFF_));
#ifdef TIMEMASK
  unsigned long long t_prev = __builtin_amdgcn_s_memrealtime(), t_acc = 0;
#define TSTAMP(k) do { const unsigned long long _t = __builtin_amdgcn_s_memrealtime(); if ((TIMEMASK >> (k)) & 1) t_acc += _t - t_prev; t_prev = _t; } while (0)
#else
#define TSTAMP(k) do { } while (0)
#endif
  phase_mod(KP);
  phase_cvt_static(KP);
  phase_cvt_small(KP);
  xcd_barrier(bar); TSTAMP(12);
  for (int l = 0; l < DEPTH_; ++l) {
    phase_norm<0>(KP, l); xcd_barrier(bar); TSTAMP(0);
    phase_gemm_in_mfma(KP, l, lds); xcd_barrier(bar); TSTAMP(1);
    phase_prepA(KP, l); xcd_barrier(bar); TSTAMP(2);
    phase_gemm_small_mfma(KP, l, lds); phase_retA_mfma(KP, lds); xcd_barrier(bar); TSTAMP(3);
    phase_prepC(KP, l); xcd_barrier(bar); TSTAMP(4);
    phase_mix<false, false, true>(KP, l); phase_attn(KP, l); phase_scan(KP, l, lds); xcd_barrier(bar); TSTAMP(5);
    phase_post_fast(KP, l); phase_retB_mfma(KP, l, lds); xcd_barrier(bar); TSTAMP(6);
    phase_gemm_out_mfma(KP, l, lds); xcd_barrier(bar); TSTAMP(7);
    phase_norm2_pf(KP, l); xcd_barrier(bar); TSTAMP(8);
    phase_topk(KP, l); xcd_barrier(bar); TSTAMP(9);
    phase_moe1_mfma(KP, l, lds); xcd_barrier(bar); TSTAMP(10);
    phase_moe2_mfma(KP, l, lds); xcd_barrier(bar); TSTAMP(11);
  }
  phase_norm<2>(KP, DEPTH_ - 1);
#ifdef TIMEMASK
  if (blockIdx.x == 0) { const unsigned long long t0 = __builtin_amdgcn_s_memrealtime(); while (__builtin_amdgcn_s_memrealtime() - t0 < t_acc * TIMEMULT) __builtin_amdgcn_s_sleep(16); }
#endif
}
#endif

#ifdef CPU_EMU
#define LAUNCH(PH, grid, p, l) emu_launch(dim3(grid), dim3(NT), LDS_BYTES_, [=]() { k_phase<PH>(p, l); })
#else
#define LAUNCH(PH, grid, p, l) hipLaunchKernelGGL(k_phase<PH>, dim3(grid), dim3(NT), LDS_BYTES_, stream, p, l)
#endif

static size_t align_up(size_t v) { return (v + 255) & ~(size_t)255; }

extern "C" void kernel_launch(void* const* d_in, const int* in_sizes, int n_in, void* d_out, int out_size, void* d_ws, size_t ws_size, hipStream_t stream) {
  (void)in_sizes; (void)n_in; (void)out_size; (void)ws_size;
  Params p;
  memset(&p, 0, sizeof(p));
  const float** ip = (const float**)&p.x;
  for (int i = 0; i < 34; ++i) ip[i] = (const float*)d_in[i];
  p.out = (float*)d_out;
  char* w = (char*)d_ws; size_t off = 0;
#define CARVE(field, type, count) do { p.field = (type*)(w + off); off = align_up(off + sizeof(type) * (size_t)(count)); } while (0)
  CARVE(bar, unsigned, 4096);
  CARVE(modv, float, (size_t)DEPTH_ * (B_ + 1) * 6 * D_);
  CARVE(xc, float, (size_t)NCTX_ * D_);
  CARVE(h, bf16_t, (size_t)NROWS_ * D_);
  CARVE(z, bf16_t, (size_t)NROWS_ * ZLD_);
  CARVE(y, bf16_t, (size_t)NROWS_ * D_);
  CARVE(qb, bf16_t, (size_t)NROWS_ * NH_ * QK_);
  CARVE(kb, bf16_t, (size_t)B_ * NH_ * LK_ * KLD_);
  CARVE(vb, bf16_t, (size_t)B_ * NH_ * LK_ * HD_);
  CARVE(sc_r, float, (size_t)NROWS_ * GWID_);
  CARVE(sc_v, float, (size_t)NROWS_ * GWID_);
  CARVE(sc_kk, float, (size_t)NROWS_ * GWID_);
  CARVE(sc_w, float, (size_t)2 * NROWS_ * GWID_);
  CARVE(sc_kka, float, (size_t)2 * NROWS_ * GWID_);
  CARVE(sc_kt, float, (size_t)2 * NROWS_ * GWID_);
  CARVE(sc_gate, float, (size_t)NROWS_ * GWID_);
  CARVE(sc_bonus, float, (size_t)2 * NROWS_ * NH_);
  CARVE(ys, float, (size_t)2 * NROWS_ * GWID_);
  CARVE(ob, float, (size_t)NROWS_ * GWID_);
  CARVE(rq, bf16_t, (size_t)NROWS_ * GWID_);
  CARVE(rk, bf16_t, (size_t)NROWS_ * GWID_);
  CARVE(rv, bf16_t, (size_t)NROWS_ * GWID_);
  CARVE(tab_mla, float, (size_t)L_ * ROPE_);
  CARVE(tab_ret, float, (size_t)L_ * HD_);
  CARVE(aff, float, (size_t)NROWS_ * NEXP_);
  CARVE(sel_idx, int, (size_t)XSLOTS_ + CSLOTS_);
  CARVE(sel_gate, float, (size_t)XSLOTS_ + CSLOTS_);
  CARVE(inv, int, (size_t)NROWS_ * NEXP_);
  CARVE(wb_in, bf16_t, (size_t)DEPTH_ * ZLD_ * D_);
  CARVE(wb_out, bf16_t, (size_t)DEPTH_ * D_ * D_);
  CARVE(kr2, float, (size_t)NROWS_);
  CARVE(bts, bf16_t, (size_t)DEPTH_ * ZS2W_ * AUXW_);
  CARVE(rg, bf16_t, (size_t)NROWS_ * GWID_);
  p.hid = (bf16_t*)p.z;
  p.ye = (bf16_t*)p.sc_w;
  p.zs2 = p.z;
  p.rd = (float*)p.h; p.rs = p.rd + (size_t)B_ * NH_ * NCH_ * 2 * HD_ * HD_;
  p.aux = (bf16_t*)p.ob;
  p.kbuf = (bf16_t*)p.ys; p.krp = p.kbuf + (size_t)NROWS_ * GWID_;
  p.wb_moe1 = p.z + (((size_t)(XSLOTS_ + CSLOTS_) * D_ + 127) / 128) * 128;
  p.wb_moe2 = p.wb_moe1 + (size_t)NEXP_ * 2 * D_ * D_;
#undef CARVE
#ifndef CPU_EMU
  {
    static int grid = 0;
    if (!grid) {
      int dev = 0, cus = 0, per_cu = 0;
      hipGetDevice(&dev);
      hipDeviceGetAttribute(&cus, hipDeviceAttributeMultiprocessorCount, dev);
      hipFuncSetAttribute((const void*)mega, hipFuncAttributeMaxDynamicSharedMemorySize, LDS_BYTES_);
      hipOccupancyMaxActiveBlocksPerMultiprocessor(&per_cu, mega, NT, LDS_BYTES_);
      grid = cus * (per_cu < 1 ? per_cu : 1);
    }
    hipMemsetAsync(p.bar, 0, 4096 * sizeof(unsigned), stream);
    hipLaunchKernelGGL(mega, dim3(grid), dim3(NT), LDS_BYTES_, stream, p);
    return;
  }
#else
  const int grid = 256;
  LAUNCH(PH_MOD, grid, p, 0);
  for (int l = 0; l < DEPTH_; ++l) {
    LAUNCH(PH_NORM1, grid, p, l);
    LAUNCH(PH_GEMM_IN, grid, p, l);
    LAUNCH(PH_PREP, grid, p, l);
    LAUNCH(PH_RETD, grid, p, l);
    LAUNCH(PH_PREPC, grid, p, l);
    LAUNCH(PH_MIX, grid, p, l);
    LAUNCH(PH_POST, grid, p, l);
    LAUNCH(PH_GEMM_OUT, grid, p, l);
    LAUNCH(PH_NORM2, grid, p, l);
    LAUNCH(PH_TOPK, grid, p, l);
    LAUNCH(PH_MOE1, grid, p, l);
    LAUNCH(PH_MOE2, grid, p, l);
    if (l == DEPTH_ - 1) LAUNCH(PH_FINAL, grid, p, l);
  }
#endif
}
```
